# Optimizing an MI355X kernel written in HIP

```python
import math
import jax, jax.numpy as jnp
from jax import lax
import numpy as np

D_MODEL = 1024
BATCH = 8
SEQ = 2048
DEPTH = 4
DEC_BATCH = 128
DEC_SEQ = 8
PAST_LEN = 16384
PAGE_SIZE = 128

N_MIXERS = 2
POOL_WINDOWS = (2, 4, 8, 16)
POOL_GROUPS = len(POOL_WINDOWS)
POOL_GW = D_MODEL // POOL_GROUPS
POOL_MAXW = max(POOL_WINDOWS)
POOL_BUF = POOL_MAXW - 1
GLA_HEADS = 4
GLA_DK = D_MODEL // 2
GLA_DV = D_MODEL
GLA_DKH = GLA_DK // GLA_HEADS
GLA_DVH = GLA_DV // GLA_HEADS
GLA_GATE_RANK = 16
GLA_GATE_TEMP = 16.0
GLA_CHUNK = 32
GLA_IN = 2 * GLA_DK + 2 * GLA_DV + GLA_GATE_RANK
D_FF = ((8 * D_MODEL + 3 * 256 - 1) // (3 * 256)) * 256
N_POOL_LAYERS = (DEPTH + 1) // 2
N_GLA_LAYERS = DEPTH // 2
EPS = 1e-6

kernel_name = "pool_gla_hybrid_decoder_step"


def rmsnorm(x, g):
    xf = x.astype(jnp.float32)
    y = xf * lax.rsqrt(jnp.mean(xf * xf, axis=-1, keepdims=True) + EPS)
    return y.astype(x.dtype) * g


def swiglu(h, w1, w3, w2):
    return (jax.nn.silu(h @ w1) * (h @ w3)) @ w2


def pool_mixer(u, ctx, pos, w_pool, scale):
    B, T, D = u.shape
    ext = jnp.concatenate([jnp.zeros((B, 1, D), u.dtype), ctx.astype(u.dtype), u], axis=1)
    cs = jnp.cumsum(ext.astype(jnp.float32), axis=1)
    lag = jnp.concatenate(
        [cs[:, POOL_MAXW - w:POOL_MAXW - w + T, g * POOL_GW:(g + 1) * POOL_GW]
         for g, w in enumerate(POOL_WINDOWS)], axis=-1)
    sums = (cs[:, POOL_MAXW:] - lag).reshape(B, T, POOL_GROUPS, POOL_GW)
    wins = jnp.array(POOL_WINDOWS, dtype=jnp.int32)
    counts = jnp.minimum(pos[:, None] + 1, wins[None, :]).astype(jnp.float32)
    pooled = sums / counts[None, :, :, None]
    diff = (pooled - u.astype(jnp.float32).reshape(B, T, POOL_GROUPS, POOL_GW)).astype(u.dtype)
    y = jnp.einsum('btgc,gcd->btgd', diff, w_pool).reshape(B, T, D) * scale
    new_ctx = ext[:, -POOL_BUF:]
    return y, new_ctx


def gla_recurrence(q, k, v, log_a, S0):
    B, T, H, _ = q.shape
    C = min(GLA_CHUNK, T)
    n = -(-T // C)
    pad = n * C - T

    def prep(t):
        t = jnp.pad(t.astype(jnp.float32), ((0, 0), (0, pad), (0, 0), (0, 0)))
        return t.reshape(B, n, C, H, t.shape[-1]).transpose(1, 0, 3, 2, 4)

    qs, ks, vs, gs = prep(q), prep(k), prep(v), prep(log_a)
    mask = jnp.tril(jnp.ones((C, C), dtype=bool))[:, :, None]

    def step(S, inp):
        qc, kc, vc, gc = inp
        b = jnp.cumsum(gc, axis=2)
        diff = b[:, :, :, None, :] - b[:, :, None, :, :]
        decay = jnp.exp(jnp.where(mask, diff, -jnp.inf))
        A = jnp.einsum('bhid,bhjd,bhijd->bhij', qc, kc, decay)
        o = jnp.einsum('bhij,bhjv->bhiv', A, vc) + jnp.einsum('bhid,bhdv->bhiv', qc * jnp.exp(b), S)
        b_last = b[:, :, -1:, :]
        S_new = jnp.exp(b_last[:, :, 0, :, None]) * S + jnp.einsum('bhjd,bhjv->bhdv', kc * jnp.exp(b_last - b), vc)
        return S_new, o

    S_fin, os_ = lax.scan(step, S0.astype(jnp.float32), (qs, ks, vs, gs))
    o = os_.transpose(1, 0, 3, 2, 4).reshape(B, n * C, H, -1)[:, :T]
    return o, S_fin


def gla_mixer(u, S0, w_in, w_a2, b_a, norm_w, w_o):
    B, T, _ = u.shape
    proj = u @ w_in
    q = proj[..., :GLA_DK].reshape(B, T, GLA_HEADS, GLA_DKH) * (GLA_DKH ** -0.5)
    k = proj[..., GLA_DK:2 * GLA_DK].reshape(B, T, GLA_HEADS, GLA_DKH)
    v = proj[..., 2 * GLA_DK:2 * GLA_DK + GLA_DV].reshape(B, T, GLA_HEADS, GLA_DVH)
    r = proj[..., 2 * GLA_DK + GLA_DV:2 * GLA_DK + 2 * GLA_DV]
    a_low = proj[..., 2 * GLA_DK + 2 * GLA_DV:]
    log_a = (jax.nn.log_sigmoid((a_low @ w_a2 + b_a).astype(jnp.float32)) / GLA_GATE_TEMP)
    log_a = log_a.reshape(B, T, GLA_HEADS, GLA_DKH)
    o, S = gla_recurrence(q, k, v, log_a, S0)
    o = o * lax.rsqrt(jnp.mean(o * o, axis=-1, keepdims=True) + EPS)
    o = o.astype(u.dtype) * norm_w.reshape(GLA_HEADS, GLA_DVH)
    o = o.reshape(B, T, GLA_DV) * jax.nn.silu(r)
    return o @ w_o, S.astype(S0.dtype)


def trunk(x, pool_ctx, gla_S, pos, norm_mix, norm_ffn, norm_final, pool_w, pool_scale,
          gla_w_in, gla_w_a2, gla_b_a, gla_norm, gla_w_o, ffn_w1, ffn_w3, ffn_w2):
    new_pool, new_gla = [], []
    for i in range(DEPTH):
        h = rmsnorm(x, norm_mix[i])
        j = i // N_MIXERS
        if i % N_MIXERS == 0:
            y, c = pool_mixer(h, pool_ctx[j], pos, pool_w[j], pool_scale[j])
            new_pool.append(c)
        else:
            y, S = gla_mixer(h, gla_S[j], gla_w_in[j], gla_w_a2[j], gla_b_a[j], gla_norm[j], gla_w_o[j])
            new_gla.append(S)
        x = x + y
        x = x + swiglu(rmsnorm(x, norm_ffn[i]), ffn_w1[i], ffn_w3[i], ffn_w2[i])
    return rmsnorm(x, norm_final), jnp.stack(new_pool), jnp.stack(new_gla)


def setup_inputs(seed: int = 0) -> dict:
    key = jax.random.key(seed)
    ks = jax.random.split(key, 20)
    f32 = jnp.float32
    nrm = lambda k, shape, s: jax.random.normal(k, shape, f32) * s
    return {
        "x_prompt": nrm(ks[0], (BATCH, SEQ, D_MODEL), 1.0),
        "x_sample": nrm(ks[1], (DEC_BATCH, DEC_SEQ, D_MODEL), 1.0),
        "state_pool": nrm(ks[2], (N_POOL_LAYERS, DEC_BATCH, POOL_BUF, D_MODEL), 1.0),
        "state_gla": nrm(ks[3], (N_GLA_LAYERS, DEC_BATCH, GLA_HEADS, GLA_DKH, GLA_DVH), 0.3),
        "norm_mix": 1.0 + nrm(ks[4], (DEPTH, D_MODEL), 0.02),
        "norm_ffn": 1.0 + nrm(ks[5], (DEPTH, D_MODEL), 0.02),
        "norm_final": 1.0 + nrm(ks[6], (D_MODEL,), 0.02),
        "pool_w": nrm(ks[7], (N_POOL_LAYERS, POOL_GROUPS, POOL_GW, POOL_GW), POOL_GW ** -0.5),
        "pool_scale": 1.0 + nrm(ks[8], (N_POOL_LAYERS, D_MODEL), 0.1),
        "gla_w_in": nrm(ks[9], (N_GLA_LAYERS, D_MODEL, GLA_IN), D_MODEL ** -0.5),
        "gla_w_a2": nrm(ks[10], (N_GLA_LAYERS, GLA_GATE_RANK, GLA_DK), GLA_GATE_RANK ** -0.5),
        "gla_b_a": nrm(ks[11], (N_GLA_LAYERS, GLA_DK), 0.1),
        "gla_norm": 1.0 + nrm(ks[12], (N_GLA_LAYERS, GLA_DV), 0.02),
        "gla_w_o": nrm(ks[13], (N_GLA_LAYERS, GLA_DV, D_MODEL), GLA_DV ** -0.5),
        "ffn_w1": nrm(ks[14], (DEPTH, D_MODEL, D_FF), D_MODEL ** -0.5),
        "ffn_w3": nrm(ks[15], (DEPTH, D_MODEL, D_FF), D_MODEL ** -0.5),
        "ffn_w2": nrm(ks[16], (DEPTH, D_FF, D_MODEL), D_FF ** -0.5),
    }


def reference(x_prompt, x_sample, state_pool, state_gla, norm_mix, norm_ffn, norm_final, pool_w, pool_scale,
              gla_w_in, gla_w_a2, gla_b_a, gla_norm, gla_w_o, ffn_w1, ffn_w3, ffn_w2):
    B, T = x_prompt.shape[0], x_prompt.shape[1]
    Bs, Ts = x_sample.shape[0], x_sample.shape[1]
    pos_prompt = jnp.arange(T, dtype=jnp.int32)
    pos_sample = PAST_LEN + jnp.arange(Ts, dtype=jnp.int32)
    pool0 = jnp.zeros((N_POOL_LAYERS, B, POOL_BUF, D_MODEL), x_prompt.dtype)
    gla0 = jnp.zeros((N_GLA_LAYERS, B, GLA_HEADS, GLA_DKH, GLA_DVH), jnp.float32)
    y_prompt, new_pool_prompt, new_gla_prompt = trunk(
        x_prompt, pool0, gla0, pos_prompt, norm_mix, norm_ffn, norm_final, pool_w, pool_scale,
        gla_w_in, gla_w_a2, gla_b_a, gla_norm, gla_w_o, ffn_w1, ffn_w3, ffn_w2)
    y_sample, new_pool_sample, new_gla_sample = trunk(
        x_sample, state_pool, state_gla, pos_sample, norm_mix, norm_ffn, norm_final, pool_w, pool_scale,
        gla_w_in, gla_w_a2, gla_b_a, gla_norm, gla_w_o, ffn_w1, ffn_w3, ffn_w2)
    return (y_prompt, y_sample, new_pool_prompt, new_gla_prompt, new_pool_sample, new_gla_sample)
```

```cpp
#include <hip/hip_runtime.h>
#include <cstdio>
#include <cstdint>
namespace pg8 {
#define PG8_LAS __attribute__((address_space(3)))
typedef unsigned short bf16_t;
typedef short bf16x8 __attribute__((ext_vector_type(8)));
typedef float f32x4 __attribute__((ext_vector_type(4)));
typedef unsigned u32x4 __attribute__((ext_vector_type(4)));
constexpr int BM = 256, BK = 64, HALF = 128, HTB = HALF * BK * 2  , STAGE_BYTES = 8 * HTB, NXCD = 8, WGM = 8;

__host__ __device__ __forceinline__ int lds_byte(int r, int c) { const int st = (r >> 4) * 2 + (c >> 5), rr = r & 15, cc = c & 31, ob = rr * 64 + cc * 2; return st * 1024 + (ob ^ (((ob >> 9) & 1) << 5)); }
__host__ __device__ __forceinline__ void stage_rc(int b, int& R, int& C) { const int st = b / 1024, sb = b % 1024, swz = sb ^ (((sb >> 9) & 1) << 5); R = (st >> 1) * 16 + swz / 64; C = (st & 1) * 32 + (swz % 64) / 2; }
__host__ __device__ __forceinline__ int perm32(int rho) { const int n = rho >> 4, i = rho & 15; return 8 * (i >> 2) + 4 * n + (i & 3); }

struct Unit { int pm, pn; };
struct Gemm { const bf16_t* A; const bf16_t* Bt; int M, N, K; };

struct StaticOrder {
    int nM, nN, nwg, G, c;
    __host__ __device__ void init(int M, int N, int G_, int c_) { nM = M / BM; nN = N / BM; nwg = nM * nN; G = G_; c = c_; }
    __host__ __device__ bool next(int i, Unit& u) const {
        const long L = (long)i * G + c; if (L >= nwg) return false;
        int wgid = (int)L; { const int q = nwg / NXCD, r = nwg % NXCD, xcd = wgid % NXCD, off = wgid / NXCD; wgid = (xcd < r ? xcd * (q + 1) : r * (q + 1) + (xcd - r) * q) + off; }
        const int nig = WGM * nN, gid = wgid / nig, fm = gid * WGM, gsz = (nM - fm) < WGM ? (nM - fm) : WGM;
        u.pm = fm + ((wgid % nig) % gsz); u.pn = (wgid % nig) / gsz; return true;
    }
    __device__ __forceinline__ void a_ready(const Unit&) const {}
    __device__ __forceinline__ void done(const Unit&) const {}
};

__device__ __forceinline__ unsigned cvt_pk_bf16(float lo, float hi) { unsigned r; asm volatile("v_cvt_pk_bf16_f32 %0, %1, %2" : "=v"(r) : "v"(lo), "v"(hi)); return r; }
typedef float f32x2 __attribute__((ext_vector_type(2)));
typedef unsigned u32x2 __attribute__((ext_vector_type(2)));
__device__ __forceinline__ float silu_f(float x) { return x * __builtin_amdgcn_rcpf(1.0f + __expf(-x)); }
constexpr int P_DM = 1024, P_FF = 2816, P_NT = 68  , P_PROJ = 3072;

struct EpiSwiglu {
    static constexpr bool PERM = true, AFTER_DRAIN = false;
    bf16_t* U;
    __device__ __forceinline__ void operator()(const f32x4 (&acc)[2][2][4][2], const Unit& u, int wr, int wc, int fr, int fq) const {
        const int row0 = u.pm * BM + wr * 64 + fr, col0 = u.pn * 128 + wc * 32 + 8 * fq;
#pragma unroll
        for (int ai = 0; ai < 2; ++ai)
#pragma unroll
            for (int m = 0; m < 4; ++m) { bf16_t* rowp = U + (size_t)(row0 + ai * HALF + m * 16) * P_FF + col0;
                const f32x4 g0 = acc[ai][0][m][0], g1 = acc[ai][0][m][1], u0 = acc[ai][1][m][0], u1 = acc[ai][1][m][1];
                u32x4 w; w.x = cvt_pk_bf16(silu_f(g0[0]) * u0[0], silu_f(g0[1]) * u0[1]); w.y = cvt_pk_bf16(silu_f(g0[2]) * u0[2], silu_f(g0[3]) * u0[3]);
                w.z = cvt_pk_bf16(silu_f(g1[0]) * u1[0], silu_f(g1[1]) * u1[1]); w.w = cvt_pk_bf16(silu_f(g1[2]) * u1[2], silu_f(g1[3]) * u1[3]);
                *(u32x4*)rowp = w; }
    }
};
struct EpiProj {
    static constexpr bool PERM = true, AFTER_DRAIN = false;
    bf16_t* P; float* AL;
    __device__ __forceinline__ void operator()(const f32x4 (&acc)[2][2][4][2], const Unit& u, int wr, int wc, int fr, int fq) const {
        const int row0 = u.pm * BM + wr * 64 + fr;
        if (u.pn < 12) {
            const float sc = u.pn < 2 ? 0.08838834764831845f : 1.0f;
            const int col0 = u.pn * BM + wc * 32 + 8 * fq;
#pragma unroll
            for (int ai = 0; ai < 2; ++ai)
#pragma unroll
                for (int m = 0; m < 4; ++m) { bf16_t* rowp = P + (size_t)(row0 + ai * HALF + m * 16) * P_PROJ + col0;
#pragma unroll
                    for (int bj = 0; bj < 2; ++bj) { const f32x4 v0 = acc[ai][bj][m][0] * sc, v1 = acc[ai][bj][m][1] * sc;
                        u32x4 w; w.x = cvt_pk_bf16(v0[0], v0[1]); w.y = cvt_pk_bf16(v0[2], v0[3]); w.z = cvt_pk_bf16(v1[0], v1[1]); w.w = cvt_pk_bf16(v1[2], v1[3]);
                        *(u32x4*)(rowp + bj * HALF) = w; } }
        } else if (wc == 0 && fq < 2) {
#pragma unroll
            for (int ai = 0; ai < 2; ++ai)
#pragma unroll
                for (int m = 0; m < 4; ++m) { float* rowp = AL + (size_t)(row0 + ai * HALF + m * 16) * 16 + 8 * fq;
                    *(f32x4*)rowp = acc[ai][0][m][0]; *(f32x4*)(rowp + 4) = acc[ai][0][m][1]; }
        }
    }
};
template <bool POOL> struct EpiRes {
    static constexpr bool PERM = false, AFTER_DRAIN = false;
    const float* bp; const float* bs; float* out; const float* scale;
    __device__ __forceinline__ void operator()(const f32x4 (&acc)[2][2][4][2], const Unit& u, int wr, int wc, int fr, int fq) const {
        const int pm = POOL ? (u.pm - P_NT * u.pn) : u.pm, pn = u.pn;
        const float* base = pm < 64 ? bp + (size_t)pm * BM * P_DM : bs + (size_t)(pm - 64) * BM * P_DM;
        float* o = out + (size_t)pm * BM * P_DM;
        int frq = fr + 16 * fq; asm volatile("" : "+v"(frq));
        const unsigned col0 = (unsigned)(pn * BM + wc * 32 + 4 * (frq >> 4));
        const unsigned roff = (unsigned)(wr * 64 + (frq & 15)) * P_DM + col0;
#pragma unroll
        for (int ai = 0; ai < 2; ++ai)
#pragma unroll
            for (int m = 0; m < 4; ++m) { const unsigned off = roff + (unsigned)(ai * HALF + m * 16) * P_DM;
#pragma unroll
                for (int bj = 0; bj < 2; ++bj)
#pragma unroll
                    for (int n = 0; n < 2; ++n) { f32x4 a = acc[ai][bj][m][n]; if (POOL) a = a * *(const f32x4*)(scale + col0 + bj * HALF + n * 16);
                        const f32x4 b = *(const f32x4*)(base + off + bj * HALF + n * 16); *(f32x4*)(o + off + bj * HALF + n * 16) = a + b; } }
    }
};
struct PoolOrder {
    int G, c;
    __device__ bool next(int i, Unit& u) const { const int L = i * G + c; if (L >= 4 * P_NT) return false; const int g = L & 3, pm = L >> 2; u.pm = g * P_NT + pm; u.pn = g; return true; }
    __device__ __forceinline__ void a_ready(const Unit&) const {}
    __device__ __forceinline__ void done(const Unit&) const {}
};
template <class Epi, class Sched, bool ALIGN_EPI = false, bool SP2 = false>
__device__ __forceinline__ void gemm_phase(PG8_LAS unsigned char* lds, const Gemm g, const Sched& S, const Epi& E, const int tid_in) {
    int tid_raw = tid_in; asm volatile("" : "+v"(tid_raw));
    const int tid = tid_raw, wid = __builtin_amdgcn_readfirstlane(tid >> 6), lane = tid & 63, wr = wid >> 2, wc = wid & 3, fr = lane & 15, fq = lane >> 4;
    const int K = g.K, nt = K / BK;
    unsigned voffA[2], voffB[2];
#pragma unroll
    for (int i = 0; i < 2; ++i) { int R, C; stage_rc(tid * 16 + i * 8192, R, C); const int Rb = Epi::PERM ? ((R & ~31) + perm32(R & 31)) : R;
        voffA[i] = (unsigned)(R * K + C) * 2u; voffB[i] = (unsigned)(Rb * K + C) * 2u; }
    const size_t kstep = (size_t)(BK * 2);
    const size_t hstep = (size_t)HALF * K * 2;
    const size_t tstep = 2 * hstep;
    const unsigned ldsw = (unsigned)wid * 1024u;
    const int aoff = lds_byte(wr * 64 + fr, fq * 8), boff = lds_byte(wc * 32 + fr, fq * 8);
#define PG8_SA(b, h) (((b) * 2 + (h)) * HTB)
#define PG8_SB(b, h) ((4 + (b) * 2 + (h)) * HTB)
#define PG8_STAGE(bufoff, gbase, voff) do { _Pragma("unroll") for (int _i = 0; _i < 2; ++_i) \
        __builtin_amdgcn_global_load_lds((const unsigned*)((const char*)(gbase) + (voff)[_i]), (PG8_LAS unsigned*)(lds + (bufoff) + ldsw + _i * 8192), 16, 0, 0); } while (0)
#define PG8_LDA(dst, b, h) do { _Pragma("unroll") for (int m = 0; m < 4; ++m) _Pragma("unroll") for (int k = 0; k < 2; ++k) dst[m][k] = *(const PG8_LAS bf16x8*)(lds + PG8_SA(b, h) + aoff + m * 2048 + k * 1024); } while (0)
#define PG8_LDB(dst, b, h) do { _Pragma("unroll") for (int n = 0; n < 2; ++n) _Pragma("unroll") for (int k = 0; k < 2; ++k) dst[n][k] = *(const PG8_LAS bf16x8*)(lds + PG8_SB(b, h) + boff + n * 2048 + k * 1024); } while (0)
#define PG8_MMA(ai, bj, At, Bt) do { __builtin_amdgcn_s_setprio(1); _Pragma("unroll") for (int m = 0; m < 4; ++m) _Pragma("unroll") for (int n = 0; n < 2; ++n) _Pragma("unroll") for (int k = 0; k < 2; ++k) \
        acc[ai][bj][m][n] = __builtin_amdgcn_mfma_f32_16x16x32_bf16(Bt[n][k], At[m][k], acc[ai][bj][m][n], 0, 0, 0); __builtin_amdgcn_s_setprio(0); } while (0)
#define PG8_WAIT_V(n) asm volatile("s_waitcnt vmcnt(" #n ")" ::: "memory")
#define PG8_WAIT_L(n) asm volatile("s_waitcnt lgkmcnt(" #n ")" ::: "memory")
#define PG8_BAR __builtin_amdgcn_s_barrier()
#define PG8_SCHED __builtin_amdgcn_sched_barrier(0)
    Unit cur, nxt; int ui = 0;
    if (!S.next(0, cur)) return;
    f32x4 acc[2][2][4][2];
#pragma unroll
    for (int a = 0; a < 2; ++a)
#pragma unroll
        for (int b = 0; b < 2; ++b)
#pragma unroll
            for (int m = 0; m < 4; ++m)
#pragma unroll
                for (int n = 0; n < 2; ++n) acc[a][b][m][n] = (f32x4){0.f, 0.f, 0.f, 0.f};
    bf16x8 At[4][2], B0[2][2], B1[2][2];
    const char* cA = (const char*)g.A + (size_t)cur.pm * tstep; const char* cB = (const char*)g.Bt + (size_t)cur.pn * tstep;
    S.a_ready(cur);
    if constexpr (SP2) {
        PG8_STAGE(PG8_SB(0, 0), cB, voffB); PG8_STAGE(PG8_SB(0, 1), cB + hstep, voffB); PG8_STAGE(PG8_SA(0, 0), cA, voffA); PG8_STAGE(PG8_SA(0, 1), cA + hstep, voffA);
        if (wr == 1) PG8_BAR;
        PG8_WAIT_V(2); PG8_BAR;
        PG8_STAGE(PG8_SB(1, 0), cB + kstep, voffB); PG8_STAGE(PG8_SA(1, 0), cA + kstep, voffA); PG8_STAGE(PG8_SB(1, 1), cB + hstep + kstep, voffB);
        PG8_WAIT_V(6); PG8_BAR;
    } else {
        PG8_STAGE(PG8_SB(0, 0), cB, voffB); PG8_STAGE(PG8_SA(0, 0), cA, voffA); PG8_STAGE(PG8_SB(0, 1), cB + hstep, voffB); PG8_STAGE(PG8_SA(0, 1), cA + hstep, voffA);
        if (wr == 1) PG8_BAR;
        PG8_WAIT_V(4); PG8_BAR;
        PG8_STAGE(PG8_SB(1, 0), cB + kstep, voffB); PG8_STAGE(PG8_SA(1, 0), cA + kstep, voffA); PG8_STAGE(PG8_SB(1, 1), cB + hstep + kstep, voffB);
        PG8_WAIT_V(6); PG8_BAR;
    }
    for (;;) {
        const bool has_next = S.next(ui + 1, nxt);
        const char* nA = has_next ? (const char*)g.A + (size_t)nxt.pm * tstep : cA; const char* nB = has_next ? (const char*)g.Bt + (size_t)nxt.pn * tstep : cB;
        for (int t = 0; t < nt; t += 2) {
            const bool last = (t == nt - 2);
            const char* a1 = cA + (size_t)(t + 1) * kstep;
            const char* a2 = last ? nA : cA + (size_t)(t + 2) * kstep; const char* b2 = last ? nB : cB + (size_t)(t + 2) * kstep;
            const char* a3 = a2 + kstep; const char* b3 = b2 + kstep;
            if (last && has_next) S.a_ready(nxt);
            if constexpr (SP2) {
            PG8_LDB(B0, 0, 0); PG8_LDB(B1, 0, 1); PG8_SCHED; PG8_LDA(At, 0, 0); PG8_STAGE(PG8_SA(1, 1), a1 + hstep, voffA);
            PG8_WAIT_V(8); PG8_WAIT_L(0); PG8_BAR; PG8_MMA(0, 0, At, B0); PG8_MMA(0, 1, At, B1); PG8_BAR; PG8_SCHED;
            PG8_LDA(At, 0, 1); PG8_STAGE(PG8_SB(0, 0), b2, voffB); PG8_STAGE(PG8_SB(0, 1), b2 + hstep, voffB); PG8_STAGE(PG8_SA(0, 0), a2, voffA);
            PG8_WAIT_V(8); PG8_WAIT_L(0); PG8_BAR; PG8_MMA(1, 0, At, B0); PG8_MMA(1, 1, At, B1); PG8_BAR; PG8_SCHED;
            PG8_LDB(B0, 1, 0); PG8_LDB(B1, 1, 1); PG8_SCHED; PG8_LDA(At, 1, 0); PG8_STAGE(PG8_SA(0, 1), a2 + hstep, voffA);
            PG8_WAIT_V(8); PG8_WAIT_L(0); PG8_BAR; PG8_MMA(0, 0, At, B0); PG8_MMA(0, 1, At, B1); PG8_BAR; PG8_SCHED;
            PG8_LDA(At, 1, 1); PG8_STAGE(PG8_SB(1, 0), b3, voffB); PG8_STAGE(PG8_SB(1, 1), b3 + hstep, voffB); PG8_STAGE(PG8_SA(1, 0), a3, voffA);
            PG8_WAIT_V(8); PG8_WAIT_L(0); PG8_BAR; PG8_MMA(1, 0, At, B0); PG8_MMA(1, 1, At, B1); PG8_BAR; PG8_SCHED;
            } else {
            PG8_LDB(B0, 0, 0); PG8_SCHED; PG8_LDA(At, 0, 0); PG8_STAGE(PG8_SA(1, 1), a1 + hstep, voffA);
            PG8_WAIT_L(8); PG8_BAR; PG8_WAIT_L(0); PG8_MMA(0, 0, At, B0); PG8_BAR; PG8_SCHED;
            PG8_LDB(B1, 0, 1); PG8_STAGE(PG8_SB(0, 0), b2, voffB);
            PG8_BAR; PG8_WAIT_L(0); PG8_MMA(0, 1, At, B1); PG8_BAR;
            PG8_LDA(At, 0, 1); PG8_STAGE(PG8_SA(0, 0), a2, voffA);
            PG8_BAR; PG8_WAIT_L(0); PG8_MMA(1, 0, At, B0); PG8_BAR; PG8_SCHED;
            PG8_STAGE(PG8_SB(0, 1), b2 + hstep, voffB);
            PG8_WAIT_V(6); PG8_BAR; PG8_MMA(1, 1, At, B1); PG8_BAR;
            PG8_LDB(B0, 1, 0); PG8_SCHED; PG8_LDA(At, 1, 0); PG8_STAGE(PG8_SA(0, 1), a2 + hstep, voffA);
            PG8_WAIT_L(8); PG8_BAR; PG8_WAIT_L(0); PG8_MMA(0, 0, At, B0); PG8_BAR; PG8_SCHED;
            PG8_LDB(B1, 1, 1); PG8_STAGE(PG8_SB(1, 0), b3, voffB);
            PG8_BAR; PG8_WAIT_L(0); PG8_MMA(0, 1, At, B1); PG8_BAR;
            PG8_LDA(At, 1, 1); PG8_STAGE(PG8_SA(1, 0), a3, voffA);
            PG8_BAR; PG8_WAIT_L(0); PG8_MMA(1, 0, At, B0); PG8_BAR; PG8_SCHED;
            PG8_STAGE(PG8_SB(1, 1), b3 + hstep, voffB);
            PG8_WAIT_V(6); PG8_BAR; PG8_MMA(1, 1, At, B1); PG8_BAR;
            }
        }
        if constexpr (ALIGN_EPI) { if (wr == 0) PG8_BAR; }
        if constexpr (!Epi::AFTER_DRAIN) { E(acc, cur, wr, wc, fr, fq); S.done(cur); }
        if (!has_next) break;
#pragma unroll
        for (int a = 0; a < 2; ++a)
#pragma unroll
            for (int b = 0; b < 2; ++b)
#pragma unroll
                for (int m = 0; m < 4; ++m)
#pragma unroll
                    for (int n = 0; n < 2; ++n) acc[a][b][m][n] = (f32x4){0.f, 0.f, 0.f, 0.f};
        cur = nxt; cA = nA; cB = nB; ++ui;
        if constexpr (ALIGN_EPI) { if (wr == 1) PG8_BAR; }
    }
    PG8_WAIT_V(0);
    if constexpr (!ALIGN_EPI) { if (wr == 0) PG8_BAR; }
    PG8_BAR;
    if constexpr (Epi::AFTER_DRAIN) { E.fused(acc, cur, wr, wc, fr, fq, lds, wid, lane); S.done(cur); }
#undef PG8_SA
#undef PG8_SB
#undef PG8_STAGE
#undef PG8_LDA
#undef PG8_LDB
#undef PG8_MMA
#undef PG8_WAIT_V
#undef PG8_WAIT_L
#undef PG8_BAR
#undef PG8_SCHED
}
}
#define GAS __attribute__((address_space(1)))
#define LAS __attribute__((address_space(3)))
typedef unsigned short bf16;
typedef unsigned v4u __attribute__((ext_vector_type(4)));
typedef float f32x4 __attribute__((ext_vector_type(4)));
typedef short bf16x8 __attribute__((ext_vector_type(8)));
typedef GAS unsigned gu32;
typedef GAS unsigned long long gu64;
#define RLX_AGENT __ATOMIC_RELAXED, __HIP_MEMORY_SCOPE_AGENT
#define LDS_WAIT() asm volatile("s_waitcnt lgkmcnt(0)" ::: "memory")
#define VM_WAIT() asm volatile("s_waitcnt vmcnt(0)" ::: "memory")
__device__ __forceinline__ unsigned long long rt() { return __builtin_amdgcn_s_memrealtime(); }
__device__ __forceinline__ unsigned f2bf(float f) { unsigned u = __builtin_bit_cast(unsigned, f); return (u + 0x7fffu + ((u >> 16) & 1u)) >> 16; }
__device__ __forceinline__ unsigned pk2(float lo, float hi) { return f2bf(lo) | (f2bf(hi) << 16); }

#define XB_TMO      128
#define XB_XCNT(j)  (256  + 64 * (j))
#define XB_XSUB(j)  (1280 + 64 * (j))
#define XB_XGEN(j)  (2304 + 64 * (j))
#define XB_TOP      3328
#define XB_TOPGEN   3392
#define XCD_BAR_WORDS 3456
#define XB_SPIN_CAP (1u << 18)

__device__ __forceinline__ unsigned xb_ld(unsigned* p)              { return __hip_atomic_load(p, __ATOMIC_RELAXED, __HIP_MEMORY_SCOPE_AGENT); }
__device__ __forceinline__ unsigned xb_add(unsigned* p, unsigned v) { return __hip_atomic_fetch_add(p, v, __ATOMIC_RELAXED, __HIP_MEMORY_SCOPE_AGENT); }
__device__ __forceinline__ unsigned xb_xcc_id() { return (unsigned)__builtin_amdgcn_s_getreg((3 << 11) | 20) & 0xFu; }
#define XB_SPIN(cond, bar) do { unsigned _sp = 0; while (cond) { __builtin_amdgcn_s_sleep(1); \
    if ((++_sp & 255u) == 0u) { if (xb_ld(&(bar)[XB_TMO])) break; if (_sp > XB_SPIN_CAP) { atomicAdd(&(bar)[XB_TMO], 1u); break; } } } } while (0)

struct XcdBarrier {
    unsigned* bar; unsigned x;
    volatile LAS unsigned* st;
};

__device__ __forceinline__ XcdBarrier xcd_barrier_post(unsigned* bar, volatile LAS unsigned* st) {
    XcdBarrier b; b.bar = bar; b.x = xb_xcc_id(); b.st = st;
    if (threadIdx.x == 0) (void)xb_add(&bar[XB_XCNT(b.x)], 1u);
    return b;
}
__device__ __forceinline__ void xcd_barrier_complete(unsigned* bar, unsigned x, unsigned& nloc, unsigned& nx) {
    const unsigned G = gridDim.x * gridDim.y * gridDim.z;
    unsigned sum, cnt, mine, sp = 0u;
    for (;;) {
        sum = 0u; cnt = 0u; mine = 0u;
#pragma unroll
        for (unsigned j = 0; j < 16; ++j) { const unsigned c = xb_ld(&bar[XB_XCNT(j)]); sum += c; cnt += (c > 0u) ? 1u : 0u; mine = (j == x) ? c : mine; }
        if (sum == G) break;
        __builtin_amdgcn_s_sleep(1);
        if ((++sp & 255u) == 0u) { if (xb_ld(&bar[XB_TMO])) break; if (sp > XB_SPIN_CAP) { atomicAdd(&bar[XB_TMO], 1u); break; } }
    }
    nloc = mine > 0u ? mine : 1u; nx = cnt > 0u ? cnt : 1u;
}

__device__ __forceinline__ void xcd_barrier(const XcdBarrier& b) {
    asm volatile("s_waitcnt vmcnt(0)" ::: "memory");
    __syncthreads();
    if (threadIdx.x == 0) {
        unsigned* bar = b.bar;
        __builtin_amdgcn_s_waitcnt(0);
        unsigned nloc = b.st[0], nx = b.st[1];
        if (nloc == 0u) { xcd_barrier_complete(bar, b.x, nloc, nx); b.st[0] = nloc; b.st[1] = nx; }
        const unsigned old = xb_add(&bar[XB_XSUB(b.x)], 1u);
        const unsigned gen = old / nloc;
        if (old + 1u == (gen + 1u) * nloc) {
            __builtin_amdgcn_fence(__ATOMIC_RELEASE, "agent");
            asm volatile("s_waitcnt vmcnt(0)" ::: "memory");
            const unsigned og = xb_add(&bar[XB_TOP], 1u);
            const unsigned tg = og / nx;
            if (og + 1u == (tg + 1u) * nx) xb_add(&bar[XB_TOPGEN], 1u);
            else XB_SPIN(xb_ld(&bar[XB_TOPGEN]) == tg, bar);
            __builtin_amdgcn_fence(__ATOMIC_ACQUIRE, "agent");
            xb_add(&bar[XB_XGEN(b.x)], 1u);
            asm volatile("s_waitcnt vmcnt(0)" ::: "memory");
        } else {
            XB_SPIN(xb_ld(&bar[XB_XGEN(b.x)]) == gen, bar);
            __builtin_amdgcn_fence(__ATOMIC_ACQUIRE, "agent");
            asm volatile("s_waitcnt vmcnt(0)" ::: "memory");
        }
    }
    __syncthreads();
}
constexpr int NWAVES = 8;
constexpr int DM = 1024, TP = 2048, NBP = 8, MP = NBP * TP, NBS = 128, TS = 8, MS = NBS * TS, M = MP + MS, FF = 2816, NG1 = 2 * FF;
constexpr int NIN = 3088, NINP = 3328, NPROJ = 3072, DK = 128, DV = 256, NH = 4;
constexpr float EPS = 1e-6f;
static_assert(M == 68 * 256, "row tiles");
constexpr size_t O_YP = 0, O_YS = (size_t)MP * DM, O_NPP = O_YS + (size_t)MS * DM, O_NGP = O_NPP + (size_t)2 * NBP * 15 * DM, O_NPS = O_NGP + (size_t)2 * NBP * NH * DK * DV,
                 O_NGS = O_NPS + (size_t)2 * NBS * 15 * DM, O_END = O_NGS + (size_t)2 * NBS * NH * DK * DV;
constexpr size_t MiB = 1u << 20;
constexpr size_t WS_CTL = 0, CTL_ZERO_BYTES = 1 * MiB;
constexpr size_t SZ_W13 = (size_t)NG1 * DM * 2, SZ_W2 = (size_t)DM * FF * 2, SZ_WIN = (size_t)NINP * DM * 2, SZ_WO = (size_t)DM * DM * 2, SZ_WP = (size_t)4 * 256 * 256 * 2;
constexpr size_t WS_W13 = 1 * MiB, WS_W2 = WS_W13 + 4 * SZ_W13, WS_WIN = WS_W2 + 4 * SZ_W2, WS_WO = WS_WIN + 2 * SZ_WIN, WS_WP = WS_WO + 2 * SZ_WO;
constexpr size_t WS_H = WS_WP + 2 * SZ_WP;
constexpr size_t WS_BIG = WS_H + (size_t)M * DM * 2;
constexpr size_t WS_ALOW = WS_BIG + (size_t)M * NPROJ * 2;
constexpr size_t WS_DS = WS_ALOW + (size_t)M * 16 * 4;
constexpr size_t WS_DSC = WS_DS + (size_t)32 * 7 * DK * DV * 4;
constexpr size_t WS_END = WS_DSC + (size_t)32 * 7 * DK * 4;
static_assert(WS_END <= 256 * MiB, "d_ws map");
static_assert(WS_H % 256 == 0 && WS_BIG % 256 == 0 && WS_ALOW % 256 == 0 && WS_DS % 256 == 0 && WS_DSC % 256 == 0, "alignment");
constexpr int CW_BAR = 4096;
constexpr int RING_BYTES = 131072, LDSCTL_OFF = RING_BYTES, MISC_OFF = LDSCTL_OFF + 320, LDS_BYTES = 147456;

__device__ __forceinline__ float wave_sum(float v) {
#pragma unroll
    for (int o = 1; o < 64; o <<= 1) v += __shfl_xor(v, o);
    return v;
}
__device__ __forceinline__ float bf2f(unsigned short b) { return __builtin_bit_cast(float, (unsigned)b << 16); }

__device__ __forceinline__ void tr_item(const float* W, int K, int N, bf16* WT, int mode, int row_off, LAS float* scr, int item, int lane) {
    const int nblk = (N + 31) >> 5, kb = item / nblk, nb = item - kb * nblk, k0 = 64 * kb, n0 = 32 * nb;
    const int nn = n0 + (lane & 31); const bool ok = nn < N;
#pragma unroll 8
    for (int i = 0; i < 32; ++i) { const int kk = 2 * i + (lane >> 5); scr[kk * 33 + (lane & 31)] = ok ? W[(size_t)(k0 + kk) * N + nn] : 0.f; }
    LDS_WAIT(); asm volatile("" ::: "memory");
    const int c = lane & 7;
#pragma unroll
    for (int j = 0; j < 4; ++j) { const int n = (lane >> 3) + 8 * j; const LAS float* s = scr + (8 * c) * 33 + n;
        v4u o; o.x = pk2(s[0 * 33], s[1 * 33]); o.y = pk2(s[2 * 33], s[3 * 33]); o.z = pk2(s[4 * 33], s[5 * 33]); o.w = pk2(s[6 * 33], s[7 * 33]);
        const int ng = n0 + n; const int row = mode ? (((ng >> 7) << 8) + (ng & 127) + row_off) : (row_off + ng);
        *(v4u*)(WT + (size_t)row * K + k0 + 8 * c) = o; }
    LDS_WAIT(); asm volatile("" ::: "memory");
}
__device__ __forceinline__ void p0_weights(LAS unsigned char* lds, int wave, int lane, int gw, int NGW, const float* const* in, unsigned char* ws) {
    LAS float* scr = (LAS float*)(lds + wave * 16384);
    constexpr int I_W1 = (DM / 64) * (FF / 32), I_W2 = (FF / 64) * (DM / 32), I_WIN = (DM / 64) * ((NIN + 31) / 32), I_WO = (DM / 64) * (DM / 32), I_WP = (256 / 64) * (256 / 32);
    constexpr int N_FFN = 4 * (2 * I_W1 + I_W2), N_GLA = 2 * (I_WIN + I_WO), N_POOL = 8 * I_WP, NITEMS = N_FFN + N_GLA + N_POOL;
    for (int it = gw; it < NITEMS; it += NGW) {
        int r = it;
        if (r < N_FFN) { const int L = r / (2 * I_W1 + I_W2); r -= L * (2 * I_W1 + I_W2);
            if (r < I_W1) { tr_item(in[14] + (size_t)L * DM * FF, DM, FF, (bf16*)(ws + WS_W13 + L * SZ_W13), 1, 0, scr, r, lane); continue; } r -= I_W1;
            if (r < I_W1) { tr_item(in[15] + (size_t)L * DM * FF, DM, FF, (bf16*)(ws + WS_W13 + L * SZ_W13), 1, 128, scr, r, lane); continue; } r -= I_W1;
            tr_item(in[16] + (size_t)L * FF * DM, FF, DM, (bf16*)(ws + WS_W2 + L * SZ_W2), 0, 0, scr, r, lane); continue; }
        r -= N_FFN;
        if (r < N_GLA) { const int L = r / (I_WIN + I_WO); r -= L * (I_WIN + I_WO);
            if (r < I_WIN) { tr_item(in[9] + (size_t)L * DM * NIN, DM, NIN, (bf16*)(ws + WS_WIN + L * SZ_WIN), 0, 0, scr, r, lane); continue; } r -= I_WIN;
            tr_item(in[13] + (size_t)L * DM * DM, DM, DM, (bf16*)(ws + WS_WO + L * SZ_WO), 0, 0, scr, r, lane); continue; }
        r -= N_GLA;
        { const int jg = r / I_WP; r -= jg * I_WP;
          tr_item(in[7] + (size_t)jg * 65536, 256, 256, (bf16*)(ws + WS_WP + (jg >> 2) * SZ_WP), 0, (jg & 3) * 256, scr, r, lane); }
    }
    constexpr int PADV = (NINP - 3104) * DM * 2 / 16;
    for (int i = gw * 64 + lane; i < 2 * PADV; i += NGW * 64) { const int L = i / PADV, e = i - L * PADV;
        ((v4u*)(ws + WS_WIN + L * SZ_WIN + (size_t)3104 * DM * 2))[e] = (v4u){0u, 0u, 0u, 0u}; }
}

__device__ __forceinline__ void rms_row_bf16(const float* xrow, const float* g, bf16* orow, int lane) {
    const f32x4* xr = (const f32x4*)xrow + lane; const f32x4* gr = (const f32x4*)g + lane;
    f32x4 v[4]; float s = 0.f;
#pragma unroll
    for (int j = 0; j < 4; ++j) { v[j] = xr[64 * j]; s += (v[j].x * v[j].x + v[j].y * v[j].y) + (v[j].z * v[j].z + v[j].w * v[j].w); }
    const float rstd = rsqrtf(wave_sum(s) * (1.f / DM) + EPS);
    unsigned long long* o8 = (unsigned long long*)orow + lane;
#pragma unroll
    for (int j = 0; j < 4; ++j) { const f32x4 gg = gr[64 * j]; const f32x4 y = v[j] * rstd * gg;
        o8[64 * j] = (unsigned long long)pk2(y.x, y.y) | ((unsigned long long)pk2(y.z, y.w) << 32); }
}
__device__ __forceinline__ void rms_phase(int gw, int NGW, int lane, const float* X, const float* g, bf16* H) {
    for (int m = gw; m < M; m += NGW) rms_row_bf16(X + (size_t)m * DM, g, H + (size_t)m * DM, lane);
}
__device__ __forceinline__ void final_norm_phase(int gw, int NGW, int lane, float* X, const float* g) {
    for (int m = gw; m < M; m += NGW) {
        f32x4* xr = (f32x4*)(X + (size_t)m * DM) + lane; const f32x4* gr = (const f32x4*)g + lane;
        f32x4 v[4]; float s = 0.f;
#pragma unroll
        for (int j = 0; j < 4; ++j) { v[j] = xr[64 * j]; s += (v[j].x * v[j].x + v[j].y * v[j].y) + (v[j].z * v[j].z + v[j].w * v[j].w); }
        const float rstd = rsqrtf(wave_sum(s) * (1.f / DM) + EPS);
#pragma unroll
        for (int j = 0; j < 4; ++j) xr[64 * j] = v[j] * rstd * gr[64 * j];
    }
}

__device__ __forceinline__ void pool_prep(LAS unsigned char* lds, int tid, int wave, int lane, int G, int bid,
                                          const float* xp, const float* xs, const float* gmix, const float* spool, bf16* DIFF, float* onp, float* ons) {
    typedef float f32x2 __attribute__((ext_vector_type(2)));
    LAS float* hb = (LAS float*)lds;
    for (int u = bid; u < 1024 + NBS; u += G) {
        const bool pr = u < 1024; const int b = pr ? (u >> 7) : (u - 1024); const int t0 = pr ? (u & 127) * 16 : 0; const int ntok = pr ? 16 : 8;
        for (int r = wave; r < 15 + ntok; r += NWAVES) {
            LAS f32x4* hrow = (LAS f32x4*)(hb + r * DM) + lane;
            const float* src = nullptr; bool donorm = true;
            if (pr) { const int t = t0 - 15 + r; if (t >= 0) src = xp + ((size_t)b * TP + t) * DM; }
            else { if (r < 15) { src = spool + ((size_t)b * 15 + r) * DM; donorm = false; } else src = xs + ((size_t)b * TS + (r - 15)) * DM; }
            if (!src) {
#pragma unroll
                for (int j = 0; j < 4; ++j) hrow[64 * j] = (f32x4){0.f, 0.f, 0.f, 0.f};
            } else {
                const f32x4* xr = (const f32x4*)src + lane; f32x4 v[4]; float s = 0.f;
#pragma unroll
                for (int j = 0; j < 4; ++j) { v[j] = xr[64 * j]; s += (v[j].x * v[j].x + v[j].y * v[j].y) + (v[j].z * v[j].z + v[j].w * v[j].w); }
                if (donorm) { const float rstd = rsqrtf(wave_sum(s) * (1.f / DM) + EPS); const f32x4* gr = (const f32x4*)gmix + lane;
#pragma unroll
                    for (int j = 0; j < 4; ++j) v[j] = v[j] * rstd * gr[64 * j]; }
#pragma unroll
                for (int j = 0; j < 4; ++j) hrow[64 * j] = v[j];
            }
        }
        __syncthreads();
        const int c = 2 * tid, gi = tid >> 7, w = 2 << gi;
        f32x2 sum = (f32x2){0.f, 0.f};
        for (int l = 1; l < w; ++l) sum += *(const LAS f32x2*)(hb + (15 - l) * DM + c);
        for (int i = 0; i < ntok; ++i) {
            const f32x2 cur = *(const LAS f32x2*)(hb + (15 + i) * DM + c); sum += cur;
            const int cnt = pr ? ((t0 + i + 1) < w ? (t0 + i + 1) : w) : w; const float inv = 1.0f / (float)cnt;
            const f32x2 d = sum * inv - cur;
            const size_t row = pr ? ((size_t)b * TP + t0 + i) : ((size_t)MP + b * TS + i);
            *(unsigned*)(DIFF + ((size_t)gi * M + row) * 256 + (c & 255)) = pk2(d.x, d.y);
            sum -= *(const LAS f32x2*)(hb + (15 + i - w + 1) * DM + c);
        }
        if (pr) { if (t0 == TP - 16) for (int i = 1; i < 16; ++i) *(f32x2*)(onp + ((size_t)b * 15 + (i - 1)) * DM + c) = *(const LAS f32x2*)(hb + (15 + i) * DM + c); }
        else for (int i = 0; i < 15; ++i) *(f32x2*)(ons + ((size_t)b * 15 + i) * DM + c) = *(const LAS f32x2*)(hb + (8 + i) * DM + c);
        __syncthreads();
    }
}

constexpr int L_QH = 0, L_KH = 17408, L_KT = 34816, L_VT = 53248, L_AL = 90112, L_ALOW = 99328, L_TOT = 103424, L_DL = 105472, L_SSQ = 105984, L_GLA_END = 108032;
constexpr int QS = 272, TSB = 144;
static_assert(L_GLA_END <= RING_BYTES, "GLA LDS");
__device__ __forceinline__ bf16x8 pack8(const f32x4 a, const f32x4 b) {
    v4u w; w.x = pg8::cvt_pk_bf16(a[0], a[1]); w.y = pg8::cvt_pk_bf16(a[2], a[3]); w.z = pg8::cvt_pk_bf16(b[0], b[1]); w.w = pg8::cvt_pk_bf16(b[2], b[3]);
    return __builtin_bit_cast(bf16x8, w);
}
__device__ __forceinline__ void gla_phase(LAS unsigned char* lds, int tid, int wave, int lane, int G, int bid, int phase, int jl,
                                          const float* const* in, float* out, unsigned char* ws) {
    typedef unsigned u32x2 __attribute__((ext_vector_type(2)));
    const bf16* PROJ = (const bf16*)(ws + WS_BIG); const float* ALOW = (const float*)(ws + WS_ALOW); bf16* GOUT = (bf16*)(ws + WS_H);
    float* DS = (float*)(ws + WS_DS); float* DSC = (float*)(ws + WS_DSC);
    const int nitems = phase == 0 ? (224 + 4 * NBS) : 256;
    const int tid_in = tid;
    for (int item = bid; item < nitems; item += G) {
        int tid = tid_in; asm volatile("" : "+v"(tid));
        int lane = tid & 63, fr = lane & 15, fq = lane >> 4, d = tid & 127, jq = tid >> 7;
        int b, h, row0, ntok, sc = 0; bool want_out, samp = false;
        if (phase == 0) { if (item < 224) { const int bh = item / 7; sc = item - bh * 7; b = bh >> 2; h = bh & 3; row0 = b * TP + sc * 256; ntok = 256; want_out = false; }
                          else { const int q = item - 224; b = q >> 2; h = q & 3; row0 = MP + b * TS; ntok = TS; want_out = true; samp = true; } }
        else { const int bh = item >> 3; sc = item & 7; b = bh >> 2; h = bh & 3; row0 = b * TP + sc * 256; ntok = 256; want_out = true; }
        const int bh = b * 4 + h;
        const float* wa2 = in[10] + (size_t)jl * 16 * 512 + h * DK + d;
        f32x4 S[8][2];
#pragma unroll
        for (int dt = 0; dt < 8; ++dt)
#pragma unroll
            for (int vt = 0; vt < 2; ++vt) S[dt][vt] = (f32x4){0.f, 0.f, 0.f, 0.f};
        if (samp) {
            const float* s0 = in[3] + ((size_t)(jl * NBS + b) * NH + h) * DK * DV;
#pragma unroll
            for (int dt = 0; dt < 8; ++dt)
#pragma unroll
                for (int vt = 0; vt < 2; ++vt)
#pragma unroll
                    for (int e = 0; e < 4; ++e) S[dt][vt][e] = s0[(size_t)(16 * dt + 4 * fq + e) * DV + 32 * wave + 16 * vt + fr];
        } else if (phase == 1) {
            for (int p = 0; p < sc; ++p) {
                const float* dsp = DS + (size_t)(bh * 7 + p) * DK * DV; const float* dcp = DSC + (size_t)(bh * 7 + p) * DK;
#pragma unroll
                for (int dt = 0; dt < 8; ++dt) { const f32x4 dv = *(const f32x4*)(dcp + 16 * dt + 4 * fq);
#pragma unroll
                    for (int vt = 0; vt < 2; ++vt) S[dt][vt] = S[dt][vt] * dv + *(const f32x4*)(dsp + (size_t)(((wave * 8 + dt) * 2 + vt) * 64 + lane) * 4); }
            }
        }
        float btot = 0.f;
        const int nsub = (ntok + 63) >> 6;
        for (int sb = 0; sb < nsub; ++sb) {
            const int tokv = (ntok - 64 * sb) < 64 ? (ntok - 64 * sb) : 64; const int rbase = row0 + 64 * sb;
            asm volatile("" : "+v"(tid)); lane = tid & 63; fr = lane & 15; fq = lane >> 4; d = tid & 127; jq = tid >> 7;
            unsigned short qv[16], kv[16];
#pragma unroll
            for (int i = 0; i < 16; ++i) { const int tok = jq * 16 + i; qv[i] = 0; kv[i] = 0;
                if (tok < tokv) { const bf16* pr = PROJ + (size_t)(rbase + tok) * NPROJ + h * DK + d; qv[i] = pr[0]; kv[i] = pr[512]; } }
            v4u vv[4]; { const int jv = tid & 63;
#pragma unroll
                for (int i = 0; i < 4; ++i) vv[i] = (v4u){0u, 0u, 0u, 0u};
                if (jv < tokv) { const v4u* pv = (const v4u*)(PROJ + (size_t)(rbase + jv) * NPROJ + 1024 + h * DV + 32 * wave);
#pragma unroll
                    for (int i = 0; i < 4; ++i) vv[i] = pv[i]; } }
            if (tid < 256) { const int tok = tid >> 2; f32x4 a = (f32x4){0.f, 0.f, 0.f, 0.f}; if (tok < tokv) a = *(const f32x4*)(ALOW + (size_t)(rbase + tok) * 16 + 4 * (tid & 3));
                *(LAS f32x4*)(lds + L_ALOW + tok * 64 + 16 * (tid & 3)) = a; }
            __syncthreads();
            float wa[16];
#pragma unroll
            for (int r = 0; r < 16; ++r) wa[r] = wa2[r * 512];
            const float ba = in[11][jl * 512 + h * DK + d];
            float bj[16]; float run = 0.f;
#pragma unroll
            for (int i = 0; i < 16; ++i) { const int tok = jq * 16 + i; const LAS f32x4* al = (const LAS f32x4*)(lds + L_ALOW + tok * 64);
                float x = ba;
#pragma unroll
                for (int r4 = 0; r4 < 4; ++r4) { const f32x4 a = al[r4]; x += a[0] * wa[4 * r4] + a[1] * wa[4 * r4 + 1] + a[2] * wa[4 * r4 + 2] + a[3] * wa[4 * r4 + 3]; }
                float g = (fminf(x, 0.f) - __logf(1.0f + __expf(-fabsf(x)))) * (1.0f / 16.0f);
                if (tok >= tokv) g = 0.f;
                run += g; bj[i] = run; }
            *(LAS float*)(lds + L_TOT + (jq * 128 + d) * 4) = run;
            __syncthreads();
            float pre = 0.f, blast = 0.f;
#pragma unroll
            for (int q = 0; q < 4; ++q) { const float t = *(const LAS float*)(lds + L_TOT + (q * 128 + d) * 4); blast += t; if (q < jq) pre += t; }
            btot += blast;
            if (jq == 0) *(LAS float*)(lds + L_DL + d * 4) = __expf(blast);
            { unsigned short kh[16];
#pragma unroll
              for (int i = 0; i < 16; ++i) { const int tok = jq * 16 + i; const float bb = bj[i] + pre; const float e1 = __expf(blast - bb), e2 = __expf(bb - blast);
                  const unsigned short qh = (unsigned short)f2bf(bf2f(qv[i]) * e2); kh[i] = (unsigned short)f2bf(bf2f(kv[i]) * e1);
                  *(LAS unsigned short*)(lds + L_QH + tok * QS + d * 2) = qh; *(LAS unsigned short*)(lds + L_KH + tok * QS + d * 2) = kh[i]; }
              v4u k0, k1; k0.x = kh[0] | ((unsigned)kh[1] << 16); k0.y = kh[2] | ((unsigned)kh[3] << 16); k0.z = kh[4] | ((unsigned)kh[5] << 16); k0.w = kh[6] | ((unsigned)kh[7] << 16);
              k1.x = kh[8] | ((unsigned)kh[9] << 16); k1.y = kh[10] | ((unsigned)kh[11] << 16); k1.z = kh[12] | ((unsigned)kh[13] << 16); k1.w = kh[14] | ((unsigned)kh[15] << 16);
              *(LAS v4u*)(lds + L_KT + d * TSB + jq * 32) = k0; *(LAS v4u*)(lds + L_KT + d * TSB + jq * 32 + 16) = k1; }
            { const int jv = tid & 63;
#pragma unroll
              for (int i = 0; i < 4; ++i) { const unsigned wv[4] = {vv[i].x, vv[i].y, vv[i].z, vv[i].w};
#pragma unroll
                  for (int e = 0; e < 4; ++e) { LAS unsigned char* p = lds + L_VT + (32 * wave + 8 * i + 2 * e) * TSB + jv * 2;
                      *(LAS unsigned short*)p = (unsigned short)(wv[e] & 0xffffu); *(LAS unsigned short*)(p + TSB) = (unsigned short)(wv[e] >> 16); } } }
            __syncthreads();
#pragma unroll
            for (int dt = 0; dt < 8; ++dt) { const f32x4 dv = *(const LAS f32x4*)(lds + L_DL + (16 * dt + 4 * fq) * 4); S[dt][0] = S[dt][0] * dv; S[dt][1] = S[dt][1] * dv; }
            if (want_out) {
                f32x4 O[2][4];
#pragma unroll
                for (int tt = 0; tt < 2; ++tt) { const int idx = 2 * wave + tt, it = idx >> 2, jt = idx & 3; f32x4 a = (f32x4){0.f, 0.f, 0.f, 0.f};
                    if (jt <= it) {
#pragma unroll
                        for (int ks = 0; ks < 4; ++ks) { const bf16x8 X = *(const LAS bf16x8*)(lds + L_KH + (16 * jt + fr) * QS + (32 * ks + 8 * fq) * 2);
                            const bf16x8 Y = *(const LAS bf16x8*)(lds + L_QH + (16 * it + fr) * QS + (32 * ks + 8 * fq) * 2);
                            a = __builtin_amdgcn_mfma_f32_16x16x32_bf16(X, Y, a, 0, 0, 0); }
                        const int ii = 16 * it + fr, j0 = 16 * jt + 4 * fq;
#pragma unroll
                        for (int e = 0; e < 4; ++e) if (j0 + e > ii) a[e] = 0.f;
                    }
                    u32x2 w2; w2.x = pg8::cvt_pk_bf16(a[0], a[1]); w2.y = pg8::cvt_pk_bf16(a[2], a[3]);
                    *(LAS u32x2*)(lds + L_AL + (16 * it + fr) * TSB + (16 * jt + 4 * fq) * 2) = w2; }
                __syncthreads();
                {
                bf16x8 Xs[2][4];
#pragma unroll
                for (int vt = 0; vt < 2; ++vt)
#pragma unroll
                    for (int dp = 0; dp < 4; ++dp) Xs[vt][dp] = pack8(S[2 * dp][vt], S[2 * dp + 1][vt]);
                bf16x8 XV[2][2];
#pragma unroll
                for (int vt = 0; vt < 2; ++vt)
#pragma unroll
                    for (int js = 0; js < 2; ++js) XV[vt][js] = *(const LAS bf16x8*)(lds + L_VT + (32 * wave + 16 * vt + fr) * TSB + (32 * js + 8 * fq) * 2);
#pragma unroll
                for (int it = 0; it < 4; ++it) {
                    bf16x8 YQ[4], YA[2];
#pragma unroll
                    for (int dp = 0; dp < 4; ++dp) { const u32x2 lo = *(const LAS u32x2*)(lds + L_QH + (16 * it + fr) * QS + (32 * dp + 4 * fq) * 2);
                        const u32x2 hi = *(const LAS u32x2*)(lds + L_QH + (16 * it + fr) * QS + (32 * dp + 16 + 4 * fq) * 2);
                        YQ[dp] = __builtin_bit_cast(bf16x8, (v4u){lo.x, lo.y, hi.x, hi.y}); }
#pragma unroll
                    for (int js = 0; js < 2; ++js) YA[js] = *(const LAS bf16x8*)(lds + L_AL + (16 * it + fr) * TSB + (32 * js + 8 * fq) * 2);
#pragma unroll
                    for (int vt = 0; vt < 2; ++vt) { f32x4 o = (f32x4){0.f, 0.f, 0.f, 0.f};
#pragma unroll
                        for (int dp = 0; dp < 4; ++dp) o = __builtin_amdgcn_mfma_f32_16x16x32_bf16(Xs[vt][dp], YQ[dp], o, 0, 0, 0);
#pragma unroll
                        for (int js = 0; js < 2; ++js) o = __builtin_amdgcn_mfma_f32_16x16x32_bf16(XV[vt][js], YA[js], o, 0, 0, 0);
                        O[vt][it] = o; }
                    __builtin_amdgcn_sched_barrier(0);
                }
                }
#pragma unroll
                for (int it = 0; it < 4; ++it) { float ss = 0.f;
#pragma unroll
                    for (int vt = 0; vt < 2; ++vt) { const f32x4 o = O[vt][it]; ss += (o[0] * o[0] + o[1] * o[1]) + (o[2] * o[2] + o[3] * o[3]); }
                    ss += __shfl_xor(ss, 16); ss += __shfl_xor(ss, 32);
                    if (fq == 0) *(LAS float*)(lds + L_SSQ + (wave * 64 + 16 * it + fr) * 4) = ss; }
                __syncthreads();
#pragma unroll
                for (int it = 0; it < 4; ++it) { const int tok = 16 * it + fr; float tot = 0.f;
#pragma unroll
                    for (int w8 = 0; w8 < 8; ++w8) tot += *(const LAS float*)(lds + L_SSQ + (w8 * 64 + tok) * 4);
                    const float rstd = rsqrtf(tot * (1.0f / DV) + EPS);
                    if (tok < tokv) { const size_t row = (size_t)(rbase + tok);
#pragma unroll
                        for (int vt = 0; vt < 2; ++vt) { const int vcol = h * DV + 32 * wave + 16 * vt + 4 * fq;
                            const u32x2 r2 = *(const u32x2*)(PROJ + row * NPROJ + 2048 + vcol); const f32x4 nw = *(const f32x4*)(in[12] + jl * DM + vcol);
                            const f32x4 o = O[vt][it];
                            const float r0 = bf2f((unsigned short)(r2.x & 0xffffu)), r1 = bf2f((unsigned short)(r2.x >> 16)), r2f = bf2f((unsigned short)(r2.y & 0xffffu)), r3 = bf2f((unsigned short)(r2.y >> 16));
                            u32x2 w2; w2.x = pg8::cvt_pk_bf16(o[0] * rstd * nw[0] * pg8::silu_f(r0), o[1] * rstd * nw[1] * pg8::silu_f(r1));
                            w2.y = pg8::cvt_pk_bf16(o[2] * rstd * nw[2] * pg8::silu_f(r2f), o[3] * rstd * nw[3] * pg8::silu_f(r3));
                            *(u32x2*)(GOUT + row * DM + vcol) = w2; } }
                    __builtin_amdgcn_sched_barrier(0); }
            }
            __builtin_amdgcn_sched_barrier(0);
#pragma unroll
            for (int js = 0; js < 2; ++js)
#pragma unroll
                for (int vt = 0; vt < 2; ++vt) { const bf16x8 Yv = *(const LAS bf16x8*)(lds + L_VT + (32 * wave + 16 * vt + fr) * TSB + (32 * js + 8 * fq) * 2);
#pragma unroll
                    for (int dt = 0; dt < 8; ++dt) { const bf16x8 Xk = *(const LAS bf16x8*)(lds + L_KT + (16 * dt + fr) * TSB + (32 * js + 8 * fq) * 2);
                        S[dt][vt] = __builtin_amdgcn_mfma_f32_16x16x32_bf16(Xk, Yv, S[dt][vt], 0, 0, 0); }
                    __builtin_amdgcn_sched_barrier(0); }
            __syncthreads();
        }
        asm volatile("" : "+v"(tid)); lane = tid & 63; fr = lane & 15; fq = lane >> 4; d = tid & 127; jq = tid >> 7;
        if (phase == 0 && !samp) {
            float* dsp = DS + (size_t)(bh * 7 + sc) * DK * DV;
#pragma unroll
            for (int dt = 0; dt < 8; ++dt)
#pragma unroll
                for (int vt = 0; vt < 2; ++vt) *(f32x4*)(dsp + (size_t)(((wave * 8 + dt) * 2 + vt) * 64 + lane) * 4) = S[dt][vt];
            if (jq == 0) DSC[(size_t)(bh * 7 + sc) * DK + d] = __expf(btot);
        } else if (samp || sc == 7) {
            float* so = samp ? out + O_NGS + ((size_t)(jl * NBS + b) * NH + h) * DK * DV : out + O_NGP + ((size_t)(jl * NBP + b) * NH + h) * DK * DV;
#pragma unroll
            for (int dt = 0; dt < 8; ++dt)
#pragma unroll
                for (int vt = 0; vt < 2; ++vt)
#pragma unroll
                    for (int e = 0; e < 4; ++e) so[(size_t)(16 * dt + 4 * fq + e) * DV + 32 * wave + 16 * vt + fr] = S[dt][vt][e];
        }
    }
}

struct Args { const float* in[17]; float* out; unsigned char* ws; int ph_lo, ph_hi; };
constexpr int N_PHASES = 27;
__global__ void __launch_bounds__(NWAVES * 64, 2) mk_fwd(Args args) {
    extern __shared__ __attribute__((aligned(16))) unsigned char lds_raw[];
    LAS unsigned char* lds = (LAS unsigned char*)lds_raw;
    volatile LAS unsigned* MISC = (volatile LAS unsigned*)(lds + MISC_OFF);
    for (int u = threadIdx.x; u < (LDS_BYTES - LDSCTL_OFF) / 4; u += NWAVES * 64) ((LAS unsigned*)(lds + LDSCTL_OFF))[u] = 0u;
    __syncthreads();
    XcdBarrier bar = xcd_barrier_post((unsigned*)(args.ws + WS_CTL) + CW_BAR, MISC + 8);
    const int lo = args.ph_lo, hi = args.ph_hi;
    const int wave0 = __builtin_amdgcn_readfirstlane(threadIdx.x >> 6);
#define PH_BEGIN(k) if ((k) >= lo && (k) < hi) { int tid = wave0 * 64 + (int)__builtin_amdgcn_mbcnt_hi(~0u, __builtin_amdgcn_mbcnt_lo(~0u, 0u)); asm volatile("" : "+v"(tid)); const int lane = tid & 63, wave = wave0; \
        const int G = gridDim.x, bid = blockIdx.x; const int vcu = (G % 8 == 0) ? (bid % 8) * (G / 8) + bid / 8 : bid; const int gw = vcu * NWAVES + wave, NGW = G * NWAVES; \
        unsigned char* ws = args.ws; float* out = args.out; const float* const* in = args.in; bf16* Hb = (bf16*)(ws + WS_H); bf16* BIG = (bf16*)(ws + WS_BIG); float* Xs_ = out + O_YS; \
        (void)lane; (void)gw; (void)NGW; (void)Hb; (void)BIG; (void)Xs_; (void)in;
#define PH_END(k)   if ((k) + 1 < hi) xcd_barrier(bar); }

#define POOL_GEMM(k, L) PH_BEGIN(k) { constexpr int jl = (L) >> 1; \
        pg8::Gemm g{BIG, (const bf16*)(ws + WS_WP + jl * SZ_WP), 4 * M, 1024, 256}; pg8::PoolOrder S{G, bid}; \
        pg8::EpiRes<true> E{(L) == 0 ? in[0] : out, (L) == 0 ? in[1] : Xs_, out, in[8] + jl * DM}; \
        pg8::gemm_phase<pg8::EpiRes<true>, pg8::PoolOrder, true, true>(lds, g, S, E, tid); } PH_END(k)
#define RMS_PH(k, gain) PH_BEGIN(k) rms_phase(gw, NGW, lane, out, (gain), Hb); PH_END(k)
#define FFN1(k, L) PH_BEGIN(k) { pg8::Gemm g{Hb, (const bf16*)(ws + WS_W13 + (L) * SZ_W13), M, NG1, DM}; pg8::StaticOrder S; S.init(M, NG1, G, bid); \
        pg8::EpiSwiglu E{BIG}; pg8::gemm_phase<pg8::EpiSwiglu, pg8::StaticOrder, true, true>(lds, g, S, E, tid); } PH_END(k)
#define FFN2(k, L) PH_BEGIN(k) { pg8::Gemm g{BIG, (const bf16*)(ws + WS_W2 + (L) * SZ_W2), M, DM, FF}; pg8::StaticOrder S; S.init(M, DM, G, bid); \
        pg8::EpiRes<false> E{out, Xs_, out, nullptr}; pg8::gemm_phase<pg8::EpiRes<false>, pg8::StaticOrder, true, true>(lds, g, S, E, tid); } PH_END(k)
#define PROJ_PH(k, jl) PH_BEGIN(k) { pg8::Gemm g{Hb, (const bf16*)(ws + WS_WIN + (jl) * SZ_WIN), M, NINP, DM}; pg8::StaticOrder S; S.init(M, NINP, G, bid); \
        pg8::EpiProj E{BIG, (float*)(ws + WS_ALOW)}; pg8::gemm_phase<pg8::EpiProj, pg8::StaticOrder, true, true>(lds, g, S, E, tid); } PH_END(k)
#define WO_PH(k, jl) PH_BEGIN(k) { pg8::Gemm g{Hb, (const bf16*)(ws + WS_WO + (jl) * SZ_WO), M, DM, DM}; pg8::StaticOrder S; S.init(M, DM, G, bid); \
        pg8::EpiRes<false> E{out, Xs_, out, nullptr}; pg8::gemm_phase<pg8::EpiRes<false>, pg8::StaticOrder, true, true>(lds, g, S, E, tid); } PH_END(k)
#define GLA_PH(k, sub, jl) PH_BEGIN(k) gla_phase(lds, tid, wave, lane, G, bid, (sub), (jl), in, out, ws); PH_END(k)

#ifdef NO_GLA
#undef GLA_PH
#define GLA_PH(k, sub, jl)
#endif
#ifdef NO_GEMM
#undef POOL_GEMM
#undef FFN1
#undef FFN2
#undef PROJ_PH
#undef WO_PH
#define POOL_GEMM(k, L)
#define FFN1(k, L)
#define FFN2(k, L)
#define PROJ_PH(k, jl)
#define WO_PH(k, jl)
#endif
#ifdef ONLY_FFN1
#undef POOL_GEMM
#undef FFN2
#undef PROJ_PH
#undef WO_PH
#define POOL_GEMM(k, L)
#define FFN2(k, L)
#define PROJ_PH(k, jl)
#define WO_PH(k, jl)
#endif
    PH_BEGIN(0)
        p0_weights(lds, wave, lane, gw, NGW, in, ws);
        __syncthreads();
        pool_prep(lds, tid, wave, lane, G, bid, in[0], in[1], in[4] + 0 * DM, in[2], BIG, out + O_NPP, out + O_NPS);
    PH_END(0)
    POOL_GEMM(1, 0)
    RMS_PH(2, in[5] + 0 * DM)
    FFN1(3, 0)
    FFN2(4, 0)
    RMS_PH(5, in[4] + 1 * DM)
    PROJ_PH(6, 0)
    GLA_PH(7, 0, 0)
    GLA_PH(8, 1, 0)
    WO_PH(9, 0)
    RMS_PH(10, in[5] + 1 * DM)
    FFN1(11, 1)
    FFN2(12, 1)
    PH_BEGIN(13)
        pool_prep(lds, tid, wave, lane, G, bid, out, Xs_, in[4] + 2 * DM, in[2] + (size_t)NBS * 15 * DM, BIG, out + O_NPP + (size_t)NBP * 15 * DM, out + O_NPS + (size_t)NBS * 15 * DM);
    PH_END(13)
    POOL_GEMM(14, 2)
    RMS_PH(15, in[5] + 2 * DM)
    FFN1(16, 2)
    FFN2(17, 2)
    RMS_PH(18, in[4] + 3 * DM)
    PROJ_PH(19, 1)
    GLA_PH(20, 0, 1)
    GLA_PH(21, 1, 1)
    WO_PH(22, 1)
    RMS_PH(23, in[5] + 3 * DM)
    FFN1(24, 3)
    FFN2(25, 3)
    PH_BEGIN(26)
        final_norm_phase(gw, NGW, lane, out, in[6]);
    PH_END(26)
}

#ifndef MK_SPLIT
#define MK_SPLIT 0
#endif
extern "C" void kernel_launch(void* const* d_in, const int* in_sizes, int n_in, void* d_out, int out_size, void* d_ws, size_t ws_size, hipStream_t stream) {
    static int grid = 0;
    if (grid == 0) {
        if (n_in != 17 || (size_t)out_size != O_END || ws_size < WS_END) { fprintf(stderr, "kernel_launch: unexpected shapes (n_in %d out %d ws %zu)\n", n_in, out_size, ws_size); grid = -1; return; }
        int dev = 0, cus = 0, per_cu = 0;
        if (hipGetDevice(&dev) != hipSuccess || hipDeviceGetAttribute(&cus, hipDeviceAttributeMultiprocessorCount, dev) != hipSuccess) { grid = -1; return; }
        if (hipFuncSetAttribute((const void*)mk_fwd, hipFuncAttributeMaxDynamicSharedMemorySize, LDS_BYTES) != hipSuccess) { fprintf(stderr, "kernel_launch: hipFuncSetAttribute failed\n"); grid = -1; return; }
        if (hipOccupancyMaxActiveBlocksPerMultiprocessor(&per_cu, (const void*)mk_fwd, NWAVES * 64, LDS_BYTES) != hipSuccess || per_cu < 1) { fprintf(stderr, "kernel_launch: occupancy query failed (%d)\n", per_cu); (void)hipGetLastError(); per_cu = 1; }
        grid = cus;
        if (grid > cus * per_cu) grid = cus * per_cu;
    }
    if (grid < 0) return;
    if (hipMemsetAsync((char*)d_ws + WS_CTL, 0, CTL_ZERO_BYTES, stream) != hipSuccess) { fprintf(stderr, "kernel_launch: memset failed\n"); return; }
    Args a{};
    for (int i = 0; i < 17; ++i) a.in[i] = (const float*)d_in[i];
    a.out = (float*)d_out; a.ws = (unsigned char*)d_ws;
#if MK_SPLIT
    for (int p = 0; p < N_PHASES; ++p) { a.ph_lo = p; a.ph_hi = p + 1; hipLaunchKernelGGL(mk_fwd, dim3(grid), dim3(NWAVES * 64), LDS_BYTES, stream, a); }
#else
    a.ph_lo = 0; a.ph_hi = N_PHASES;
    void* kargs[] = {&a};
    hipError_t e = hipLaunchCooperativeKernel((const void*)mk_fwd, dim3(grid), dim3(NWAVES * 64), kargs, LDS_BYTES, stream);
    if (e != hipSuccess) fprintf(stderr, "kernel_launch: cooperative launch failed: %s (grid %d)\n", hipGetErrorString(e), grid);
#endif
}
```

```cpp
#include <hip/hip_runtime.h>
#include <cstdio>
#include <cstdint>
namespace pg8 {
#define PG8_LAS __attribute__((address_space(3)))
typedef unsigned short bf16_t;
typedef short bf16x8 __attribute__((ext_vector_type(8)));
typedef float f32x4 __attribute__((ext_vector_type(4)));
typedef unsigned u32x4 __attribute__((ext_vector_type(4)));
constexpr int BM = 256, BK = 64, HALF = 128, HTB = HALF * BK * 2  , STAGE_BYTES = 8 * HTB, NXCD = 8, WGM = 8;

__host__ __device__ __forceinline__ int lds_byte(int r, int c) { const int st = (r >> 4) * 2 + (c >> 5), rr = r & 15, cc = c & 31, ob = rr * 64 + cc * 2; return st * 1024 + (ob ^ (((ob >> 9) & 1) << 5)); }
__host__ __device__ __forceinline__ void stage_rc(int b, int& R, int& C) { const int st = b / 1024, sb = b % 1024, swz = sb ^ (((sb >> 9) & 1) << 5); R = (st >> 1) * 16 + swz / 64; C = (st & 1) * 32 + (swz % 64) / 2; }
__host__ __device__ __forceinline__ int perm32(int rho) { const int n = rho >> 4, i = rho & 15; return 8 * (i >> 2) + 4 * n + (i & 3); }

struct Unit { int pm, pn, k0, nt, part; };
struct Gemm { const bf16_t* A; const bf16_t* Bt; int M, N, K; };

struct StaticOrder {
    int nM, nN, nwg, G, c, ntk;
    __host__ __device__ void init(int M, int N, int G_, int c_, int K_) { nM = M / BM; nN = N / BM; nwg = nM * nN; G = G_; c = c_; ntk = K_ / BK; }
    __host__ __device__ bool next(int i, Unit& u) const {
        const long L = (long)i * G + c; if (L >= nwg) return false;
        int wgid = (int)L; { const int q = nwg / NXCD, r = nwg % NXCD, xcd = wgid % NXCD, off = wgid / NXCD; wgid = (xcd < r ? xcd * (q + 1) : r * (q + 1) + (xcd - r) * q) + off; }
        const int nig = WGM * nN, gid = wgid / nig, fm = gid * WGM, gsz = (nM - fm) < WGM ? (nM - fm) : WGM;
        u.pm = fm + ((wgid % nig) % gsz); u.pn = (wgid % nig) / gsz; u.k0 = 0; u.nt = ntk; u.part = 0; return true;
    }
    __device__ __forceinline__ void a_ready(const Unit&) const {}
    __device__ __forceinline__ void done(const Unit&) const {}
};

__device__ __forceinline__ unsigned cvt_pk_bf16(float lo, float hi) { unsigned r; asm volatile("v_cvt_pk_bf16_f32 %0, %1, %2" : "=v"(r) : "v"(lo), "v"(hi)); return r; }
typedef float f32x2 __attribute__((ext_vector_type(2)));
typedef unsigned u32x2 __attribute__((ext_vector_type(2)));
__device__ __forceinline__ float silu_f(float x) { return x * __builtin_amdgcn_rcpf(1.0f + __expf(-x)); }
constexpr int P_DM = 1024, P_FF = 2816, P_NT = 68  , P_PROJ = 3072;

struct EpiSwiglu {
    static constexpr bool PERM = true, AFTER_DRAIN = false;
    bf16_t* U;
    __device__ __forceinline__ void operator()(const f32x4 (&acc)[2][2][4][2], const Unit& u, int wr, int wc, int fr, int fq) const {
        const int row0 = u.pm * BM + wr * 64 + fr, col0 = u.pn * 128 + wc * 32 + 8 * fq;
#pragma unroll
        for (int ai = 0; ai < 2; ++ai)
#pragma unroll
            for (int m = 0; m < 4; ++m) { bf16_t* rowp = U + (size_t)(row0 + ai * HALF + m * 16) * P_FF + col0;
                const f32x4 g0 = acc[ai][0][m][0], g1 = acc[ai][0][m][1], u0 = acc[ai][1][m][0], u1 = acc[ai][1][m][1];
                u32x4 w; w.x = cvt_pk_bf16(silu_f(g0[0]) * u0[0], silu_f(g0[1]) * u0[1]); w.y = cvt_pk_bf16(silu_f(g0[2]) * u0[2], silu_f(g0[3]) * u0[3]);
                w.z = cvt_pk_bf16(silu_f(g1[0]) * u1[0], silu_f(g1[1]) * u1[1]); w.w = cvt_pk_bf16(silu_f(g1[2]) * u1[2], silu_f(g1[3]) * u1[3]);
                *(u32x4*)rowp = w; }
    }
};
struct EpiProj {
    static constexpr bool PERM = true, AFTER_DRAIN = false;
    bf16_t* P; float* AL;
    __device__ __forceinline__ void operator()(const f32x4 (&acc)[2][2][4][2], const Unit& u, int wr, int wc, int fr, int fq) const {
        const int row0 = u.pm * BM + wr * 64 + fr;
        if (u.pn < 12) {
            const float sc = u.pn < 2 ? 0.08838834764831845f : 1.0f;
            const int col0 = u.pn * BM + wc * 32 + 8 * fq;
#pragma unroll
            for (int ai = 0; ai < 2; ++ai)
#pragma unroll
                for (int m = 0; m < 4; ++m) { bf16_t* rowp = P + (size_t)(row0 + ai * HALF + m * 16) * P_PROJ + col0;
#pragma unroll
                    for (int bj = 0; bj < 2; ++bj) { const f32x4 v0 = acc[ai][bj][m][0] * sc, v1 = acc[ai][bj][m][1] * sc;
                        u32x4 w; w.x = cvt_pk_bf16(v0[0], v0[1]); w.y = cvt_pk_bf16(v0[2], v0[3]); w.z = cvt_pk_bf16(v1[0], v1[1]); w.w = cvt_pk_bf16(v1[2], v1[3]);
                        *(u32x4*)(rowp + bj * HALF) = w; } }
        } else if (wc == 0 && fq < 2) {
#pragma unroll
            for (int ai = 0; ai < 2; ++ai)
#pragma unroll
                for (int m = 0; m < 4; ++m) { float* rowp = AL + (size_t)(row0 + ai * HALF + m * 16) * 16 + 8 * fq;
                    *(f32x4*)rowp = acc[ai][0][m][0]; *(f32x4*)(rowp + 4) = acc[ai][0][m][1]; }
        }
    }
};
template <bool POOL> struct EpiRes {
    static constexpr bool PERM = false, AFTER_DRAIN = false;
    const float* bp; const float* bs; float* out; const float* scale;
    __device__ __forceinline__ void operator()(const f32x4 (&acc)[2][2][4][2], const Unit& u, int wr, int wc, int fr, int fq) const {
        const int pm = POOL ? (u.pm - P_NT * u.pn) : u.pm, pn = u.pn;
        const float* base = pm < 64 ? bp + (size_t)pm * BM * P_DM : bs + (size_t)(pm - 64) * BM * P_DM;
        float* o = out + (size_t)pm * BM * P_DM;
        int frq = fr + 16 * fq; asm volatile("" : "+v"(frq));
        const unsigned col0 = (unsigned)(pn * BM + wc * 32 + 4 * (frq >> 4));
        const unsigned roff = (unsigned)(wr * 64 + (frq & 15)) * P_DM + col0;
#pragma unroll
        for (int ai = 0; ai < 2; ++ai)
#pragma unroll
            for (int m = 0; m < 4; ++m) { const unsigned off = roff + (unsigned)(ai * HALF + m * 16) * P_DM;
#pragma unroll
                for (int bj = 0; bj < 2; ++bj)
#pragma unroll
                    for (int n = 0; n < 2; ++n) { f32x4 a = acc[ai][bj][m][n]; if (POOL) a = a * *(const f32x4*)(scale + col0 + bj * HALF + n * 16);
                        const f32x4 b = *(const f32x4*)(base + off + bj * HALF + n * 16); *(f32x4*)(o + off + bj * HALF + n * 16) = a + b; } }
    }
};
struct PoolOrder {
    int G, c;
    __device__ bool next(int i, Unit& u) const { const int L = i * G + c; if (L >= 4 * P_NT) return false; const int g = L & 3, pm = L >> 2; u.pm = g * P_NT + pm; u.pn = g; u.k0 = 0; u.nt = 4; u.part = 0; return true; }
    __device__ __forceinline__ void a_ready(const Unit&) const {}
    __device__ __forceinline__ void done(const Unit&) const {}
};
struct PanelOrder {
    int G, c, ntk;
    __device__ bool next(int i, Unit& u) const {
        const int L = i * G + c; if (L >= 256) return false;
        const int x = L & 7, idx = L >> 3; u.pm = x * 8 + (idx >> 2); u.pn = idx & 3; u.k0 = 0; u.nt = ntk; u.part = 0; return true;
    }
    __device__ __forceinline__ void a_ready(const Unit&) const {}
    __device__ __forceinline__ void done(const Unit&) const {}
};
template <class Epi, class Sched, bool ALIGN_EPI = false, bool SP2 = false>
__device__ __forceinline__ void gemm_phase(PG8_LAS unsigned char* lds, const Gemm g, const Sched& S, const Epi& E, const int tid_in) {
    int tid_raw = tid_in; asm volatile("" : "+v"(tid_raw));
    const int tid = tid_raw, wid = __builtin_amdgcn_readfirstlane(tid >> 6), lane = tid & 63, wr = wid >> 2, wc = wid & 3, fr = lane & 15, fq = lane >> 4;
    const int K = g.K;
    unsigned voffA[2], voffB[2];
#pragma unroll
    for (int i = 0; i < 2; ++i) { int R, C; stage_rc(tid * 16 + i * 8192, R, C); const int Rb = Epi::PERM ? ((R & ~31) + perm32(R & 31)) : R;
        voffA[i] = (unsigned)(R * K + C) * 2u; voffB[i] = (unsigned)(Rb * K + C) * 2u; }
    const size_t kstep = (size_t)(BK * 2);
    const size_t hstep = (size_t)HALF * K * 2;
    const size_t tstep = 2 * hstep;
    const unsigned ldsw = (unsigned)wid * 1024u;
    const int aoff = lds_byte(wr * 64 + fr, fq * 8), boff = lds_byte(wc * 32 + fr, fq * 8);
#define PG8_SA(b, h) (((b) * 2 + (h)) * HTB)
#define PG8_SB(b, h) ((4 + (b) * 2 + (h)) * HTB)
#define PG8_STAGE(bufoff, gbase, voff) do { _Pragma("unroll") for (int _i = 0; _i < 2; ++_i) \
        __builtin_amdgcn_global_load_lds((const unsigned*)((const char*)(gbase) + (voff)[_i]), (PG8_LAS unsigned*)(lds + (bufoff) + ldsw + _i * 8192), 16, 0, 0); } while (0)
#define PG8_LDA(dst, b, h) do { _Pragma("unroll") for (int m = 0; m < 4; ++m) _Pragma("unroll") for (int k = 0; k < 2; ++k) dst[m][k] = *(const PG8_LAS bf16x8*)(lds + PG8_SA(b, h) + aoff + m * 2048 + k * 1024); } while (0)
#define PG8_LDB(dst, b, h) do { _Pragma("unroll") for (int n = 0; n < 2; ++n) _Pragma("unroll") for (int k = 0; k < 2; ++k) dst[n][k] = *(const PG8_LAS bf16x8*)(lds + PG8_SB(b, h) + boff + n * 2048 + k * 1024); } while (0)
#define PG8_MMA(ai, bj, At, Bt) do { __builtin_amdgcn_s_setprio(1); _Pragma("unroll") for (int m = 0; m < 4; ++m) _Pragma("unroll") for (int n = 0; n < 2; ++n) _Pragma("unroll") for (int k = 0; k < 2; ++k) \
        acc[ai][bj][m][n] = __builtin_amdgcn_mfma_f32_16x16x32_bf16(Bt[n][k], At[m][k], acc[ai][bj][m][n], 0, 0, 0); __builtin_amdgcn_s_setprio(0); } while (0)
#define PG8_WAIT_V(n) asm volatile("s_waitcnt vmcnt(" #n ")" ::: "memory")
#define PG8_WAIT_L(n) asm volatile("s_waitcnt lgkmcnt(" #n ")" ::: "memory")
#define PG8_BAR __builtin_amdgcn_s_barrier()
#define PG8_SCHED __builtin_amdgcn_sched_barrier(0)
    Unit cur, nxt; int ui = 0;
    if (!S.next(0, cur)) return;
    f32x4 acc[2][2][4][2];
#pragma unroll
    for (int a = 0; a < 2; ++a)
#pragma unroll
        for (int b = 0; b < 2; ++b)
#pragma unroll
            for (int m = 0; m < 4; ++m)
#pragma unroll
                for (int n = 0; n < 2; ++n) acc[a][b][m][n] = (f32x4){0.f, 0.f, 0.f, 0.f};
    bf16x8 At[4][2], B0[2][2], B1[2][2];
    const char* cA = (const char*)g.A + (size_t)cur.pm * tstep + (size_t)cur.k0 * 2; const char* cB = (const char*)g.Bt + (size_t)cur.pn * tstep + (size_t)cur.k0 * 2;
    S.a_ready(cur);
    if constexpr (SP2) {
        PG8_STAGE(PG8_SB(0, 0), cB, voffB); PG8_STAGE(PG8_SB(0, 1), cB + hstep, voffB); PG8_STAGE(PG8_SA(0, 0), cA, voffA); PG8_STAGE(PG8_SA(0, 1), cA + hstep, voffA);
        if (wr == 1) PG8_BAR;
        PG8_WAIT_V(2); PG8_BAR;
        PG8_STAGE(PG8_SB(1, 0), cB + kstep, voffB); PG8_STAGE(PG8_SA(1, 0), cA + kstep, voffA); PG8_STAGE(PG8_SB(1, 1), cB + hstep + kstep, voffB);
        PG8_WAIT_V(6); PG8_BAR;
    } else {
        PG8_STAGE(PG8_SB(0, 0), cB, voffB); PG8_STAGE(PG8_SA(0, 0), cA, voffA); PG8_STAGE(PG8_SB(0, 1), cB + hstep, voffB); PG8_STAGE(PG8_SA(0, 1), cA + hstep, voffA);
        if (wr == 1) PG8_BAR;
        PG8_WAIT_V(4); PG8_BAR;
        PG8_STAGE(PG8_SB(1, 0), cB + kstep, voffB); PG8_STAGE(PG8_SA(1, 0), cA + kstep, voffA); PG8_STAGE(PG8_SB(1, 1), cB + hstep + kstep, voffB);
        PG8_WAIT_V(6); PG8_BAR;
    }
    for (;;) {
        const bool has_next = S.next(ui + 1, nxt);
        const char* nA = has_next ? (const char*)g.A + (size_t)nxt.pm * tstep + (size_t)nxt.k0 * 2 : cA; const char* nB = has_next ? (const char*)g.Bt + (size_t)nxt.pn * tstep + (size_t)nxt.k0 * 2 : cB;
        const int nt = cur.nt;
        for (int t = 0; t < nt; t += 2) {
            const bool last = (t == nt - 2);
            const char* a1 = cA + (size_t)(t + 1) * kstep;
            const char* a2 = last ? nA : cA + (size_t)(t + 2) * kstep; const char* b2 = last ? nB : cB + (size_t)(t + 2) * kstep;
            const char* a3 = a2 + kstep; const char* b3 = b2 + kstep;
            if (last && has_next) S.a_ready(nxt);
            if constexpr (SP2) {
            PG8_LDB(B0, 0, 0); PG8_LDB(B1, 0, 1); PG8_SCHED; PG8_LDA(At, 0, 0); PG8_STAGE(PG8_SA(1, 1), a1 + hstep, voffA);
            PG8_WAIT_V(8); PG8_WAIT_L(0); PG8_BAR; PG8_MMA(0, 0, At, B0); PG8_MMA(0, 1, At, B1); PG8_BAR; PG8_SCHED;
            PG8_LDA(At, 0, 1); PG8_STAGE(PG8_SB(0, 0), b2, voffB); PG8_STAGE(PG8_SB(0, 1), b2 + hstep, voffB); PG8_STAGE(PG8_SA(0, 0), a2, voffA);
            PG8_WAIT_V(8); PG8_WAIT_L(0); PG8_BAR; PG8_MMA(1, 0, At, B0); PG8_MMA(1, 1, At, B1); PG8_BAR; PG8_SCHED;
            PG8_LDB(B0, 1, 0); PG8_LDB(B1, 1, 1); PG8_SCHED; PG8_LDA(At, 1, 0); PG8_STAGE(PG8_SA(0, 1), a2 + hstep, voffA);
            PG8_WAIT_V(8); PG8_WAIT_L(0); PG8_BAR; PG8_MMA(0, 0, At, B0); PG8_MMA(0, 1, At, B1); PG8_BAR; PG8_SCHED;
            PG8_LDA(At, 1, 1); PG8_STAGE(PG8_SB(1, 0), b3, voffB); PG8_STAGE(PG8_SB(1, 1), b3 + hstep, voffB); PG8_STAGE(PG8_SA(1, 0), a3, voffA);
            PG8_WAIT_V(8); PG8_WAIT_L(0); PG8_BAR; PG8_MMA(1, 0, At, B0); PG8_MMA(1, 1, At, B1); PG8_BAR; PG8_SCHED;
            } else {
            PG8_LDB(B0, 0, 0); PG8_SCHED; PG8_LDA(At, 0, 0); PG8_STAGE(PG8_SA(1, 1), a1 + hstep, voffA);
            PG8_WAIT_L(8); PG8_BAR; PG8_WAIT_L(0); PG8_MMA(0, 0, At, B0); PG8_BAR; PG8_SCHED;
            PG8_LDB(B1, 0, 1); PG8_STAGE(PG8_SB(0, 0), b2, voffB);
            PG8_BAR; PG8_WAIT_L(0); PG8_MMA(0, 1, At, B1); PG8_BAR;
            PG8_LDA(At, 0, 1); PG8_STAGE(PG8_SA(0, 0), a2, voffA);
            PG8_BAR; PG8_WAIT_L(0); PG8_MMA(1, 0, At, B0); PG8_BAR; PG8_SCHED;
            PG8_STAGE(PG8_SB(0, 1), b2 + hstep, voffB);
            PG8_WAIT_V(6); PG8_BAR; PG8_MMA(1, 1, At, B1); PG8_BAR;
            PG8_LDB(B0, 1, 0); PG8_SCHED; PG8_LDA(At, 1, 0); PG8_STAGE(PG8_SA(0, 1), a2 + hstep, voffA);
            PG8_WAIT_L(8); PG8_BAR; PG8_WAIT_L(0); PG8_MMA(0, 0, At, B0); PG8_BAR; PG8_SCHED;
            PG8_LDB(B1, 1, 1); PG8_STAGE(PG8_SB(1, 0), b3, voffB);
            PG8_BAR; PG8_WAIT_L(0); PG8_MMA(0, 1, At, B1); PG8_BAR;
            PG8_LDA(At, 1, 1); PG8_STAGE(PG8_SA(1, 0), a3, voffA);
            PG8_BAR; PG8_WAIT_L(0); PG8_MMA(1, 0, At, B0); PG8_BAR; PG8_SCHED;
            PG8_STAGE(PG8_SB(1, 1), b3 + hstep, voffB);
            PG8_WAIT_V(6); PG8_BAR; PG8_MMA(1, 1, At, B1); PG8_BAR;
            }
        }
        if constexpr (ALIGN_EPI) { if (wr == 0) PG8_BAR; }
        if constexpr (!Epi::AFTER_DRAIN) { E(acc, cur, wr, wc, fr, fq); S.done(cur); }
        if (!has_next) break;
#pragma unroll
        for (int a = 0; a < 2; ++a)
#pragma unroll
            for (int b = 0; b < 2; ++b)
#pragma unroll
                for (int m = 0; m < 4; ++m)
#pragma unroll
                    for (int n = 0; n < 2; ++n) acc[a][b][m][n] = (f32x4){0.f, 0.f, 0.f, 0.f};
        cur = nxt; cA = nA; cB = nB; ++ui;
        if constexpr (ALIGN_EPI) { if (wr == 1) PG8_BAR; }
    }
    PG8_WAIT_V(0);
    if constexpr (!ALIGN_EPI) { if (wr == 0) PG8_BAR; }
    PG8_BAR;
    if constexpr (Epi::AFTER_DRAIN) { E.fused(acc, cur, wr, wc, fr, fq, lds, wid, lane); S.done(cur); }
#undef PG8_SA
#undef PG8_SB
#undef PG8_STAGE
#undef PG8_LDA
#undef PG8_LDB
#undef PG8_MMA
#undef PG8_WAIT_V
#undef PG8_WAIT_L
#undef PG8_BAR
#undef PG8_SCHED
}
}
#define GAS __attribute__((address_space(1)))
#define LAS __attribute__((address_space(3)))
typedef unsigned short bf16;
typedef unsigned v4u __attribute__((ext_vector_type(4)));
typedef float f32x4 __attribute__((ext_vector_type(4)));
typedef short bf16x8 __attribute__((ext_vector_type(8)));
typedef GAS unsigned gu32;
typedef GAS unsigned long long gu64;
#define RLX_AGENT __ATOMIC_RELAXED, __HIP_MEMORY_SCOPE_AGENT
#define LDS_WAIT() asm volatile("s_waitcnt lgkmcnt(0)" ::: "memory")
#define VM_WAIT() asm volatile("s_waitcnt vmcnt(0)" ::: "memory")
__device__ __forceinline__ unsigned long long rt() { return __builtin_amdgcn_s_memrealtime(); }
__device__ __forceinline__ unsigned f2bf(float f) { unsigned u = __builtin_bit_cast(unsigned, f); return (u + 0x7fffu + ((u >> 16) & 1u)) >> 16; }
__device__ __forceinline__ unsigned pk2(float lo, float hi) { return f2bf(lo) | (f2bf(hi) << 16); }

#define XB_TMO      128
#define XB_XCNT(j)  (256  + 64 * (j))
#define XB_XSUB(j)  (1280 + 64 * (j))
#define XB_XGEN(j)  (2304 + 64 * (j))
#define XB_TOP      3328
#define XB_TOPGEN   3392
#define XCD_BAR_WORDS 3456
#define XB_SPIN_CAP (1u << 18)

__device__ __forceinline__ unsigned xb_ld(unsigned* p)              { return __hip_atomic_load(p, __ATOMIC_RELAXED, __HIP_MEMORY_SCOPE_AGENT); }
__device__ __forceinline__ unsigned xb_add(unsigned* p, unsigned v) { return __hip_atomic_fetch_add(p, v, __ATOMIC_RELAXED, __HIP_MEMORY_SCOPE_AGENT); }
__device__ __forceinline__ unsigned xb_xcc_id() { return (unsigned)__builtin_amdgcn_s_getreg((3 << 11) | 20) & 0xFu; }
#define XB_SPIN(cond, bar) do { unsigned _sp = 0; while (cond) { __builtin_amdgcn_s_sleep(1); \
    if ((++_sp & 255u) == 0u) { if (xb_ld(&(bar)[XB_TMO])) break; if (_sp > XB_SPIN_CAP) { atomicAdd(&(bar)[XB_TMO], 1u); break; } } } } while (0)

struct XcdBarrier {
    unsigned* bar; unsigned x;
    volatile LAS unsigned* st;
};

__device__ __forceinline__ XcdBarrier xcd_barrier_post(unsigned* bar, volatile LAS unsigned* st) {
    XcdBarrier b; b.bar = bar; b.x = xb_xcc_id(); b.st = st;
    if (threadIdx.x == 0) (void)xb_add(&bar[XB_XCNT(b.x)], 1u);
    return b;
}
__device__ __forceinline__ void xcd_barrier_complete(unsigned* bar, unsigned x, unsigned& nloc, unsigned& nx) {
    const unsigned G = gridDim.x * gridDim.y * gridDim.z;
    unsigned sum, cnt, mine, sp = 0u;
    for (;;) {
        sum = 0u; cnt = 0u; mine = 0u;
#pragma unroll
        for (unsigned j = 0; j < 16; ++j) { const unsigned c = xb_ld(&bar[XB_XCNT(j)]); sum += c; cnt += (c > 0u) ? 1u : 0u; mine = (j == x) ? c : mine; }
        if (sum == G) break;
        __builtin_amdgcn_s_sleep(1);
        if ((++sp & 255u) == 0u) { if (xb_ld(&bar[XB_TMO])) break; if (sp > XB_SPIN_CAP) { atomicAdd(&bar[XB_TMO], 1u); break; } }
    }
    nloc = mine > 0u ? mine : 1u; nx = cnt > 0u ? cnt : 1u;
}

__device__ __forceinline__ void xcd_barrier(const XcdBarrier& b) {
    asm volatile("s_waitcnt vmcnt(0)" ::: "memory");
    __syncthreads();
    if (threadIdx.x == 0) {
        unsigned* bar = b.bar;
        __builtin_amdgcn_s_waitcnt(0);
        unsigned nloc = b.st[0], nx = b.st[1];
        if (nloc == 0u) { xcd_barrier_complete(bar, b.x, nloc, nx); b.st[0] = nloc; b.st[1] = nx; }
        const unsigned old = xb_add(&bar[XB_XSUB(b.x)], 1u);
        const unsigned gen = old / nloc;
        if (old + 1u == (gen + 1u) * nloc) {
            __builtin_amdgcn_fence(__ATOMIC_RELEASE, "agent");
            asm volatile("s_waitcnt vmcnt(0)" ::: "memory");
            const unsigned og = xb_add(&bar[XB_TOP], 1u);
            const unsigned tg = og / nx;
            if (og + 1u == (tg + 1u) * nx) xb_add(&bar[XB_TOPGEN], 1u);
            else XB_SPIN(xb_ld(&bar[XB_TOPGEN]) == tg, bar);
            __builtin_amdgcn_fence(__ATOMIC_ACQUIRE, "agent");
            xb_add(&bar[XB_XGEN(b.x)], 1u);
            asm volatile("s_waitcnt vmcnt(0)" ::: "memory");
        } else {
            XB_SPIN(xb_ld(&bar[XB_XGEN(b.x)]) == gen, bar);
            __builtin_amdgcn_fence(__ATOMIC_ACQUIRE, "agent");
            asm volatile("s_waitcnt vmcnt(0)" ::: "memory");
        }
    }
    __syncthreads();
}
constexpr int NWAVES = 8;
constexpr int DM = 1024, TP = 2048, NBP = 8, MP = NBP * TP, NBS = 128, TS = 8, MS = NBS * TS, M = MP + MS, FF = 2816, NG1 = 2 * FF;
constexpr int NIN = 3088, NINP = 3328, NPROJ = 3072, DK = 128, DV = 256, NH = 4;
constexpr float EPS = 1e-6f;
static_assert(M == 68 * 256, "row tiles");
constexpr size_t O_YP = 0, O_YS = (size_t)MP * DM, O_NPP = O_YS + (size_t)MS * DM, O_NGP = O_NPP + (size_t)2 * NBP * 15 * DM, O_NPS = O_NGP + (size_t)2 * NBP * NH * DK * DV,
                 O_NGS = O_NPS + (size_t)2 * NBS * 15 * DM, O_END = O_NGS + (size_t)2 * NBS * NH * DK * DV;
constexpr size_t MiB = 1u << 20;
constexpr size_t WS_CTL = 0, CTL_ZERO_BYTES = 1 * MiB;
constexpr size_t SZ_W13 = (size_t)NG1 * DM * 2, SZ_W2 = (size_t)DM * FF * 2, SZ_WIN = (size_t)NINP * DM * 2, SZ_WO = (size_t)DM * DM * 2, SZ_WP = (size_t)4 * 256 * 256 * 2;
constexpr size_t WS_W13 = 1 * MiB, WS_W2 = WS_W13 + 4 * SZ_W13, WS_WIN = WS_W2 + 4 * SZ_W2, WS_WO = WS_WIN + 2 * SZ_WIN, WS_WP = WS_WO + 2 * SZ_WO;
constexpr size_t WS_H = WS_WP + 2 * SZ_WP;
constexpr size_t WS_BIG = WS_H + (size_t)M * DM * 2;
constexpr size_t WS_ALOW = WS_BIG + (size_t)M * NPROJ * 2;
constexpr size_t WS_DS = WS_ALOW + (size_t)M * 16 * 4;
constexpr size_t WS_DSC = WS_DS + (size_t)32 * 7 * DK * DV * 4;
constexpr size_t WS_END = WS_DSC + (size_t)32 * 7 * DK * 4;
static_assert(WS_END <= 256 * MiB, "d_ws map");
static_assert(WS_H % 256 == 0 && WS_BIG % 256 == 0 && WS_ALOW % 256 == 0 && WS_DS % 256 == 0 && WS_DSC % 256 == 0, "alignment");
constexpr int CW_BAR = 4096;
constexpr int RING_BYTES = 131072, LDSCTL_OFF = RING_BYTES, MISC_OFF = LDSCTL_OFF + 320, LDS_BYTES = 147456;

__device__ __forceinline__ float wave_sum(float v) {
#pragma unroll
    for (int o = 1; o < 64; o <<= 1) v += __shfl_xor(v, o);
    return v;
}
__device__ __forceinline__ float bf2f(unsigned short b) { return __builtin_bit_cast(float, (unsigned)b << 16); }

__device__ __forceinline__ void tr_item(const float* W, int K, int N, bf16* WT, int mode, int row_off, LAS float* scr, int item, int lane) {
    const int nblk = (N + 31) >> 5, kb = item / nblk, nb = item - kb * nblk, k0 = 64 * kb, n0 = 32 * nb;
    const int nn = n0 + (lane & 31); const bool ok = nn < N;
    float wv[32];
#pragma unroll
    for (int i = 0; i < 32; ++i) { const int kk = 2 * i + (lane >> 5); wv[i] = ok ? W[(size_t)(k0 + kk) * N + nn] : 0.f; }
#pragma unroll
    for (int i = 0; i < 32; ++i) { const int kk = 2 * i + (lane >> 5); scr[kk * 33 + (lane & 31)] = wv[i]; }
    LDS_WAIT(); asm volatile("" ::: "memory");
    const int c = lane & 7;
#pragma unroll
    for (int j = 0; j < 4; ++j) { const int n = (lane >> 3) + 8 * j; const LAS float* s = scr + (8 * c) * 33 + n;
        v4u o; o.x = pk2(s[0 * 33], s[1 * 33]); o.y = pk2(s[2 * 33], s[3 * 33]); o.z = pk2(s[4 * 33], s[5 * 33]); o.w = pk2(s[6 * 33], s[7 * 33]);
        const int ng = n0 + n; const int row = mode ? (((ng >> 7) << 8) + (ng & 127) + row_off) : (row_off + ng);
        *(v4u*)(WT + (size_t)row * K + k0 + 8 * c) = o; }
    LDS_WAIT(); asm volatile("" ::: "memory");
}
__device__ __forceinline__ void p0_weights(LAS unsigned char* lds, int wave, int lane, int gw, int NGW, const float* const* in, unsigned char* ws) {
    LAS float* scr = (LAS float*)(lds + wave * 16384);
    constexpr int I_W1 = (DM / 64) * (FF / 32), I_W2 = (FF / 64) * (DM / 32), I_WIN = (DM / 64) * ((NIN + 31) / 32), I_WO = (DM / 64) * (DM / 32), I_WP = (256 / 64) * (256 / 32);
    constexpr int N_FFN = 4 * (2 * I_W1 + I_W2), N_GLA = 2 * (I_WIN + I_WO), N_POOL = 8 * I_WP, NITEMS = N_FFN + N_GLA + N_POOL;
    for (int it = gw; it < NITEMS; it += NGW) {
        int r = it;
        if (r < N_FFN) { const int L = r / (2 * I_W1 + I_W2); r -= L * (2 * I_W1 + I_W2);
            if (r < I_W1) { tr_item(in[14] + (size_t)L * DM * FF, DM, FF, (bf16*)(ws + WS_W13 + L * SZ_W13), 1, 0, scr, r, lane); continue; } r -= I_W1;
            if (r < I_W1) { tr_item(in[15] + (size_t)L * DM * FF, DM, FF, (bf16*)(ws + WS_W13 + L * SZ_W13), 1, 128, scr, r, lane); continue; } r -= I_W1;
            tr_item(in[16] + (size_t)L * FF * DM, FF, DM, (bf16*)(ws + WS_W2 + L * SZ_W2), 0, 0, scr, r, lane); continue; }
        r -= N_FFN;
        if (r < N_GLA) { const int L = r / (I_WIN + I_WO); r -= L * (I_WIN + I_WO);
            if (r < I_WIN) { tr_item(in[9] + (size_t)L * DM * NIN, DM, NIN, (bf16*)(ws + WS_WIN + L * SZ_WIN), 0, 0, scr, r, lane); continue; } r -= I_WIN;
            tr_item(in[13] + (size_t)L * DM * DM, DM, DM, (bf16*)(ws + WS_WO + L * SZ_WO), 0, 0, scr, r, lane); continue; }
        r -= N_GLA;
        { const int jg = r / I_WP; r -= jg * I_WP;
          tr_item(in[7] + (size_t)jg * 65536, 256, 256, (bf16*)(ws + WS_WP + (jg >> 2) * SZ_WP), 0, (jg & 3) * 256, scr, r, lane); }
    }
    constexpr int PADV = (NINP - 3104) * DM * 2 / 16;
    for (int i = gw * 64 + lane; i < 2 * PADV; i += NGW * 64) { const int L = i / PADV, e = i - L * PADV;
        ((v4u*)(ws + WS_WIN + L * SZ_WIN + (size_t)3104 * DM * 2))[e] = (v4u){0u, 0u, 0u, 0u}; }
}

__device__ __forceinline__ void rms_row_bf16(const float* xrow, const float* g, bf16* orow, int lane) {
    const f32x4* xr = (const f32x4*)xrow + lane; const f32x4* gr = (const f32x4*)g + lane;
    f32x4 v[4]; float s = 0.f;
#pragma unroll
    for (int j = 0; j < 4; ++j) { v[j] = xr[64 * j]; s += (v[j].x * v[j].x + v[j].y * v[j].y) + (v[j].z * v[j].z + v[j].w * v[j].w); }
    const float rstd = rsqrtf(wave_sum(s) * (1.f / DM) + EPS);
    unsigned long long* o8 = (unsigned long long*)orow + lane;
#pragma unroll
    for (int j = 0; j < 4; ++j) { const f32x4 gg = gr[64 * j]; const f32x4 y = v[j] * rstd * gg;
        o8[64 * j] = (unsigned long long)pk2(y.x, y.y) | ((unsigned long long)pk2(y.z, y.w) << 32); }
}
__device__ __forceinline__ void rms_phase(int gw, int NGW, int lane, const float* X, const float* g, bf16* H) {
    for (int m = gw; m < M; m += NGW) rms_row_bf16(X + (size_t)m * DM, g, H + (size_t)m * DM, lane);
}
__device__ __forceinline__ void final_norm_phase(int gw, int NGW, int lane, float* X, const float* g) {
    for (int m = gw; m < M; m += NGW) {
        f32x4* xr = (f32x4*)(X + (size_t)m * DM) + lane; const f32x4* gr = (const f32x4*)g + lane;
        f32x4 v[4]; float s = 0.f;
#pragma unroll
        for (int j = 0; j < 4; ++j) { v[j] = xr[64 * j]; s += (v[j].x * v[j].x + v[j].y * v[j].y) + (v[j].z * v[j].z + v[j].w * v[j].w); }
        const float rstd = rsqrtf(wave_sum(s) * (1.f / DM) + EPS);
#pragma unroll
        for (int j = 0; j < 4; ++j) xr[64 * j] = v[j] * rstd * gr[64 * j];
    }
}

__device__ __forceinline__ void small_gemm_res(LAS unsigned char* lds, const bf16* A, const bf16* Bt, int K, float* X, int tid, int wave, int G, int bid) {
    constexpr int RS = 272, BUF = 2 * 64 * RS;
    const int lane = tid & 63, fr = lane & 15, fq = lane >> 4, rt = wave & 3, ch = wave >> 2;
    const int lr = tid >> 3, lc = (tid & 7) * 16;
    const int nch = K >> 7;
    for (int L = bid; L < 256; L += G) {
        const int tm = L >> 4, tn = L & 15;
        const v4u* ag = (const v4u*)(A + (size_t)(tm * 64 + lr) * K + lc); const v4u* bg = (const v4u*)(Bt + (size_t)(tn * 64 + lr) * K + lc);
        LAS unsigned char* wa = lds + lr * RS + lc * 2; LAS unsigned char* wb = wa + 64 * RS;
        v4u pa[2], pb[2], qa[2], qb[2];
        { const v4u a0 = ag[0], a1 = ag[1], b0 = bg[0], b1 = bg[1];
          pa[0] = ag[16]; pa[1] = ag[17]; pb[0] = bg[16]; pb[1] = bg[17];
          qa[0] = ag[32]; qa[1] = ag[33]; qb[0] = bg[32]; qb[1] = bg[33];
          *(LAS v4u*)wa = a0; *(LAS v4u*)(wa + 16) = a1; *(LAS v4u*)wb = b0; *(LAS v4u*)(wb + 16) = b1; }
        __syncthreads();
        f32x4 acc0 = (f32x4){0.f, 0.f, 0.f, 0.f}, acc1 = (f32x4){0.f, 0.f, 0.f, 0.f};
#define SG_COMPUTE(bufoff) { _Pragma("unroll") for (int ks = 0; ks < 4; ++ks) { const bf16x8 a = *(const LAS bf16x8*)(lds + (bufoff) + (16 * rt + fr) * RS + (32 * ks + 8 * fq) * 2); \
            const bf16x8 b0 = *(const LAS bf16x8*)(lds + (bufoff) + 64 * RS + (32 * ch + fr) * RS + (32 * ks + 8 * fq) * 2), b1 = *(const LAS bf16x8*)(lds + (bufoff) + 64 * RS + (32 * ch + 16 + fr) * RS + (32 * ks + 8 * fq) * 2); \
            acc0 = __builtin_amdgcn_mfma_f32_16x16x32_bf16(b0, a, acc0, 0, 0, 0); acc1 = __builtin_amdgcn_mfma_f32_16x16x32_bf16(b1, a, acc1, 0, 0, 0); } }
        for (int kc = 0; kc < nch; kc += 2) {
            SG_COMPUTE(0)
            *(LAS v4u*)(wa + BUF) = pa[0]; *(LAS v4u*)(wa + BUF + 16) = pa[1]; *(LAS v4u*)(wb + BUF) = pb[0]; *(LAS v4u*)(wb + BUF + 16) = pb[1];
            if (kc + 3 < nch) { pa[0] = ag[16 * (kc + 3)]; pa[1] = ag[16 * (kc + 3) + 1]; pb[0] = bg[16 * (kc + 3)]; pb[1] = bg[16 * (kc + 3) + 1]; }
            __syncthreads();
            SG_COMPUTE(BUF)
            if (kc + 2 < nch) { *(LAS v4u*)wa = qa[0]; *(LAS v4u*)(wa + 16) = qa[1]; *(LAS v4u*)wb = qb[0]; *(LAS v4u*)(wb + 16) = qb[1]; }
            if (kc + 4 < nch) { qa[0] = ag[16 * (kc + 4)]; qa[1] = ag[16 * (kc + 4) + 1]; qb[0] = bg[16 * (kc + 4)]; qb[1] = bg[16 * (kc + 4) + 1]; }
            __syncthreads();
        }
#undef SG_COMPUTE
        float* o = X + (size_t)(tm * 64 + 16 * rt + fr) * DM + tn * 64 + 32 * ch + 4 * fq;
        *(f32x4*)o = *(const f32x4*)o + acc0; *(f32x4*)(o + 16) = *(const f32x4*)(o + 16) + acc1;
    }
    __syncthreads();
}

__device__ __forceinline__ void pool_prep(LAS unsigned char* lds, int tid, int wave, int lane, int G, int bid,
                                          const float* xp, const float* xs, const float* gmix, const float* spool, bf16* DIFF, float* onp, float* ons) {
    typedef float f32x2 __attribute__((ext_vector_type(2)));
    LAS float* hb = (LAS float*)lds;
    for (int u = bid; u < 1024 + NBS; u += G) {
        const bool pr = u < 1024; const int b = pr ? (u >> 7) : (u - 1024); const int t0 = pr ? (u & 127) * 16 : 0; const int ntok = pr ? 16 : 8;
        {
            f32x4 v[4][4]; bool has[4], donorm[4];
#pragma unroll
            for (int k = 0; k < 4; ++k) { const int r = wave + 8 * k; const float* src = nullptr; donorm[k] = true;
                if (r < 15 + ntok) {
                    if (pr) { const int t = t0 - 15 + r; if (t >= 0) src = xp + ((size_t)b * TP + t) * DM; }
                    else { if (r < 15) { src = spool + ((size_t)b * 15 + r) * DM; donorm[k] = false; } else src = xs + ((size_t)b * TS + (r - 15)) * DM; } }
                has[k] = src != nullptr;
#pragma unroll
                for (int j = 0; j < 4; ++j) v[k][j] = has[k] ? ((const f32x4*)src + lane)[64 * j] : (f32x4){0.f, 0.f, 0.f, 0.f}; }
            const f32x4* gr = (const f32x4*)gmix + lane;
#pragma unroll
            for (int k = 0; k < 4; ++k) { const int r = wave + 8 * k;
                if (r < 15 + ntok) { float s = 0.f;
#pragma unroll
                    for (int j = 0; j < 4; ++j) s += (v[k][j].x * v[k][j].x + v[k][j].y * v[k][j].y) + (v[k][j].z * v[k][j].z + v[k][j].w * v[k][j].w);
                    const float rstd = (has[k] && donorm[k]) ? rsqrtf(wave_sum(s) * (1.f / DM) + EPS) : 1.f;
                    LAS f32x4* hrow = (LAS f32x4*)(hb + r * DM) + lane;
#pragma unroll
                    for (int j = 0; j < 4; ++j) hrow[64 * j] = (has[k] && donorm[k]) ? v[k][j] * rstd * gr[64 * j] : v[k][j]; } }
        }
        __syncthreads();
        const int c = 2 * tid, gi = tid >> 7, w = 2 << gi;
        f32x2 sum = (f32x2){0.f, 0.f};
        for (int l = 1; l < w; ++l) sum += *(const LAS f32x2*)(hb + (15 - l) * DM + c);
        for (int i = 0; i < ntok; ++i) {
            const f32x2 cur = *(const LAS f32x2*)(hb + (15 + i) * DM + c); sum += cur;
            const int cnt = pr ? ((t0 + i + 1) < w ? (t0 + i + 1) : w) : w; const float inv = 1.0f / (float)cnt;
            const f32x2 d = sum * inv - cur;
            const size_t row = pr ? ((size_t)b * TP + t0 + i) : ((size_t)MP + b * TS + i);
            *(unsigned*)(DIFF + ((size_t)gi * M + row) * 256 + (c & 255)) = pk2(d.x, d.y);
            sum -= *(const LAS f32x2*)(hb + (15 + i - w + 1) * DM + c);
        }
        if (pr) { if (t0 == TP - 16) for (int i = 1; i < 16; ++i) *(f32x2*)(onp + ((size_t)b * 15 + (i - 1)) * DM + c) = *(const LAS f32x2*)(hb + (15 + i) * DM + c); }
        else for (int i = 0; i < 15; ++i) *(f32x2*)(ons + ((size_t)b * 15 + i) * DM + c) = *(const LAS f32x2*)(hb + (8 + i) * DM + c);
        __syncthreads();
    }
}

constexpr int L_QH = 0, L_KH = 17408, L_KT = 34816, L_VT = 53248, L_AL = 90112, L_ALOW = 99328, L_DL = 105472, L_SSQ = 105984, L_TOT = 108032, L_WA = 112128, L_BA = 120320, L_NW = 120832, L_GLA_END = 121856;
constexpr int QS = 272, TSB = 144;
static_assert(L_GLA_END <= RING_BYTES, "GLA LDS");
__device__ __forceinline__ bf16x8 pack8(const f32x4 a, const f32x4 b) {
    v4u w; w.x = pg8::cvt_pk_bf16(a[0], a[1]); w.y = pg8::cvt_pk_bf16(a[2], a[3]); w.z = pg8::cvt_pk_bf16(b[0], b[1]); w.w = pg8::cvt_pk_bf16(b[2], b[3]);
    return __builtin_bit_cast(bf16x8, w);
}
__device__ __forceinline__ void gla_phase(LAS unsigned char* lds, int tid, int wave, int lane, int G, int bid, int phase, int jl,
                                          const float* const* in, float* out, unsigned char* ws) {
    typedef unsigned u32x2 __attribute__((ext_vector_type(2)));
    const bf16* PROJ = (const bf16*)(ws + WS_BIG); const float* ALOW = (const float*)(ws + WS_ALOW); bf16* GOUT = (bf16*)(ws + WS_H);
    float* DS = (float*)(ws + WS_DS); float* DSC = (float*)(ws + WS_DSC);
    const int nitems = phase == 0 ? (224 + 4 * NBS) : 256;
    const int tid_in = tid;
    for (int item = bid; item < nitems; item += G) {
        int tid = tid_in; asm volatile("" : "+v"(tid));
        int lane = tid & 63, fr = lane & 15, fq = lane >> 4;
        int b, h, row0, ntok, sc = 0; bool want_out, samp = false;
        if (phase == 0) { if (item < 224) { const int bh = item / 7; sc = item - bh * 7; b = bh >> 2; h = bh & 3; row0 = b * TP + sc * 256; ntok = 256; want_out = false; }
                          else { const int q = item - 224; b = q >> 2; h = q & 3; row0 = MP + b * TS; ntok = TS; want_out = true; samp = true; } }
        else { const int bh = item >> 3; sc = item & 7; b = bh >> 2; h = bh & 3; row0 = b * TP + sc * 256; ntok = 256; want_out = true; }
        const int bh = b * 4 + h;
        f32x4 S[8][2];
#pragma unroll
        for (int dt = 0; dt < 8; ++dt)
#pragma unroll
            for (int vt = 0; vt < 2; ++vt) S[dt][vt] = (f32x4){0.f, 0.f, 0.f, 0.f};
        if (samp) {
            const float* s0 = in[3] + ((size_t)(jl * NBS + b) * NH + h) * DK * DV;
#pragma unroll
            for (int dt = 0; dt < 8; ++dt)
#pragma unroll
                for (int vt = 0; vt < 2; ++vt)
#pragma unroll
                    for (int e = 0; e < 4; ++e) S[dt][vt][e] = s0[(size_t)(16 * dt + 4 * fq + e) * DV + 32 * wave + 16 * vt + fr];
        } else if (phase == 1 && sc > 0) {
            const float* dsp = DS + (size_t)(bh * 7 + sc - 1) * DK * DV;
#pragma unroll
            for (int dt = 0; dt < 8; ++dt)
#pragma unroll
                for (int vt = 0; vt < 2; ++vt) S[dt][vt] = *(const f32x4*)(dsp + (size_t)(((wave * 8 + dt) * 2 + vt) * 64 + lane) * 4);
        }
        { const int r = tid >> 5, d4 = (tid & 31) * 4;
          *(LAS f32x4*)(lds + L_WA + (r * 128 + d4) * 4) = *(const f32x4*)(in[10] + (size_t)jl * 16 * 512 + r * 512 + h * DK + d4);
          if (tid < 32) *(LAS f32x4*)(lds + L_BA + tid * 16) = *(const f32x4*)(in[11] + jl * 512 + h * DK + tid * 4);
          if (tid < 64) *(LAS f32x4*)(lds + L_NW + tid * 16) = *(const f32x4*)(in[12] + jl * DM + h * DV + tid * 4); }
        float btot0 = 0.f, btot1 = 0.f;
        const int nsub = (ntok + 63) >> 6;
        unsigned qn[8], kn[8]; v4u vn[4]; f32x4 aln;
#define GLA_LOAD(sbx) { const int tokv_ = (ntok - 64 * (sbx)) < 64 ? (ntok - 64 * (sbx)) : 64; const int rb_ = row0 + 64 * (sbx); const int dp_ = tid & 63, jp_ = tid & 31, vg_ = tid >> 5; \
            _Pragma("unroll") for (int i = 0; i < 8; ++i) { const int tok = 8 * wave + i; qn[i] = 0u; kn[i] = 0u; \
                if (tok < tokv_) { const unsigned* pr = (const unsigned*)(PROJ + (size_t)(rb_ + tok) * NPROJ + h * DK) + dp_; qn[i] = pr[0]; kn[i] = pr[256]; } } \
            _Pragma("unroll") for (int i = 0; i < 2; ++i) { const int tok = 2 * jp_ + i; vn[2 * i] = (v4u){0u, 0u, 0u, 0u}; vn[2 * i + 1] = (v4u){0u, 0u, 0u, 0u}; \
                if (tok < tokv_) { const v4u* pv = (const v4u*)(PROJ + (size_t)(rb_ + tok) * NPROJ + 1024 + h * DV + 16 * vg_); vn[2 * i] = pv[0]; vn[2 * i + 1] = pv[1]; } } \
            aln = (f32x4){0.f, 0.f, 0.f, 0.f}; if (tid < 256) { const int tok = tid >> 2; if (tok < tokv_) aln = *(const f32x4*)(ALOW + (size_t)(rb_ + tok) * 16 + 4 * (tid & 3)); } }
        GLA_LOAD(0)
        for (int sb = 0; sb < nsub; ++sb) {
            typedef float f32x2 __attribute__((ext_vector_type(2)));
            const int tokv = (ntok - 64 * sb) < 64 ? (ntok - 64 * sb) : 64; const int rbase = row0 + 64 * sb;
            asm volatile("" : "+v"(tid)); lane = tid & 63; fr = lane & 15; fq = lane >> 4;
            const int dp = tid & 63, jp = tid & 31, vg = tid >> 5;
            if (tid < 256) *(LAS f32x4*)(lds + L_ALOW + (tid >> 2) * 64 + 16 * (tid & 3)) = aln;
            __syncthreads();
            f32x2 bj[8];
            const bool grp_live = 8 * wave < tokv;
            if (!grp_live) {
#pragma unroll
              for (int i = 0; i < 8; ++i) bj[i] = (f32x2){0.f, 0.f};
              *(LAS f32x2*)(lds + L_TOT + (wave * 128 + 2 * dp) * 4) = (f32x2){0.f, 0.f};
            } else
            { f32x2 x[8]; const f32x2 bav = *(const LAS f32x2*)(lds + L_BA + dp * 8);
#pragma unroll
              for (int i = 0; i < 8; ++i) x[i] = bav;
#pragma unroll
              for (int r4 = 0; r4 < 4; ++r4) { const f32x2 w0 = *(const LAS f32x2*)(lds + L_WA + ((4 * r4 + 0) * 128 + 2 * dp) * 4), w1 = *(const LAS f32x2*)(lds + L_WA + ((4 * r4 + 1) * 128 + 2 * dp) * 4),
                                                            w2 = *(const LAS f32x2*)(lds + L_WA + ((4 * r4 + 2) * 128 + 2 * dp) * 4), w3 = *(const LAS f32x2*)(lds + L_WA + ((4 * r4 + 3) * 128 + 2 * dp) * 4);
#pragma unroll
                  for (int i = 0; i < 8; ++i) { const f32x4 al = *(const LAS f32x4*)(lds + L_ALOW + (8 * wave + i) * 64 + 16 * r4); x[i] += w0 * al[0] + w1 * al[1] + w2 * al[2] + w3 * al[3]; } }
              f32x2 run = (f32x2){0.f, 0.f};
#pragma unroll
              for (int i = 0; i < 8; ++i) { f32x2 g; g.x = (fminf(x[i].x, 0.f) - __logf(1.0f + __expf(-fabsf(x[i].x)))) * (1.0f / 16.0f); g.y = (fminf(x[i].y, 0.f) - __logf(1.0f + __expf(-fabsf(x[i].y)))) * (1.0f / 16.0f);
                  if (8 * wave + i >= tokv) g = (f32x2){0.f, 0.f};
                  run += g; bj[i] = run; }
              *(LAS f32x2*)(lds + L_TOT + (wave * 128 + 2 * dp) * 4) = run; }
            __syncthreads();
            f32x2 pre = (f32x2){0.f, 0.f}, blast = (f32x2){0.f, 0.f};
#pragma unroll
            for (int q = 0; q < 8; ++q) { const f32x2 t = *(const LAS f32x2*)(lds + L_TOT + (q * 128 + 2 * dp) * 4); blast += t; if (q < wave) pre += t; }
            btot0 += blast.x; btot1 += blast.y;
            if (wave == 0) *(LAS f32x2*)(lds + L_DL + dp * 8) = (f32x2){__expf(blast.x), __expf(blast.y)};
            if (!grp_live) {
#pragma unroll
              for (int i = 0; i < 8; ++i) { const int tok = 8 * wave + i; *(LAS unsigned*)(lds + L_QH + tok * QS + dp * 4) = 0u; *(LAS unsigned*)(lds + L_KH + tok * QS + dp * 4) = 0u; }
              *(LAS v4u*)(lds + L_KT + (2 * dp) * TSB + wave * 16) = (v4u){0u, 0u, 0u, 0u}; *(LAS v4u*)(lds + L_KT + (2 * dp + 1) * TSB + wave * 16) = (v4u){0u, 0u, 0u, 0u};
            } else
            { unsigned kb[8];
#pragma unroll
              for (int i = 0; i < 8; ++i) { const int tok = 8 * wave + i; const f32x2 bb = bj[i] + pre;
                  const float e1x = __expf(blast.x - bb.x), e1y = __expf(blast.y - bb.y), e2x = __expf(bb.x - blast.x), e2y = __expf(bb.y - blast.y);
                  const unsigned qh = pg8::cvt_pk_bf16(bf2f((unsigned short)(qn[i] & 0xffffu)) * e2x, bf2f((unsigned short)(qn[i] >> 16)) * e2y);
                  const unsigned kh = pg8::cvt_pk_bf16(bf2f((unsigned short)(kn[i] & 0xffffu)) * e1x, bf2f((unsigned short)(kn[i] >> 16)) * e1y);
                  *(LAS unsigned*)(lds + L_QH + tok * QS + dp * 4) = qh; *(LAS unsigned*)(lds + L_KH + tok * QS + dp * 4) = kh; kb[i] = kh; }
              v4u k0, k1;
              k0.x = (kb[0] & 0xffffu) | (kb[1] << 16); k0.y = (kb[2] & 0xffffu) | (kb[3] << 16); k0.z = (kb[4] & 0xffffu) | (kb[5] << 16); k0.w = (kb[6] & 0xffffu) | (kb[7] << 16);
              k1.x = (kb[0] >> 16) | (kb[1] & 0xffff0000u); k1.y = (kb[2] >> 16) | (kb[3] & 0xffff0000u); k1.z = (kb[4] >> 16) | (kb[5] & 0xffff0000u); k1.w = (kb[6] >> 16) | (kb[7] & 0xffff0000u);
              *(LAS v4u*)(lds + L_KT + (2 * dp) * TSB + wave * 16) = k0; *(LAS v4u*)(lds + L_KT + (2 * dp + 1) * TSB + wave * 16) = k1; }
            {
#pragma unroll
              for (int hv = 0; hv < 2; ++hv) { const unsigned a4[4] = {vn[hv].x, vn[hv].y, vn[hv].z, vn[hv].w}, b4[4] = {vn[2 + hv].x, vn[2 + hv].y, vn[2 + hv].z, vn[2 + hv].w};
#pragma unroll
                  for (int k = 0; k < 4; ++k) { LAS unsigned char* p = lds + L_VT + (16 * vg + 8 * hv + 2 * k) * TSB + jp * 4;
                      *(LAS unsigned*)p = (a4[k] & 0xffffu) | (b4[k] << 16); *(LAS unsigned*)(p + TSB) = (a4[k] >> 16) | (b4[k] & 0xffff0000u); } } }
            __syncthreads();
            u32x2 rcur[4][2];
            if (want_out) {
#pragma unroll
                for (int it = 0; it < 4; ++it)
#pragma unroll
                    for (int vt = 0; vt < 2; ++vt) { rcur[it][vt] = (u32x2){0u, 0u};
                        if (16 * it + fr < tokv) rcur[it][vt] = *(const u32x2*)(PROJ + (size_t)(rbase + 16 * it + fr) * NPROJ + 2048 + h * DV + 32 * wave + 16 * vt + 4 * fq); } }
            if (sb + 1 < nsub) GLA_LOAD(sb + 1)
#pragma unroll
            for (int dt = 0; dt < 8; ++dt) { const f32x4 dv = *(const LAS f32x4*)(lds + L_DL + (16 * dt + 4 * fq) * 4); S[dt][0] = S[dt][0] * dv; S[dt][1] = S[dt][1] * dv; }
            if (want_out) {
                f32x4 O[2][4];
#pragma unroll
                for (int tt = 0; tt < 2; ++tt) { const int idx = 2 * wave + tt, it = idx >> 2, jt = idx & 3; f32x4 a = (f32x4){0.f, 0.f, 0.f, 0.f};
                    if (jt <= it && 16 * it < tokv) {
#pragma unroll
                        for (int ks = 0; ks < 4; ++ks) { const bf16x8 X = *(const LAS bf16x8*)(lds + L_KH + (16 * jt + fr) * QS + (32 * ks + 8 * fq) * 2);
                            const bf16x8 Y = *(const LAS bf16x8*)(lds + L_QH + (16 * it + fr) * QS + (32 * ks + 8 * fq) * 2);
                            a = __builtin_amdgcn_mfma_f32_16x16x32_bf16(X, Y, a, 0, 0, 0); }
                        const int ii = 16 * it + fr, j0 = 16 * jt + 4 * fq;
#pragma unroll
                        for (int e = 0; e < 4; ++e) if (j0 + e > ii) a[e] = 0.f;
                    }
                    u32x2 w2; w2.x = pg8::cvt_pk_bf16(a[0], a[1]); w2.y = pg8::cvt_pk_bf16(a[2], a[3]);
                    *(LAS u32x2*)(lds + L_AL + (16 * it + fr) * TSB + (16 * jt + 4 * fq) * 2) = w2; }
                __syncthreads();
                {
                bf16x8 Xs[2][4];
#pragma unroll
                for (int vt = 0; vt < 2; ++vt)
#pragma unroll
                    for (int dp = 0; dp < 4; ++dp) Xs[vt][dp] = pack8(S[2 * dp][vt], S[2 * dp + 1][vt]);
                bf16x8 XV[2][2];
#pragma unroll
                for (int vt = 0; vt < 2; ++vt)
#pragma unroll
                    for (int js = 0; js < 2; ++js) XV[vt][js] = *(const LAS bf16x8*)(lds + L_VT + (32 * wave + 16 * vt + fr) * TSB + (32 * js + 8 * fq) * 2);
#pragma unroll
                for (int it = 0; it < 4; ++it) {
                    if (16 * it >= tokv) { O[0][it] = (f32x4){0.f, 0.f, 0.f, 0.f}; O[1][it] = (f32x4){0.f, 0.f, 0.f, 0.f}; continue; }
                    bf16x8 YQ[4], YA[2];
#pragma unroll
                    for (int dp = 0; dp < 4; ++dp) { const u32x2 lo = *(const LAS u32x2*)(lds + L_QH + (16 * it + fr) * QS + (32 * dp + 4 * fq) * 2);
                        const u32x2 hi = *(const LAS u32x2*)(lds + L_QH + (16 * it + fr) * QS + (32 * dp + 16 + 4 * fq) * 2);
                        YQ[dp] = __builtin_bit_cast(bf16x8, (v4u){lo.x, lo.y, hi.x, hi.y}); }
#pragma unroll
                    for (int js = 0; js < 2; ++js) YA[js] = *(const LAS bf16x8*)(lds + L_AL + (16 * it + fr) * TSB + (32 * js + 8 * fq) * 2);
#pragma unroll
                    for (int vt = 0; vt < 2; ++vt) { f32x4 o = (f32x4){0.f, 0.f, 0.f, 0.f};
#pragma unroll
                        for (int dp = 0; dp < 4; ++dp) o = __builtin_amdgcn_mfma_f32_16x16x32_bf16(Xs[vt][dp], YQ[dp], o, 0, 0, 0);
#pragma unroll
                        for (int js = 0; js < 2; ++js) o = __builtin_amdgcn_mfma_f32_16x16x32_bf16(XV[vt][js], YA[js], o, 0, 0, 0);
                        O[vt][it] = o; }
                    __builtin_amdgcn_sched_barrier(0);
                }
                }
#pragma unroll
                for (int it = 0; it < 4; ++it) { float ss = 0.f;
#pragma unroll
                    for (int vt = 0; vt < 2; ++vt) { const f32x4 o = O[vt][it]; ss += (o[0] * o[0] + o[1] * o[1]) + (o[2] * o[2] + o[3] * o[3]); }
                    ss += __shfl_xor(ss, 16); ss += __shfl_xor(ss, 32);
                    if (fq == 0) *(LAS float*)(lds + L_SSQ + (wave * 64 + 16 * it + fr) * 4) = ss; }
                __syncthreads();
#pragma unroll
                for (int it = 0; it < 4; ++it) { const int tok = 16 * it + fr; float tot = 0.f;
#pragma unroll
                    for (int w8 = 0; w8 < 8; ++w8) tot += *(const LAS float*)(lds + L_SSQ + (w8 * 64 + tok) * 4);
                    const float rstd = rsqrtf(tot * (1.0f / DV) + EPS);
                    if (tok < tokv) { const size_t row = (size_t)(rbase + tok);
#pragma unroll
                        for (int vt = 0; vt < 2; ++vt) { const int vcol = h * DV + 32 * wave + 16 * vt + 4 * fq;
                            const u32x2 r2 = rcur[it][vt]; const f32x4 nw = *(const LAS f32x4*)(lds + L_NW + (32 * wave + 16 * vt + 4 * fq) * 4);
                            const f32x4 o = O[vt][it];
                            const float r0 = bf2f((unsigned short)(r2.x & 0xffffu)), r1 = bf2f((unsigned short)(r2.x >> 16)), r2f = bf2f((unsigned short)(r2.y & 0xffffu)), r3 = bf2f((unsigned short)(r2.y >> 16));
                            u32x2 w2; w2.x = pg8::cvt_pk_bf16(o[0] * rstd * nw[0] * pg8::silu_f(r0), o[1] * rstd * nw[1] * pg8::silu_f(r1));
                            w2.y = pg8::cvt_pk_bf16(o[2] * rstd * nw[2] * pg8::silu_f(r2f), o[3] * rstd * nw[3] * pg8::silu_f(r3));
                            *(u32x2*)(GOUT + row * DM + vcol) = w2; } }
                    __builtin_amdgcn_sched_barrier(0); }
            }
            __builtin_amdgcn_sched_barrier(0);
#pragma unroll
            for (int js = 0; js < 2; ++js) { if (32 * js >= tokv) continue;
#pragma unroll
                for (int vt = 0; vt < 2; ++vt) { const bf16x8 Yv = *(const LAS bf16x8*)(lds + L_VT + (32 * wave + 16 * vt + fr) * TSB + (32 * js + 8 * fq) * 2);
#pragma unroll
                    for (int dt = 0; dt < 8; ++dt) { const bf16x8 Xk = *(const LAS bf16x8*)(lds + L_KT + (16 * dt + fr) * TSB + (32 * js + 8 * fq) * 2);
                        S[dt][vt] = __builtin_amdgcn_mfma_f32_16x16x32_bf16(Xk, Yv, S[dt][vt], 0, 0, 0); }
                    __builtin_amdgcn_sched_barrier(0); } }
            __syncthreads();
        }
        asm volatile("" : "+v"(tid)); lane = tid & 63; fr = lane & 15; fq = lane >> 4;
        if (phase == 0 && !samp) {
            float* dsp = DS + (size_t)(bh * 7 + sc) * DK * DV;
#pragma unroll
            for (int dt = 0; dt < 8; ++dt)
#pragma unroll
                for (int vt = 0; vt < 2; ++vt) *(f32x4*)(dsp + (size_t)(((wave * 8 + dt) * 2 + vt) * 64 + lane) * 4) = S[dt][vt];
            if (wave == 0) { DSC[(size_t)(bh * 7 + sc) * DK + 2 * (tid & 63)] = __expf(btot0); DSC[(size_t)(bh * 7 + sc) * DK + 2 * (tid & 63) + 1] = __expf(btot1); }
        } else if (samp || sc == 7) {
            float* so = samp ? out + O_NGS + ((size_t)(jl * NBS + b) * NH + h) * DK * DV : out + O_NGP + ((size_t)(jl * NBP + b) * NH + h) * DK * DV;
#pragma unroll
            for (int dt = 0; dt < 8; ++dt)
#pragma unroll
                for (int vt = 0; vt < 2; ++vt)
#pragma unroll
                    for (int e = 0; e < 4; ++e) so[(size_t)(16 * dt + 4 * fq + e) * DV + 32 * wave + 16 * vt + fr] = S[dt][vt][e];
        }
    }
}


__device__ __forceinline__ void gla_scan_phase(int gt, int NT, unsigned char* ws) {
    float* DS = (float*)(ws + WS_DS); const float* DSC = (const float*)(ws + WS_DSC);
    for (int c = gt; c < 32 * 8192; c += NT) {
        const int bh = c >> 13, e4 = c & 8191, ln = e4 & 63, dt = (e4 >> 7) & 7, dcol = 16 * dt + 4 * (ln >> 4);
        f32x4 ds[7], dv[7];
#pragma unroll
        for (int k = 0; k < 7; ++k) { ds[k] = *(const f32x4*)(DS + (size_t)(bh * 7 + k) * DK * DV + (size_t)e4 * 4); dv[k] = *(const f32x4*)(DSC + (size_t)(bh * 7 + k) * DK + dcol); }
        f32x4 run = (f32x4){0.f, 0.f, 0.f, 0.f};
#pragma unroll
        for (int k = 0; k < 7; ++k) { run = run * dv[k] + ds[k]; *(f32x4*)(DS + (size_t)(bh * 7 + k) * DK * DV + (size_t)e4 * 4) = run; }
    }
}

struct Args { const float* in[17]; float* out; unsigned char* ws; int ph_lo, ph_hi; };
constexpr int N_PHASES = 29;
__global__ void __launch_bounds__(NWAVES * 64, 2) mk_fwd(Args args) {
    extern __shared__ __attribute__((aligned(16))) unsigned char lds_raw[];
    LAS unsigned char* lds = (LAS unsigned char*)lds_raw;
    volatile LAS unsigned* MISC = (volatile LAS unsigned*)(lds + MISC_OFF);
    for (int u = threadIdx.x; u < (LDS_BYTES - LDSCTL_OFF) / 4; u += NWAVES * 64) ((LAS unsigned*)(lds + LDSCTL_OFF))[u] = 0u;
    __syncthreads();
    XcdBarrier bar = xcd_barrier_post((unsigned*)(args.ws + WS_CTL) + CW_BAR, MISC + 8);
    const int lo = args.ph_lo, hi = args.ph_hi;
    const int wave0 = __builtin_amdgcn_readfirstlane(threadIdx.x >> 6);
#define PH_BEGIN(k) if ((k) >= lo && (k) < hi) { int tid = wave0 * 64 + (int)__builtin_amdgcn_mbcnt_hi(~0u, __builtin_amdgcn_mbcnt_lo(~0u, 0u)); asm volatile("" : "+v"(tid)); const int lane = tid & 63, wave = wave0; \
        const int G = gridDim.x, bid = blockIdx.x; const int vcu = (G % 8 == 0) ? (bid % 8) * (G / 8) + bid / 8 : bid; const int gw = vcu * NWAVES + wave, NGW = G * NWAVES; \
        unsigned char* ws = args.ws; float* out = args.out; const float* const* in = args.in; bf16* Hb = (bf16*)(ws + WS_H); bf16* BIG = (bf16*)(ws + WS_BIG); float* Xs_ = out + O_YS; \
        (void)lane; (void)gw; (void)NGW; (void)Hb; (void)BIG; (void)Xs_; (void)in;
#define PH_END(k)   if ((k) + 1 < hi) xcd_barrier(bar); }

#define POOL_GEMM(k, L) PH_BEGIN(k) { constexpr int jl = (L) >> 1; \
        pg8::Gemm g{BIG, (const bf16*)(ws + WS_WP + jl * SZ_WP), 4 * M, 1024, 256}; pg8::PoolOrder S{G, bid}; \
        pg8::EpiRes<true> E{(L) == 0 ? in[0] : out, (L) == 0 ? in[1] : Xs_, out, in[8] + jl * DM}; \
        pg8::gemm_phase<pg8::EpiRes<true>, pg8::PoolOrder, true, true>(lds, g, S, E, tid); } PH_END(k)
#define RMS_PH(k, gain) PH_BEGIN(k) rms_phase(gw, NGW, lane, out, (gain), Hb); PH_END(k)
#define FFN1(k, L) PH_BEGIN(k) { pg8::Gemm g{Hb, (const bf16*)(ws + WS_W13 + (L) * SZ_W13), M, NG1, DM}; pg8::StaticOrder S; S.init(M, NG1, G, bid, DM); \
        pg8::EpiSwiglu E{BIG}; pg8::gemm_phase<pg8::EpiSwiglu, pg8::StaticOrder, true, true>(lds, g, S, E, tid); } PH_END(k)
#define FFN2(k, L) PH_BEGIN(k) { pg8::Gemm g{BIG, (const bf16*)(ws + WS_W2 + (L) * SZ_W2), M, DM, FF}; pg8::PanelOrder S{G, bid, FF / 64}; \
        pg8::EpiRes<false> E{out, Xs_, out, nullptr}; pg8::gemm_phase<pg8::EpiRes<false>, pg8::PanelOrder, true, true>(lds, g, S, E, tid); \
        small_gemm_res(lds, BIG + (size_t)MP * FF, (const bf16*)(ws + WS_W2 + (L) * SZ_W2), FF, Xs_, tid, wave, G, bid); } PH_END(k)
#define PROJ_PH(k, jl) PH_BEGIN(k) { pg8::Gemm g{Hb, (const bf16*)(ws + WS_WIN + (jl) * SZ_WIN), M, NINP, DM}; pg8::StaticOrder S; S.init(M, NINP, G, bid, DM); \
        pg8::EpiProj E{BIG, (float*)(ws + WS_ALOW)}; pg8::gemm_phase<pg8::EpiProj, pg8::StaticOrder, true, true>(lds, g, S, E, tid); } PH_END(k)
#define WO_PH(k, jl) PH_BEGIN(k) { pg8::Gemm g{Hb, (const bf16*)(ws + WS_WO + (jl) * SZ_WO), M, DM, DM}; pg8::PanelOrder S{G, bid, DM / 64}; \
        pg8::EpiRes<false> E{out, Xs_, out, nullptr}; pg8::gemm_phase<pg8::EpiRes<false>, pg8::PanelOrder, true, true>(lds, g, S, E, tid); \
        small_gemm_res(lds, Hb + (size_t)MP * DM, (const bf16*)(ws + WS_WO + (jl) * SZ_WO), DM, Xs_, tid, wave, G, bid); } PH_END(k)
#define GLA_PH(k, sub, jl) PH_BEGIN(k) gla_phase(lds, tid, wave, lane, G, bid, (sub), (jl), in, out, ws); PH_END(k)

#ifdef NO_GLA
#undef GLA_PH
#define GLA_PH(k, sub, jl)
#endif
#ifdef NO_GEMM
#undef POOL_GEMM
#undef FFN1
#undef FFN2
#undef PROJ_PH
#undef WO_PH
#define POOL_GEMM(k, L)
#define FFN1(k, L)
#define FFN2(k, L)
#define PROJ_PH(k, jl)
#define WO_PH(k, jl)
#endif
#ifdef ONLY_FFN1
#undef POOL_GEMM
#undef FFN2
#undef PROJ_PH
#undef WO_PH
#define POOL_GEMM(k, L)
#define FFN2(k, L)
#define PROJ_PH(k, jl)
#define WO_PH(k, jl)
#endif
    PH_BEGIN(0)
        p0_weights(lds, wave, lane, gw, NGW, in, ws);
        __syncthreads();
        pool_prep(lds, tid, wave, lane, G, bid, in[0], in[1], in[4] + 0 * DM, in[2], BIG, out + O_NPP, out + O_NPS);
    PH_END(0)
    POOL_GEMM(1, 0)
    RMS_PH(2, in[5] + 0 * DM)
    FFN1(3, 0)
    FFN2(4, 0)
    RMS_PH(5, in[4] + 1 * DM)
    PROJ_PH(6, 0)
    GLA_PH(7, 0, 0)
    PH_BEGIN(8)
        gla_scan_phase(vcu * (NWAVES * 64) + tid, G * NWAVES * 64, ws);
    PH_END(8)
    GLA_PH(9, 1, 0)
    WO_PH(10, 0)
    RMS_PH(11, in[5] + 1 * DM)
    FFN1(12, 1)
    FFN2(13, 1)
    PH_BEGIN(14)
        pool_prep(lds, tid, wave, lane, G, bid, out, Xs_, in[4] + 2 * DM, in[2] + (size_t)NBS * 15 * DM, BIG, out + O_NPP + (size_t)NBP * 15 * DM, out + O_NPS + (size_t)NBS * 15 * DM);
    PH_END(14)
    POOL_GEMM(15, 2)
    RMS_PH(16, in[5] + 2 * DM)
    FFN1(17, 2)
    FFN2(18, 2)
    RMS_PH(19, in[4] + 3 * DM)
    PROJ_PH(20, 1)
    GLA_PH(21, 0, 1)
    PH_BEGIN(22)
        gla_scan_phase(vcu * (NWAVES * 64) + tid, G * NWAVES * 64, ws);
    PH_END(22)
    GLA_PH(23, 1, 1)
    WO_PH(24, 1)
    RMS_PH(25, in[5] + 3 * DM)
    FFN1(26, 3)
    FFN2(27, 3)
    PH_BEGIN(28)
        final_norm_phase(gw, NGW, lane, out, in[6]);
    PH_END(28)
}

#ifndef MK_SPLIT
#define MK_SPLIT 0
#endif
extern "C" void kernel_launch(void* const* d_in, const int* in_sizes, int n_in, void* d_out, int out_size, void* d_ws, size_t ws_size, hipStream_t stream) {
    static int grid = 0;
    if (grid == 0) {
        if (n_in != 17 || (size_t)out_size != O_END || ws_size < WS_END) { fprintf(stderr, "kernel_launch: unexpected shapes (n_in %d out %d ws %zu)\n", n_in, out_size, ws_size); grid = -1; return; }
        int dev = 0, cus = 0, per_cu = 0;
        if (hipGetDevice(&dev) != hipSuccess || hipDeviceGetAttribute(&cus, hipDeviceAttributeMultiprocessorCount, dev) != hipSuccess) { grid = -1; return; }
        if (hipFuncSetAttribute((const void*)mk_fwd, hipFuncAttributeMaxDynamicSharedMemorySize, LDS_BYTES) != hipSuccess) { fprintf(stderr, "kernel_launch: hipFuncSetAttribute failed\n"); grid = -1; return; }
        if (hipOccupancyMaxActiveBlocksPerMultiprocessor(&per_cu, (const void*)mk_fwd, NWAVES * 64, LDS_BYTES) != hipSuccess || per_cu < 1) { fprintf(stderr, "kernel_launch: occupancy query failed (%d)\n", per_cu); (void)hipGetLastError(); per_cu = 1; }
        grid = cus;
        if (grid > cus * per_cu) grid = cus * per_cu;
    }
    if (grid < 0) return;
    if (hipMemsetAsync((char*)d_ws + WS_CTL, 0, CTL_ZERO_BYTES, stream) != hipSuccess) { fprintf(stderr, "kernel_launch: memset failed\n"); return; }
    Args a{};
    for (int i = 0; i < 17; ++i) a.in[i] = (const float*)d_in[i];
    a.out = (float*)d_out; a.ws = (unsigned char*)d_ws;
#if MK_SPLIT
    for (int p = 0; p < N_PHASES; ++p) { a.ph_lo = p; a.ph_hi = p + 1; hipLaunchKernelGGL(mk_fwd, dim3(grid), dim3(NWAVES * 64), LDS_BYTES, stream, a); }
#else
    a.ph_lo = 0; a.ph_hi = N_PHASES;
    void* kargs[] = {&a};
    hipError_t e = hipLaunchCooperativeKernel((const void*)mk_fwd, dim3(grid), dim3(NWAVES * 64), kargs, LDS_BYTES, stream);
    if (e != hipSuccess) fprintf(stderr, "kernel_launch: cooperative launch failed: %s (grid %d)\n", hipGetErrorString(e), grid);
#endif
}
```

```cpp
#include <hip/hip_runtime.h>
#include <cstdio>
#include <cstdint>
namespace pg8 {
#define PG8_LAS __attribute__((address_space(3)))
typedef unsigned short bf16_t;
typedef short bf16x8 __attribute__((ext_vector_type(8)));
typedef float f32x4 __attribute__((ext_vector_type(4)));
typedef unsigned u32x4 __attribute__((ext_vector_type(4)));
constexpr int BM = 256, BK = 64, HALF = 128, HTB = HALF * BK * 2  , STAGE_BYTES = 8 * HTB, NXCD = 8, WGM = 8;

__host__ __device__ __forceinline__ int lds_byte(int r, int c) { const int st = (r >> 4) * 2 + (c >> 5), rr = r & 15, cc = c & 31, ob = rr * 64 + cc * 2; return st * 1024 + (ob ^ (((ob >> 9) & 1) << 5)); }
__host__ __device__ __forceinline__ void stage_rc(int b, int& R, int& C) { const int st = b / 1024, sb = b % 1024, swz = sb ^ (((sb >> 9) & 1) << 5); R = (st >> 1) * 16 + swz / 64; C = (st & 1) * 32 + (swz % 64) / 2; }
__host__ __device__ __forceinline__ int perm32(int rho) { const int n = rho >> 4, i = rho & 15; return 8 * (i >> 2) + 4 * n + (i & 3); }

struct Unit { int pm, pn, k0, nt, part; };
struct Gemm { const bf16_t* A; const bf16_t* Bt; int M, N, K; };

struct StaticOrder {
    int nM, nN, nwg, G, c, ntk;
    __host__ __device__ void init(int M, int N, int G_, int c_, int K_) { nM = M / BM; nN = N / BM; nwg = nM * nN; G = G_; c = c_; ntk = K_ / BK; }
    __host__ __device__ bool next(int i, Unit& u) const {
        const long L = (long)i * G + c; if (L >= nwg) return false;
        int wgid = (int)L; { const int q = nwg / NXCD, r = nwg % NXCD, xcd = wgid % NXCD, off = wgid / NXCD; wgid = (xcd < r ? xcd * (q + 1) : r * (q + 1) + (xcd - r) * q) + off; }
        const int nig = WGM * nN, gid = wgid / nig, fm = gid * WGM, gsz = (nM - fm) < WGM ? (nM - fm) : WGM;
        u.pm = fm + ((wgid % nig) % gsz); u.pn = (wgid % nig) / gsz; u.k0 = 0; u.nt = ntk; u.part = 0; return true;
    }
    __device__ __forceinline__ void a_ready(const Unit&) const {}
    __device__ __forceinline__ void done(const Unit&) const {}
};

__device__ __forceinline__ unsigned cvt_pk_bf16(float lo, float hi) { unsigned r; asm volatile("v_cvt_pk_bf16_f32 %0, %1, %2" : "=v"(r) : "v"(lo), "v"(hi)); return r; }
typedef float f32x2 __attribute__((ext_vector_type(2)));
typedef unsigned u32x2 __attribute__((ext_vector_type(2)));
__device__ __forceinline__ float silu_f(float x) { return x * __builtin_amdgcn_rcpf(1.0f + __builtin_amdgcn_exp2f(x * -1.4426950408889634f)); }
constexpr int P_DM = 1024, P_FF = 2816, P_NT = 68  , P_PROJ = 3072;

struct EpiSwiglu {
    static constexpr bool PERM = true, AFTER_DRAIN = false;
    bf16_t* U;
    __device__ __forceinline__ void operator()(const f32x4 (&acc)[2][2][4][2], const Unit& u, int wr, int wc, int fr, int fq) const {
        const int row0 = u.pm * BM + wr * 64 + fr, col0 = u.pn * 128 + wc * 32 + 8 * fq;
#pragma unroll
        for (int ai = 0; ai < 2; ++ai)
#pragma unroll
            for (int m = 0; m < 4; ++m) { bf16_t* rowp = U + (size_t)(row0 + ai * HALF + m * 16) * P_FF + col0;
                const f32x4 g0 = acc[ai][0][m][0], g1 = acc[ai][0][m][1], u0 = acc[ai][1][m][0], u1 = acc[ai][1][m][1];
                u32x4 w; w.x = cvt_pk_bf16(silu_f(g0[0]) * u0[0], silu_f(g0[1]) * u0[1]); w.y = cvt_pk_bf16(silu_f(g0[2]) * u0[2], silu_f(g0[3]) * u0[3]);
                w.z = cvt_pk_bf16(silu_f(g1[0]) * u1[0], silu_f(g1[1]) * u1[1]); w.w = cvt_pk_bf16(silu_f(g1[2]) * u1[2], silu_f(g1[3]) * u1[3]);
                *(u32x4*)rowp = w; }
    }
};
struct EpiProj {
    static constexpr bool PERM = true, AFTER_DRAIN = false;
    bf16_t* P; float* AL;
    __device__ __forceinline__ void operator()(const f32x4 (&acc)[2][2][4][2], const Unit& u, int wr, int wc, int fr, int fq) const {
        const int row0 = u.pm * BM + wr * 64 + fr;
        if (u.pn < 12) {
            const float sc = u.pn < 2 ? 0.08838834764831845f : 1.0f;
            const int col0 = u.pn * BM + wc * 32 + 8 * fq;
#pragma unroll
            for (int ai = 0; ai < 2; ++ai)
#pragma unroll
                for (int m = 0; m < 4; ++m) { bf16_t* rowp = P + (size_t)(row0 + ai * HALF + m * 16) * P_PROJ + col0;
#pragma unroll
                    for (int bj = 0; bj < 2; ++bj) { const f32x4 v0 = acc[ai][bj][m][0] * sc, v1 = acc[ai][bj][m][1] * sc;
                        u32x4 w; w.x = cvt_pk_bf16(v0[0], v0[1]); w.y = cvt_pk_bf16(v0[2], v0[3]); w.z = cvt_pk_bf16(v1[0], v1[1]); w.w = cvt_pk_bf16(v1[2], v1[3]);
                        *(u32x4*)(rowp + bj * HALF) = w; } }
        } else if (wc == 0 && fq < 2) {
#pragma unroll
            for (int ai = 0; ai < 2; ++ai)
#pragma unroll
                for (int m = 0; m < 4; ++m) { float* rowp = AL + (size_t)(row0 + ai * HALF + m * 16) * 16 + 8 * fq;
                    *(f32x4*)rowp = acc[ai][0][m][0]; *(f32x4*)(rowp + 4) = acc[ai][0][m][1]; }
        }
    }
};
template <bool POOL> struct EpiRes {
    static constexpr bool PERM = false, AFTER_DRAIN = false;
    const float* bp; const float* bs; float* out; const float* scale;
    __device__ __forceinline__ void operator()(const f32x4 (&acc)[2][2][4][2], const Unit& u, int wr, int wc, int fr, int fq) const {
        const int pm = POOL ? (u.pm - P_NT * u.pn) : u.pm, pn = u.pn;
        const float* base = pm < 64 ? bp + (size_t)pm * BM * P_DM : bs + (size_t)(pm - 64) * BM * P_DM;
        float* o = out + (size_t)pm * BM * P_DM;
        int frq = fr + 16 * fq; asm volatile("" : "+v"(frq));
        const unsigned col0 = (unsigned)(pn * BM + wc * 32 + 4 * (frq >> 4));
        const unsigned roff = (unsigned)(wr * 64 + (frq & 15)) * P_DM + col0;
#pragma unroll
        for (int ai = 0; ai < 2; ++ai)
#pragma unroll
            for (int m = 0; m < 4; ++m) { const unsigned off = roff + (unsigned)(ai * HALF + m * 16) * P_DM;
#pragma unroll
                for (int bj = 0; bj < 2; ++bj)
#pragma unroll
                    for (int n = 0; n < 2; ++n) { f32x4 a = acc[ai][bj][m][n]; if (POOL) a = a * *(const f32x4*)(scale + col0 + bj * HALF + n * 16);
                        const f32x4 b = *(const f32x4*)(base + off + bj * HALF + n * 16); *(f32x4*)(o + off + bj * HALF + n * 16) = a + b; } }
    }
};
struct PoolOrder {
    int G, c;
    __device__ bool next(int i, Unit& u) const { const int L = i * G + c; if (L >= 4 * P_NT) return false; const int g = L & 3, pm = L >> 2; u.pm = g * P_NT + pm; u.pn = g; u.k0 = 0; u.nt = 4; u.part = 0; return true; }
    __device__ __forceinline__ void a_ready(const Unit&) const {}
    __device__ __forceinline__ void done(const Unit&) const {}
};
struct PanelOrder {
    int G, c, ntk;
    __device__ bool next(int i, Unit& u) const {
        const int L = i * G + c; if (L >= 256) return false;
        const int x = L & 7, idx = L >> 3; u.pm = x * 8 + (idx >> 2); u.pn = idx & 3; u.k0 = 0; u.nt = ntk; u.part = 0; return true;
    }
    __device__ __forceinline__ void a_ready(const Unit&) const {}
    __device__ __forceinline__ void done(const Unit&) const {}
};
template <class Epi, class Sched, bool ALIGN_EPI = false, bool SP2 = false>
__device__ __forceinline__ void gemm_phase(PG8_LAS unsigned char* lds, const Gemm g, const Sched& S, const Epi& E, const int tid_in) {
    int tid_raw = tid_in; asm volatile("" : "+v"(tid_raw));
    const int tid = tid_raw, wid = __builtin_amdgcn_readfirstlane(tid >> 6), lane = tid & 63, wr = wid >> 2, wc = wid & 3, fr = lane & 15, fq = lane >> 4;
    const int K = g.K;
    unsigned voffA[2], voffB[2];
#pragma unroll
    for (int i = 0; i < 2; ++i) { int R, C; stage_rc(tid * 16 + i * 8192, R, C); const int Rb = Epi::PERM ? ((R & ~31) + perm32(R & 31)) : R;
        voffA[i] = (unsigned)(R * K + C) * 2u; voffB[i] = (unsigned)(Rb * K + C) * 2u; }
    const size_t kstep = (size_t)(BK * 2);
    const size_t hstep = (size_t)HALF * K * 2;
    const size_t tstep = 2 * hstep;
    const unsigned ldsw = (unsigned)wid * 1024u;
    const int aoff = lds_byte(wr * 64 + fr, fq * 8), boff = lds_byte(wc * 32 + fr, fq * 8);
#define PG8_SA(b, h) (((b) * 2 + (h)) * HTB)
#define PG8_SB(b, h) ((4 + (b) * 2 + (h)) * HTB)
#define PG8_STAGE(bufoff, gbase, voff) do { _Pragma("unroll") for (int _i = 0; _i < 2; ++_i) \
        __builtin_amdgcn_global_load_lds((const unsigned*)((const char*)(gbase) + (voff)[_i]), (PG8_LAS unsigned*)(lds + (bufoff) + ldsw + _i * 8192), 16, 0, 0); } while (0)
#define PG8_LDA(dst, b, h) do { _Pragma("unroll") for (int m = 0; m < 4; ++m) _Pragma("unroll") for (int k = 0; k < 2; ++k) dst[m][k] = *(const PG8_LAS bf16x8*)(lds + PG8_SA(b, h) + aoff + m * 2048 + k * 1024); } while (0)
#define PG8_LDB(dst, b, h) do { _Pragma("unroll") for (int n = 0; n < 2; ++n) _Pragma("unroll") for (int k = 0; k < 2; ++k) dst[n][k] = *(const PG8_LAS bf16x8*)(lds + PG8_SB(b, h) + boff + n * 2048 + k * 1024); } while (0)
#define PG8_MMA(ai, bj, At, Bt) do { __builtin_amdgcn_s_setprio(1); _Pragma("unroll") for (int m = 0; m < 4; ++m) _Pragma("unroll") for (int n = 0; n < 2; ++n) _Pragma("unroll") for (int k = 0; k < 2; ++k) \
        acc[ai][bj][m][n] = __builtin_amdgcn_mfma_f32_16x16x32_bf16(Bt[n][k], At[m][k], acc[ai][bj][m][n], 0, 0, 0); __builtin_amdgcn_s_setprio(0); } while (0)
#define PG8_WAIT_V(n) asm volatile("s_waitcnt vmcnt(" #n ")" ::: "memory")
#define PG8_WAIT_L(n) asm volatile("s_waitcnt lgkmcnt(" #n ")" ::: "memory")
#define PG8_BAR __builtin_amdgcn_s_barrier()
#define PG8_SCHED __builtin_amdgcn_sched_barrier(0)
    Unit cur, nxt; int ui = 0;
    if (!S.next(0, cur)) return;
    f32x4 acc[2][2][4][2];
#pragma unroll
    for (int a = 0; a < 2; ++a)
#pragma unroll
        for (int b = 0; b < 2; ++b)
#pragma unroll
            for (int m = 0; m < 4; ++m)
#pragma unroll
                for (int n = 0; n < 2; ++n) acc[a][b][m][n] = (f32x4){0.f, 0.f, 0.f, 0.f};
    bf16x8 At[4][2], B0[2][2], B1[2][2];
    const char* cA = (const char*)g.A + (size_t)cur.pm * tstep + (size_t)cur.k0 * 2; const char* cB = (const char*)g.Bt + (size_t)cur.pn * tstep + (size_t)cur.k0 * 2;
    S.a_ready(cur);
    if constexpr (SP2) {
        PG8_STAGE(PG8_SB(0, 0), cB, voffB); PG8_STAGE(PG8_SB(0, 1), cB + hstep, voffB); PG8_STAGE(PG8_SA(0, 0), cA, voffA); PG8_STAGE(PG8_SA(0, 1), cA + hstep, voffA);
        if (wr == 1) PG8_BAR;
        PG8_WAIT_V(2); PG8_BAR;
        PG8_STAGE(PG8_SB(1, 0), cB + kstep, voffB); PG8_STAGE(PG8_SA(1, 0), cA + kstep, voffA); PG8_STAGE(PG8_SB(1, 1), cB + hstep + kstep, voffB);
        PG8_WAIT_V(6); PG8_BAR;
    } else {
        PG8_STAGE(PG8_SB(0, 0), cB, voffB); PG8_STAGE(PG8_SA(0, 0), cA, voffA); PG8_STAGE(PG8_SB(0, 1), cB + hstep, voffB); PG8_STAGE(PG8_SA(0, 1), cA + hstep, voffA);
        if (wr == 1) PG8_BAR;
        PG8_WAIT_V(4); PG8_BAR;
        PG8_STAGE(PG8_SB(1, 0), cB + kstep, voffB); PG8_STAGE(PG8_SA(1, 0), cA + kstep, voffA); PG8_STAGE(PG8_SB(1, 1), cB + hstep + kstep, voffB);
        PG8_WAIT_V(6); PG8_BAR;
    }
    for (;;) {
        const bool has_next = S.next(ui + 1, nxt);
        const char* nA = has_next ? (const char*)g.A + (size_t)nxt.pm * tstep + (size_t)nxt.k0 * 2 : cA; const char* nB = has_next ? (const char*)g.Bt + (size_t)nxt.pn * tstep + (size_t)nxt.k0 * 2 : cB;
        const int nt = cur.nt;
        for (int t = 0; t < nt; t += 2) {
            const bool last = (t == nt - 2);
            const char* a1 = cA + (size_t)(t + 1) * kstep;
            const char* a2 = last ? nA : cA + (size_t)(t + 2) * kstep; const char* b2 = last ? nB : cB + (size_t)(t + 2) * kstep;
            const char* a3 = a2 + kstep; const char* b3 = b2 + kstep;
            if (last && has_next) S.a_ready(nxt);
            if constexpr (SP2) {
            PG8_LDB(B0, 0, 0); PG8_LDB(B1, 0, 1); PG8_SCHED; PG8_LDA(At, 0, 0); PG8_STAGE(PG8_SA(1, 1), a1 + hstep, voffA);
            PG8_WAIT_V(8); PG8_WAIT_L(0); PG8_BAR; PG8_MMA(0, 0, At, B0); PG8_MMA(0, 1, At, B1); PG8_BAR; PG8_SCHED;
            PG8_LDA(At, 0, 1); PG8_STAGE(PG8_SB(0, 0), b2, voffB); PG8_STAGE(PG8_SB(0, 1), b2 + hstep, voffB); PG8_STAGE(PG8_SA(0, 0), a2, voffA);
            PG8_WAIT_V(8); PG8_WAIT_L(0); PG8_BAR; PG8_MMA(1, 0, At, B0); PG8_MMA(1, 1, At, B1); PG8_BAR; PG8_SCHED;
            PG8_LDB(B0, 1, 0); PG8_LDB(B1, 1, 1); PG8_SCHED; PG8_LDA(At, 1, 0); PG8_STAGE(PG8_SA(0, 1), a2 + hstep, voffA);
            PG8_WAIT_V(8); PG8_WAIT_L(0); PG8_BAR; PG8_MMA(0, 0, At, B0); PG8_MMA(0, 1, At, B1); PG8_BAR; PG8_SCHED;
            PG8_LDA(At, 1, 1); PG8_STAGE(PG8_SB(1, 0), b3, voffB); PG8_STAGE(PG8_SB(1, 1), b3 + hstep, voffB); PG8_STAGE(PG8_SA(1, 0), a3, voffA);
            PG8_WAIT_V(8); PG8_WAIT_L(0); PG8_BAR; PG8_MMA(1, 0, At, B0); PG8_MMA(1, 1, At, B1); PG8_BAR; PG8_SCHED;
            } else {
            PG8_LDB(B0, 0, 0); PG8_SCHED; PG8_LDA(At, 0, 0); PG8_STAGE(PG8_SA(1, 1), a1 + hstep, voffA);
            PG8_WAIT_L(8); PG8_BAR; PG8_WAIT_L(0); PG8_MMA(0, 0, At, B0); PG8_BAR; PG8_SCHED;
            PG8_LDB(B1, 0, 1); PG8_STAGE(PG8_SB(0, 0), b2, voffB);
            PG8_BAR; PG8_WAIT_L(0); PG8_MMA(0, 1, At, B1); PG8_BAR;
            PG8_LDA(At, 0, 1); PG8_STAGE(PG8_SA(0, 0), a2, voffA);
            PG8_BAR; PG8_WAIT_L(0); PG8_MMA(1, 0, At, B0); PG8_BAR; PG8_SCHED;
            PG8_STAGE(PG8_SB(0, 1), b2 + hstep, voffB);
            PG8_WAIT_V(6); PG8_BAR; PG8_MMA(1, 1, At, B1); PG8_BAR;
            PG8_LDB(B0, 1, 0); PG8_SCHED; PG8_LDA(At, 1, 0); PG8_STAGE(PG8_SA(0, 1), a2 + hstep, voffA);
            PG8_WAIT_L(8); PG8_BAR; PG8_WAIT_L(0); PG8_MMA(0, 0, At, B0); PG8_BAR; PG8_SCHED;
            PG8_LDB(B1, 1, 1); PG8_STAGE(PG8_SB(1, 0), b3, voffB);
            PG8_BAR; PG8_WAIT_L(0); PG8_MMA(0, 1, At, B1); PG8_BAR;
            PG8_LDA(At, 1, 1); PG8_STAGE(PG8_SA(1, 0), a3, voffA);
            PG8_BAR; PG8_WAIT_L(0); PG8_MMA(1, 0, At, B0); PG8_BAR; PG8_SCHED;
            PG8_STAGE(PG8_SB(1, 1), b3 + hstep, voffB);
            PG8_WAIT_V(6); PG8_BAR; PG8_MMA(1, 1, At, B1); PG8_BAR;
            }
        }
        if constexpr (ALIGN_EPI) { if (wr == 0) PG8_BAR; }
        if constexpr (!Epi::AFTER_DRAIN) { E(acc, cur, wr, wc, fr, fq); S.done(cur); }
        if (!has_next) break;
#pragma unroll
        for (int a = 0; a < 2; ++a)
#pragma unroll
            for (int b = 0; b < 2; ++b)
#pragma unroll
                for (int m = 0; m < 4; ++m)
#pragma unroll
                    for (int n = 0; n < 2; ++n) acc[a][b][m][n] = (f32x4){0.f, 0.f, 0.f, 0.f};
        cur = nxt; cA = nA; cB = nB; ++ui;
        if constexpr (ALIGN_EPI) { if (wr == 1) PG8_BAR; }
    }
    PG8_WAIT_V(0);
    if constexpr (!ALIGN_EPI) { if (wr == 0) PG8_BAR; }
    PG8_BAR;
    if constexpr (Epi::AFTER_DRAIN) { E.fused(acc, cur, wr, wc, fr, fq, lds, wid, lane); S.done(cur); }
#undef PG8_SA
#undef PG8_SB
#undef PG8_STAGE
#undef PG8_LDA
#undef PG8_LDB
#undef PG8_MMA
#undef PG8_WAIT_V
#undef PG8_WAIT_L
#undef PG8_BAR
#undef PG8_SCHED
}
}
#define GAS __attribute__((address_space(1)))
#define LAS __attribute__((address_space(3)))
typedef unsigned short bf16;
typedef unsigned v4u __attribute__((ext_vector_type(4)));
typedef float f32x4 __attribute__((ext_vector_type(4)));
typedef short bf16x8 __attribute__((ext_vector_type(8)));
typedef GAS unsigned gu32;
typedef GAS unsigned long long gu64;
#define RLX_AGENT __ATOMIC_RELAXED, __HIP_MEMORY_SCOPE_AGENT
#define LDS_WAIT() asm volatile("s_waitcnt lgkmcnt(0)" ::: "memory")
#define VM_WAIT() asm volatile("s_waitcnt vmcnt(0)" ::: "memory")
__device__ __forceinline__ unsigned long long rt() { return __builtin_amdgcn_s_memrealtime(); }
__device__ __forceinline__ unsigned f2bf(float f) { unsigned u = __builtin_bit_cast(unsigned, f); return (u + 0x7fffu + ((u >> 16) & 1u)) >> 16; }
__device__ __forceinline__ unsigned pk2(float lo, float hi) { return f2bf(lo) | (f2bf(hi) << 16); }

#define XB_TMO      128
#define XB_XCNT(j)  (256  + 64 * (j))
#define XB_XSUB(j)  (1280 + 64 * (j))
#define XB_XGEN(j)  (2304 + 64 * (j))
#define XB_TOP      3328
#define XB_TOPGEN   3392
#define XCD_BAR_WORDS 3456
#define XB_SPIN_CAP (1u << 18)

__device__ __forceinline__ unsigned xb_ld(unsigned* p)              { return __hip_atomic_load(p, __ATOMIC_RELAXED, __HIP_MEMORY_SCOPE_AGENT); }
__device__ __forceinline__ unsigned xb_add(unsigned* p, unsigned v) { return __hip_atomic_fetch_add(p, v, __ATOMIC_RELAXED, __HIP_MEMORY_SCOPE_AGENT); }
__device__ __forceinline__ unsigned xb_xcc_id() { return (unsigned)__builtin_amdgcn_s_getreg((3 << 11) | 20) & 0xFu; }
#define XB_SPIN(cond, bar) do { unsigned _sp = 0; while (cond) { __builtin_amdgcn_s_sleep(1); \
    if ((++_sp & 255u) == 0u) { if (xb_ld(&(bar)[XB_TMO])) break; if (_sp > XB_SPIN_CAP) { atomicAdd(&(bar)[XB_TMO], 1u); break; } } } } while (0)

struct XcdBarrier {
    unsigned* bar; unsigned x;
    volatile LAS unsigned* st;
};

__device__ __forceinline__ XcdBarrier xcd_barrier_post(unsigned* bar, volatile LAS unsigned* st) {
    XcdBarrier b; b.bar = bar; b.x = xb_xcc_id(); b.st = st;
    if (threadIdx.x == 0) (void)xb_add(&bar[XB_XCNT(b.x)], 1u);
    return b;
}
__device__ __forceinline__ void xcd_barrier_complete(unsigned* bar, unsigned x, unsigned& nloc, unsigned& nx) {
    const unsigned G = gridDim.x * gridDim.y * gridDim.z;
    unsigned sum, cnt, mine, sp = 0u;
    for (;;) {
        sum = 0u; cnt = 0u; mine = 0u;
#pragma unroll
        for (unsigned j = 0; j < 16; ++j) { const unsigned c = xb_ld(&bar[XB_XCNT(j)]); sum += c; cnt += (c > 0u) ? 1u : 0u; mine = (j == x) ? c : mine; }
        if (sum == G) break;
        __builtin_amdgcn_s_sleep(1);
        if ((++sp & 255u) == 0u) { if (xb_ld(&bar[XB_TMO])) break; if (sp > XB_SPIN_CAP) { atomicAdd(&bar[XB_TMO], 1u); break; } }
    }
    nloc = mine > 0u ? mine : 1u; nx = cnt > 0u ? cnt : 1u;
}

__device__ __forceinline__ void xcd_barrier(const XcdBarrier& b) {
    asm volatile("s_waitcnt vmcnt(0)" ::: "memory");
    __syncthreads();
    if (threadIdx.x == 0) {
        unsigned* bar = b.bar;
        __builtin_amdgcn_s_waitcnt(0);
        unsigned nloc = b.st[0], nx = b.st[1];
        if (nloc == 0u) { xcd_barrier_complete(bar, b.x, nloc, nx); b.st[0] = nloc; b.st[1] = nx; }
        const unsigned old = xb_add(&bar[XB_XSUB(b.x)], 1u);
        const unsigned gen = old / nloc;
        if (old + 1u == (gen + 1u) * nloc) {
            __builtin_amdgcn_fence(__ATOMIC_RELEASE, "agent");
            asm volatile("s_waitcnt vmcnt(0)" ::: "memory");
            const unsigned og = xb_add(&bar[XB_TOP], 1u);
            const unsigned tg = og / nx;
            if (og + 1u == (tg + 1u) * nx) xb_add(&bar[XB_TOPGEN], 1u);
            else XB_SPIN(xb_ld(&bar[XB_TOPGEN]) == tg, bar);
            __builtin_amdgcn_fence(__ATOMIC_ACQUIRE, "agent");
            xb_add(&bar[XB_XGEN(b.x)], 1u);
            asm volatile("s_waitcnt vmcnt(0)" ::: "memory");
        } else {
            XB_SPIN(xb_ld(&bar[XB_XGEN(b.x)]) == gen, bar);
            __builtin_amdgcn_fence(__ATOMIC_ACQUIRE, "agent");
            asm volatile("s_waitcnt vmcnt(0)" ::: "memory");
        }
    }
    __syncthreads();
}
constexpr int NWAVES = 8;
constexpr int DM = 1024, TP = 2048, NBP = 8, MP = NBP * TP, NBS = 128, TS = 8, MS = NBS * TS, M = MP + MS, FF = 2816, NG1 = 2 * FF;
constexpr int NIN = 3088, NINP = 3328, NPROJ = 3072, DK = 128, DV = 256, NH = 4;
constexpr float EPS = 1e-6f;
static_assert(M == 68 * 256, "row tiles");
constexpr size_t O_YP = 0, O_YS = (size_t)MP * DM, O_NPP = O_YS + (size_t)MS * DM, O_NGP = O_NPP + (size_t)2 * NBP * 15 * DM, O_NPS = O_NGP + (size_t)2 * NBP * NH * DK * DV,
                 O_NGS = O_NPS + (size_t)2 * NBS * 15 * DM, O_END = O_NGS + (size_t)2 * NBS * NH * DK * DV;
constexpr size_t MiB = 1u << 20;
constexpr size_t WS_CTL = 0, CTL_ZERO_BYTES = 1 * MiB;
constexpr size_t SZ_W13 = (size_t)NG1 * DM * 2, SZ_W2 = (size_t)DM * FF * 2, SZ_WIN = (size_t)NINP * DM * 2, SZ_WO = (size_t)DM * DM * 2, SZ_WP = (size_t)4 * 256 * 256 * 2;
constexpr size_t WS_W13 = 1 * MiB, WS_W2 = WS_W13 + 4 * SZ_W13, WS_WIN = WS_W2 + 4 * SZ_W2, WS_WO = WS_WIN + 2 * SZ_WIN, WS_WP = WS_WO + 2 * SZ_WO;
constexpr size_t WS_H = WS_WP + 2 * SZ_WP;
constexpr size_t WS_BIG = WS_H + (size_t)M * DM * 2;
constexpr size_t WS_ALOW = WS_BIG + (size_t)M * NPROJ * 2;
constexpr size_t WS_DS = WS_ALOW + (size_t)M * 16 * 4;
constexpr size_t WS_DSC = WS_DS + (size_t)32 * 7 * DK * DV * 4;
constexpr size_t WS_END = WS_DSC + (size_t)32 * 7 * DK * 4;
static_assert(WS_END <= 256 * MiB, "d_ws map");
static_assert(WS_H % 256 == 0 && WS_BIG % 256 == 0 && WS_ALOW % 256 == 0 && WS_DS % 256 == 0 && WS_DSC % 256 == 0, "alignment");
constexpr int CW_BAR = 4096;
constexpr int RING_BYTES = 131072, LDSCTL_OFF = RING_BYTES, MISC_OFF = LDSCTL_OFF + 320, LDS_BYTES = 147456;

__device__ __forceinline__ float wave_sum(float v) {
#pragma unroll
    for (int o = 1; o < 64; o <<= 1) v += __shfl_xor(v, o);
    return v;
}
__device__ __forceinline__ float bf2f(unsigned short b) { return __builtin_bit_cast(float, (unsigned)b << 16); }

__device__ __forceinline__ void tr_item(const float* W, int K, int N, bf16* WT, int mode, int row_off, LAS float* scr, int item, int lane) {
    const int nblk = (N + 31) >> 5, kb = item / nblk, nb = item - kb * nblk, k0 = 64 * kb, n0 = 32 * nb;
    const int nn = n0 + (lane & 31); const bool ok = nn < N;
    float wv[32];
#pragma unroll
    for (int i = 0; i < 32; ++i) { const int kk = 2 * i + (lane >> 5); wv[i] = ok ? W[(size_t)(k0 + kk) * N + nn] : 0.f; }
#pragma unroll
    for (int i = 0; i < 32; ++i) { const int kk = 2 * i + (lane >> 5); scr[kk * 33 + (lane & 31)] = wv[i]; }
    LDS_WAIT(); asm volatile("" ::: "memory");
    const int c = lane & 7;
#pragma unroll
    for (int j = 0; j < 4; ++j) { const int n = (lane >> 3) + 8 * j; const LAS float* s = scr + (8 * c) * 33 + n;
        v4u o; o.x = pk2(s[0 * 33], s[1 * 33]); o.y = pk2(s[2 * 33], s[3 * 33]); o.z = pk2(s[4 * 33], s[5 * 33]); o.w = pk2(s[6 * 33], s[7 * 33]);
        const int ng = n0 + n; const int row = mode ? (((ng >> 7) << 8) + (ng & 127) + row_off) : (row_off + ng);
        *(v4u*)(WT + (size_t)row * K + k0 + 8 * c) = o; }
    LDS_WAIT(); asm volatile("" ::: "memory");
}
__device__ __forceinline__ void p0_weights(LAS unsigned char* lds, int wave, int lane, int gw, int NGW, const float* const* in, unsigned char* ws) {
    LAS float* scr = (LAS float*)(lds + wave * 16384);
    constexpr int I_W1 = (DM / 64) * (FF / 32), I_W2 = (FF / 64) * (DM / 32), I_WIN = (DM / 64) * ((NIN + 31) / 32), I_WO = (DM / 64) * (DM / 32), I_WP = (256 / 64) * (256 / 32);
    constexpr int N_FFN = 4 * (2 * I_W1 + I_W2), N_GLA = 2 * (I_WIN + I_WO), N_POOL = 8 * I_WP, NITEMS = N_FFN + N_GLA + N_POOL;
    for (int it = gw; it < NITEMS; it += NGW) {
        int r = it;
        if (r < N_FFN) { const int L = r / (2 * I_W1 + I_W2); r -= L * (2 * I_W1 + I_W2);
            if (r < I_W1) { tr_item(in[14] + (size_t)L * DM * FF, DM, FF, (bf16*)(ws + WS_W13 + L * SZ_W13), 1, 0, scr, r, lane); continue; } r -= I_W1;
            if (r < I_W1) { tr_item(in[15] + (size_t)L * DM * FF, DM, FF, (bf16*)(ws + WS_W13 + L * SZ_W13), 1, 128, scr, r, lane); continue; } r -= I_W1;
            tr_item(in[16] + (size_t)L * FF * DM, FF, DM, (bf16*)(ws + WS_W2 + L * SZ_W2), 0, 0, scr, r, lane); continue; }
        r -= N_FFN;
        if (r < N_GLA) { const int L = r / (I_WIN + I_WO); r -= L * (I_WIN + I_WO);
            if (r < I_WIN) { tr_item(in[9] + (size_t)L * DM * NIN, DM, NIN, (bf16*)(ws + WS_WIN + L * SZ_WIN), 0, 0, scr, r, lane); continue; } r -= I_WIN;
            tr_item(in[13] + (size_t)L * DM * DM, DM, DM, (bf16*)(ws + WS_WO + L * SZ_WO), 0, 0, scr, r, lane); continue; }
        r -= N_GLA;
        { const int jg = r / I_WP; r -= jg * I_WP;
          tr_item(in[7] + (size_t)jg * 65536, 256, 256, (bf16*)(ws + WS_WP + (jg >> 2) * SZ_WP), 0, (jg & 3) * 256, scr, r, lane); }
    }
    constexpr int PADV = (NINP - 3104) * DM * 2 / 16;
    for (int i = gw * 64 + lane; i < 2 * PADV; i += NGW * 64) { const int L = i / PADV, e = i - L * PADV;
        ((v4u*)(ws + WS_WIN + L * SZ_WIN + (size_t)3104 * DM * 2))[e] = (v4u){0u, 0u, 0u, 0u}; }
}

__device__ __forceinline__ void rms_row_bf16(const float* xrow, const float* g, bf16* orow, int lane) {
    const f32x4* xr = (const f32x4*)xrow + lane; const f32x4* gr = (const f32x4*)g + lane;
    f32x4 v[4]; float s = 0.f;
#pragma unroll
    for (int j = 0; j < 4; ++j) { v[j] = xr[64 * j]; s += (v[j].x * v[j].x + v[j].y * v[j].y) + (v[j].z * v[j].z + v[j].w * v[j].w); }
    const float rstd = rsqrtf(wave_sum(s) * (1.f / DM) + EPS);
    unsigned long long* o8 = (unsigned long long*)orow + lane;
#pragma unroll
    for (int j = 0; j < 4; ++j) { const f32x4 gg = gr[64 * j]; const f32x4 y = v[j] * rstd * gg;
        o8[64 * j] = (unsigned long long)pk2(y.x, y.y) | ((unsigned long long)pk2(y.z, y.w) << 32); }
}
__device__ __forceinline__ void rms_phase(int gw, int NGW, int lane, const float* X, const float* g, bf16* H) {
    for (int m = gw; m < M; m += NGW) rms_row_bf16(X + (size_t)m * DM, g, H + (size_t)m * DM, lane);
}
__device__ __forceinline__ void final_norm_phase(int gw, int NGW, int lane, float* X, const float* g) {
    for (int m = gw; m < M; m += NGW) {
        f32x4* xr = (f32x4*)(X + (size_t)m * DM) + lane; const f32x4* gr = (const f32x4*)g + lane;
        f32x4 v[4]; float s = 0.f;
#pragma unroll
        for (int j = 0; j < 4; ++j) { v[j] = xr[64 * j]; s += (v[j].x * v[j].x + v[j].y * v[j].y) + (v[j].z * v[j].z + v[j].w * v[j].w); }
        const float rstd = rsqrtf(wave_sum(s) * (1.f / DM) + EPS);
#pragma unroll
        for (int j = 0; j < 4; ++j) xr[64 * j] = v[j] * rstd * gr[64 * j];
    }
}

__device__ __forceinline__ void small_gemm_res(LAS unsigned char* lds, const bf16* A, const bf16* Bt, int K, float* X, int tid, int wave, int G, int bid) {
    constexpr int RS = 272, BUF = 2 * 64 * RS;
    const int lane = tid & 63, fr = lane & 15, fq = lane >> 4, rt = wave & 3, ch = wave >> 2;
    const int lr = tid >> 3, lc = (tid & 7) * 16;
    const int nch = K >> 7;
    for (int L = bid; L < 256; L += G) {
        const int tm = L >> 4, tn = L & 15;
        const v4u* ag = (const v4u*)(A + (size_t)(tm * 64 + lr) * K + lc); const v4u* bg = (const v4u*)(Bt + (size_t)(tn * 64 + lr) * K + lc);
        LAS unsigned char* wa = lds + lr * RS + lc * 2; LAS unsigned char* wb = wa + 64 * RS;
        v4u pa[2], pb[2], qa[2], qb[2];
        { const v4u a0 = ag[0], a1 = ag[1], b0 = bg[0], b1 = bg[1];
          pa[0] = ag[16]; pa[1] = ag[17]; pb[0] = bg[16]; pb[1] = bg[17];
          qa[0] = ag[32]; qa[1] = ag[33]; qb[0] = bg[32]; qb[1] = bg[33];
          *(LAS v4u*)wa = a0; *(LAS v4u*)(wa + 16) = a1; *(LAS v4u*)wb = b0; *(LAS v4u*)(wb + 16) = b1; }
        __syncthreads();
        f32x4 acc0 = (f32x4){0.f, 0.f, 0.f, 0.f}, acc1 = (f32x4){0.f, 0.f, 0.f, 0.f};
#define SG_COMPUTE(bufoff) { _Pragma("unroll") for (int ks = 0; ks < 4; ++ks) { const bf16x8 a = *(const LAS bf16x8*)(lds + (bufoff) + (16 * rt + fr) * RS + (32 * ks + 8 * fq) * 2); \
            const bf16x8 b0 = *(const LAS bf16x8*)(lds + (bufoff) + 64 * RS + (32 * ch + fr) * RS + (32 * ks + 8 * fq) * 2), b1 = *(const LAS bf16x8*)(lds + (bufoff) + 64 * RS + (32 * ch + 16 + fr) * RS + (32 * ks + 8 * fq) * 2); \
            acc0 = __builtin_amdgcn_mfma_f32_16x16x32_bf16(b0, a, acc0, 0, 0, 0); acc1 = __builtin_amdgcn_mfma_f32_16x16x32_bf16(b1, a, acc1, 0, 0, 0); } }
        for (int kc = 0; kc < nch; kc += 2) {
            SG_COMPUTE(0)
            *(LAS v4u*)(wa + BUF) = pa[0]; *(LAS v4u*)(wa + BUF + 16) = pa[1]; *(LAS v4u*)(wb + BUF) = pb[0]; *(LAS v4u*)(wb + BUF + 16) = pb[1];
            if (kc + 3 < nch) { pa[0] = ag[16 * (kc + 3)]; pa[1] = ag[16 * (kc + 3) + 1]; pb[0] = bg[16 * (kc + 3)]; pb[1] = bg[16 * (kc + 3) + 1]; }
            __syncthreads();
            SG_COMPUTE(BUF)
            if (kc + 2 < nch) { *(LAS v4u*)wa = qa[0]; *(LAS v4u*)(wa + 16) = qa[1]; *(LAS v4u*)wb = qb[0]; *(LAS v4u*)(wb + 16) = qb[1]; }
            if (kc + 4 < nch) { qa[0] = ag[16 * (kc + 4)]; qa[1] = ag[16 * (kc + 4) + 1]; qb[0] = bg[16 * (kc + 4)]; qb[1] = bg[16 * (kc + 4) + 1]; }
            __syncthreads();
        }
#undef SG_COMPUTE
        float* o = X + (size_t)(tm * 64 + 16 * rt + fr) * DM + tn * 64 + 32 * ch + 4 * fq;
        *(f32x4*)o = *(const f32x4*)o + acc0; *(f32x4*)(o + 16) = *(const f32x4*)(o + 16) + acc1;
    }
    __syncthreads();
}

__device__ __forceinline__ void pool_prep(LAS unsigned char* lds, int tid, int wave, int lane, int G, int bid,
                                          const float* xp, const float* xs, const float* gmix, const float* spool, bf16* DIFF, float* onp, float* ons) {
    typedef float f32x2 __attribute__((ext_vector_type(2)));
    LAS float* hb = (LAS float*)lds;
    for (int u = bid; u < 1024 + NBS; u += G) {
        const bool pr = u < 1024; const int b = pr ? (u >> 7) : (u - 1024); const int t0 = pr ? (u & 127) * 16 : 0; const int ntok = pr ? 16 : 8;
        {
            f32x4 v[4][4]; bool has[4], donorm[4];
#pragma unroll
            for (int k = 0; k < 4; ++k) { const int r = wave + 8 * k; const float* src = nullptr; donorm[k] = true;
                if (r < 15 + ntok) {
                    if (pr) { const int t = t0 - 15 + r; if (t >= 0) src = xp + ((size_t)b * TP + t) * DM; }
                    else { if (r < 15) { src = spool + ((size_t)b * 15 + r) * DM; donorm[k] = false; } else src = xs + ((size_t)b * TS + (r - 15)) * DM; } }
                has[k] = src != nullptr;
#pragma unroll
                for (int j = 0; j < 4; ++j) v[k][j] = has[k] ? ((const f32x4*)src + lane)[64 * j] : (f32x4){0.f, 0.f, 0.f, 0.f}; }
            const f32x4* gr = (const f32x4*)gmix + lane;
#pragma unroll
            for (int k = 0; k < 4; ++k) { const int r = wave + 8 * k;
                if (r < 15 + ntok) { float s = 0.f;
#pragma unroll
                    for (int j = 0; j < 4; ++j) s += (v[k][j].x * v[k][j].x + v[k][j].y * v[k][j].y) + (v[k][j].z * v[k][j].z + v[k][j].w * v[k][j].w);
                    const float rstd = (has[k] && donorm[k]) ? rsqrtf(wave_sum(s) * (1.f / DM) + EPS) : 1.f;
                    LAS f32x4* hrow = (LAS f32x4*)(hb + r * DM) + lane;
#pragma unroll
                    for (int j = 0; j < 4; ++j) hrow[64 * j] = (has[k] && donorm[k]) ? v[k][j] * rstd * gr[64 * j] : v[k][j]; } }
        }
        __syncthreads();
        const int c = 2 * tid, gi = tid >> 7, w = 2 << gi;
        f32x2 sum = (f32x2){0.f, 0.f};
        for (int l = 1; l < w; ++l) sum += *(const LAS f32x2*)(hb + (15 - l) * DM + c);
        for (int i = 0; i < ntok; ++i) {
            const f32x2 cur = *(const LAS f32x2*)(hb + (15 + i) * DM + c); sum += cur;
            const int cnt = pr ? ((t0 + i + 1) < w ? (t0 + i + 1) : w) : w; const float inv = 1.0f / (float)cnt;
            const f32x2 d = sum * inv - cur;
            const size_t row = pr ? ((size_t)b * TP + t0 + i) : ((size_t)MP + b * TS + i);
            *(unsigned*)(DIFF + ((size_t)gi * M + row) * 256 + (c & 255)) = pk2(d.x, d.y);
            sum -= *(const LAS f32x2*)(hb + (15 + i - w + 1) * DM + c);
        }
        if (pr) { if (t0 == TP - 16) for (int i = 1; i < 16; ++i) *(f32x2*)(onp + ((size_t)b * 15 + (i - 1)) * DM + c) = *(const LAS f32x2*)(hb + (15 + i) * DM + c); }
        else for (int i = 0; i < 15; ++i) *(f32x2*)(ons + ((size_t)b * 15 + i) * DM + c) = *(const LAS f32x2*)(hb + (8 + i) * DM + c);
        __syncthreads();
    }
}

constexpr int L_QH = 0, L_KH = 17408, L_KT = 34816, L_VT = 53248, L_AL = 90112, L_ALOW = 99328, L_DL = 105472, L_SSQ = 105984, L_TOT = 108032, L_WA = 112128, L_BA = 120320, L_NW = 120832, L_GLA_END = 121856;
constexpr int QS = 272, TSB = 144;
static_assert(L_GLA_END <= RING_BYTES, "GLA LDS");
__device__ __forceinline__ bf16x8 pack8(const f32x4 a, const f32x4 b) {
    v4u w; w.x = pg8::cvt_pk_bf16(a[0], a[1]); w.y = pg8::cvt_pk_bf16(a[2], a[3]); w.z = pg8::cvt_pk_bf16(b[0], b[1]); w.w = pg8::cvt_pk_bf16(b[2], b[3]);
    return __builtin_bit_cast(bf16x8, w);
}
__device__ __forceinline__ void gla_phase(LAS unsigned char* lds, int tid, int wave, int lane, int G, int bid, int phase, int jl,
                                          const float* const* in, float* out, unsigned char* ws) {
    typedef unsigned u32x2 __attribute__((ext_vector_type(2)));
    const bf16* PROJ = (const bf16*)(ws + WS_BIG); const float* ALOW = (const float*)(ws + WS_ALOW); bf16* GOUT = (bf16*)(ws + WS_H);
    float* DS = (float*)(ws + WS_DS); float* DSC = (float*)(ws + WS_DSC);
    const int nitems = phase == 0 ? (224 + 4 * NBS) : 256;
    const int tid_in = tid;
    for (int item = bid; item < nitems; item += G) {
        int tid = tid_in; asm volatile("" : "+v"(tid));
        int lane = tid & 63, fr = lane & 15, fq = lane >> 4;
        int b, h, row0, ntok, sc = 0; bool want_out, samp = false;
        if (phase == 0) { if (item < 224) { const int bh = item / 7; sc = item - bh * 7; b = bh >> 2; h = bh & 3; row0 = b * TP + sc * 256; ntok = 256; want_out = false; }
                          else { const int q = item - 224; b = q >> 2; h = q & 3; row0 = MP + b * TS; ntok = TS; want_out = true; samp = true; } }
        else { const int bh = item >> 3; sc = item & 7; b = bh >> 2; h = bh & 3; row0 = b * TP + sc * 256; ntok = 256; want_out = true; }
        const int bh = b * 4 + h;
        f32x4 S[8][2];
#pragma unroll
        for (int dt = 0; dt < 8; ++dt)
#pragma unroll
            for (int vt = 0; vt < 2; ++vt) S[dt][vt] = (f32x4){0.f, 0.f, 0.f, 0.f};
        if (samp) {
            const float* s0 = in[3] + ((size_t)(jl * NBS + b) * NH + h) * DK * DV;
#pragma unroll
            for (int dt = 0; dt < 8; ++dt)
#pragma unroll
                for (int vt = 0; vt < 2; ++vt)
#pragma unroll
                    for (int e = 0; e < 4; ++e) S[dt][vt][e] = s0[(size_t)(16 * dt + 4 * fq + e) * DV + 32 * wave + 16 * vt + fr];
        } else if (phase == 1 && sc > 0) {
            const float* dsp = DS + (size_t)(bh * 7 + sc - 1) * DK * DV;
#pragma unroll
            for (int dt = 0; dt < 8; ++dt)
#pragma unroll
                for (int vt = 0; vt < 2; ++vt) S[dt][vt] = *(const f32x4*)(dsp + (size_t)(((wave * 8 + dt) * 2 + vt) * 64 + lane) * 4);
        }
        { const int r = tid >> 5, d4 = (tid & 31) * 4;
          *(LAS f32x4*)(lds + L_WA + (r * 128 + d4) * 4) = *(const f32x4*)(in[10] + (size_t)jl * 16 * 512 + r * 512 + h * DK + d4) * 1.4426950408889634f;
          if (tid < 32) *(LAS f32x4*)(lds + L_BA + tid * 16) = *(const f32x4*)(in[11] + jl * 512 + h * DK + tid * 4) * 1.4426950408889634f;
          if (tid < 64) *(LAS f32x4*)(lds + L_NW + tid * 16) = *(const f32x4*)(in[12] + jl * DM + h * DV + tid * 4); }
        float btot0 = 0.f, btot1 = 0.f;
        const int nsub = (ntok + 63) >> 6;
        unsigned qn[8], kn[8]; v4u vn[4]; f32x4 aln;
#define GLA_LOAD(sbx) { const int tokv_ = (ntok - 64 * (sbx)) < 64 ? (ntok - 64 * (sbx)) : 64; const int rb_ = row0 + 64 * (sbx); const int dp_ = tid & 63, jp_ = tid & 31, vg_ = tid >> 5; \
            _Pragma("unroll") for (int i = 0; i < 8; ++i) { const int tok = 8 * wave + i; qn[i] = 0u; kn[i] = 0u; \
                if (tok < tokv_) { const unsigned* pr = (const unsigned*)(PROJ + (size_t)(rb_ + tok) * NPROJ + h * DK) + dp_; qn[i] = pr[0]; kn[i] = pr[256]; } } \
            _Pragma("unroll") for (int i = 0; i < 2; ++i) { const int tok = 2 * jp_ + i; vn[2 * i] = (v4u){0u, 0u, 0u, 0u}; vn[2 * i + 1] = (v4u){0u, 0u, 0u, 0u}; \
                if (tok < tokv_) { const v4u* pv = (const v4u*)(PROJ + (size_t)(rb_ + tok) * NPROJ + 1024 + h * DV + 16 * vg_); vn[2 * i] = pv[0]; vn[2 * i + 1] = pv[1]; } } \
            aln = (f32x4){0.f, 0.f, 0.f, 0.f}; if (tid < 256) { const int tok = tid >> 2; if (tok < tokv_) aln = *(const f32x4*)(ALOW + (size_t)(rb_ + tok) * 16 + 4 * (tid & 3)); } }
        GLA_LOAD(0)
        for (int sb = 0; sb < nsub; ++sb) {
            typedef float f32x2 __attribute__((ext_vector_type(2)));
            const int tokv = (ntok - 64 * sb) < 64 ? (ntok - 64 * sb) : 64; const int rbase = row0 + 64 * sb;
            asm volatile("" : "+v"(tid)); lane = tid & 63; fr = lane & 15; fq = lane >> 4;
            const int dp = tid & 63, jp = tid & 31, vg = tid >> 5;
            if (tid < 256) *(LAS f32x4*)(lds + L_ALOW + (tid >> 2) * 64 + 16 * (tid & 3)) = aln;
            __syncthreads();
            f32x2 bj[8];
            { f32x2 x[8]; const f32x2 bav = *(const LAS f32x2*)(lds + L_BA + dp * 8);
#pragma unroll
              for (int i = 0; i < 8; ++i) x[i] = bav;
#pragma unroll
              for (int r4 = 0; r4 < 4; ++r4) { const f32x2 w0 = *(const LAS f32x2*)(lds + L_WA + ((4 * r4 + 0) * 128 + 2 * dp) * 4), w1 = *(const LAS f32x2*)(lds + L_WA + ((4 * r4 + 1) * 128 + 2 * dp) * 4),
                                                            w2 = *(const LAS f32x2*)(lds + L_WA + ((4 * r4 + 2) * 128 + 2 * dp) * 4), w3 = *(const LAS f32x2*)(lds + L_WA + ((4 * r4 + 3) * 128 + 2 * dp) * 4);
#pragma unroll
                  for (int i = 0; i < 8; ++i) { const f32x4 al = *(const LAS f32x4*)(lds + L_ALOW + (8 * wave + i) * 64 + 16 * r4); x[i] += w0 * al[0] + w1 * al[1] + w2 * al[2] + w3 * al[3]; } }
              f32x2 run = (f32x2){0.f, 0.f};
#pragma unroll
              for (int i = 0; i < 8; ++i) { f32x2 g;
                  g.x = (fminf(x[i].x, 0.f) - __builtin_amdgcn_logf(1.0f + __builtin_amdgcn_exp2f(-fabsf(x[i].x)))) * (1.0f / 16.0f); g.y = (fminf(x[i].y, 0.f) - __builtin_amdgcn_logf(1.0f + __builtin_amdgcn_exp2f(-fabsf(x[i].y)))) * (1.0f / 16.0f);
                  if (8 * wave + i >= tokv) g = (f32x2){0.f, 0.f};
                  run += g; bj[i] = run; }
              *(LAS f32x2*)(lds + L_TOT + (wave * 128 + 2 * dp) * 4) = run; }
            __syncthreads();
            f32x2 pre = (f32x2){0.f, 0.f}, blast = (f32x2){0.f, 0.f};
#pragma unroll
            for (int q = 0; q < 8; ++q) { const f32x2 t = *(const LAS f32x2*)(lds + L_TOT + (q * 128 + 2 * dp) * 4); blast += t; if (q < wave) pre += t; }
            btot0 += blast.x; btot1 += blast.y;
            if (wave == 0) *(LAS f32x2*)(lds + L_DL + dp * 8) = (f32x2){__builtin_amdgcn_exp2f(blast.x), __builtin_amdgcn_exp2f(blast.y)};
            { unsigned kb[8];
#pragma unroll
              for (int i = 0; i < 8; ++i) { const int tok = 8 * wave + i; const f32x2 bb = bj[i] + pre;
                  const float e1x = __builtin_amdgcn_exp2f(blast.x - bb.x), e1y = __builtin_amdgcn_exp2f(blast.y - bb.y), e2x = __builtin_amdgcn_exp2f(bb.x - blast.x), e2y = __builtin_amdgcn_exp2f(bb.y - blast.y);
                  const unsigned qh = pg8::cvt_pk_bf16(bf2f((unsigned short)(qn[i] & 0xffffu)) * e2x, bf2f((unsigned short)(qn[i] >> 16)) * e2y);
                  const unsigned kh = pg8::cvt_pk_bf16(bf2f((unsigned short)(kn[i] & 0xffffu)) * e1x, bf2f((unsigned short)(kn[i] >> 16)) * e1y);
                  *(LAS unsigned*)(lds + L_QH + tok * QS + dp * 4) = qh; *(LAS unsigned*)(lds + L_KH + tok * QS + dp * 4) = kh; kb[i] = kh; }
              v4u k0, k1;
              k0.x = (kb[0] & 0xffffu) | (kb[1] << 16); k0.y = (kb[2] & 0xffffu) | (kb[3] << 16); k0.z = (kb[4] & 0xffffu) | (kb[5] << 16); k0.w = (kb[6] & 0xffffu) | (kb[7] << 16);
              k1.x = (kb[0] >> 16) | (kb[1] & 0xffff0000u); k1.y = (kb[2] >> 16) | (kb[3] & 0xffff0000u); k1.z = (kb[4] >> 16) | (kb[5] & 0xffff0000u); k1.w = (kb[6] >> 16) | (kb[7] & 0xffff0000u);
              *(LAS v4u*)(lds + L_KT + (2 * dp) * TSB + wave * 16) = k0; *(LAS v4u*)(lds + L_KT + (2 * dp + 1) * TSB + wave * 16) = k1; }
            {
#pragma unroll
              for (int hv = 0; hv < 2; ++hv) { const unsigned a4[4] = {vn[hv].x, vn[hv].y, vn[hv].z, vn[hv].w}, b4[4] = {vn[2 + hv].x, vn[2 + hv].y, vn[2 + hv].z, vn[2 + hv].w};
#pragma unroll
                  for (int k = 0; k < 4; ++k) { LAS unsigned char* p = lds + L_VT + (16 * vg + 8 * hv + 2 * k) * TSB + jp * 4;
                      *(LAS unsigned*)p = (a4[k] & 0xffffu) | (b4[k] << 16); *(LAS unsigned*)(p + TSB) = (a4[k] >> 16) | (b4[k] & 0xffff0000u); } } }
            __syncthreads();
            u32x2 rcur[4][2];
            if (want_out) {
#pragma unroll
                for (int it = 0; it < 4; ++it)
#pragma unroll
                    for (int vt = 0; vt < 2; ++vt) { rcur[it][vt] = (u32x2){0u, 0u};
                        if (16 * it + fr < tokv) rcur[it][vt] = *(const u32x2*)(PROJ + (size_t)(rbase + 16 * it + fr) * NPROJ + 2048 + h * DV + 32 * wave + 16 * vt + 4 * fq); } }
            if (sb + 1 < nsub) GLA_LOAD(sb + 1)
#pragma unroll
            for (int dt = 0; dt < 8; ++dt) { const f32x4 dv = *(const LAS f32x4*)(lds + L_DL + (16 * dt + 4 * fq) * 4); S[dt][0] = S[dt][0] * dv; S[dt][1] = S[dt][1] * dv; }
            if (want_out) {
                f32x4 O[2][4];
#pragma unroll
                for (int tt = 0; tt < 2; ++tt) { const int idx = 2 * wave + tt, it = idx >> 2, jt = idx & 3; f32x4 a = (f32x4){0.f, 0.f, 0.f, 0.f};
                    if (jt <= it) {
#pragma unroll
                        for (int ks = 0; ks < 4; ++ks) { const bf16x8 X = *(const LAS bf16x8*)(lds + L_KH + (16 * jt + fr) * QS + (32 * ks + 8 * fq) * 2);
                            const bf16x8 Y = *(const LAS bf16x8*)(lds + L_QH + (16 * it + fr) * QS + (32 * ks + 8 * fq) * 2);
                            a = __builtin_amdgcn_mfma_f32_16x16x32_bf16(X, Y, a, 0, 0, 0); }
                        const int ii = 16 * it + fr, j0 = 16 * jt + 4 * fq;
#pragma unroll
                        for (int e = 0; e < 4; ++e) if (j0 + e > ii) a[e] = 0.f;
                    }
                    u32x2 w2; w2.x = pg8::cvt_pk_bf16(a[0], a[1]); w2.y = pg8::cvt_pk_bf16(a[2], a[3]);
                    *(LAS u32x2*)(lds + L_AL + (16 * it + fr) * TSB + (16 * jt + 4 * fq) * 2) = w2; }
                __syncthreads();
                {
                bf16x8 Xs[2][4];
#pragma unroll
                for (int vt = 0; vt < 2; ++vt)
#pragma unroll
                    for (int dp = 0; dp < 4; ++dp) Xs[vt][dp] = pack8(S[2 * dp][vt], S[2 * dp + 1][vt]);
                bf16x8 XV[2][2];
#pragma unroll
                for (int vt = 0; vt < 2; ++vt)
#pragma unroll
                    for (int js = 0; js < 2; ++js) XV[vt][js] = *(const LAS bf16x8*)(lds + L_VT + (32 * wave + 16 * vt + fr) * TSB + (32 * js + 8 * fq) * 2);
#pragma unroll
                for (int it = 0; it < 4; ++it) {
                    bf16x8 YQ[4], YA[2];
#pragma unroll
                    for (int dp = 0; dp < 4; ++dp) { const u32x2 lo = *(const LAS u32x2*)(lds + L_QH + (16 * it + fr) * QS + (32 * dp + 4 * fq) * 2);
                        const u32x2 hi = *(const LAS u32x2*)(lds + L_QH + (16 * it + fr) * QS + (32 * dp + 16 + 4 * fq) * 2);
                        YQ[dp] = __builtin_bit_cast(bf16x8, (v4u){lo.x, lo.y, hi.x, hi.y}); }
#pragma unroll
                    for (int js = 0; js < 2; ++js) YA[js] = *(const LAS bf16x8*)(lds + L_AL + (16 * it + fr) * TSB + (32 * js + 8 * fq) * 2);
#pragma unroll
                    for (int vt = 0; vt < 2; ++vt) { f32x4 o = (f32x4){0.f, 0.f, 0.f, 0.f};
#pragma unroll
                        for (int dp = 0; dp < 4; ++dp) o = __builtin_amdgcn_mfma_f32_16x16x32_bf16(Xs[vt][dp], YQ[dp], o, 0, 0, 0);
#pragma unroll
                        for (int js = 0; js < 2; ++js) o = __builtin_amdgcn_mfma_f32_16x16x32_bf16(XV[vt][js], YA[js], o, 0, 0, 0);
                        O[vt][it] = o; }
                    __builtin_amdgcn_sched_barrier(0);
                }
                }
#pragma unroll
                for (int it = 0; it < 4; ++it) { float ss = 0.f;
#pragma unroll
                    for (int vt = 0; vt < 2; ++vt) { const f32x4 o = O[vt][it]; ss += (o[0] * o[0] + o[1] * o[1]) + (o[2] * o[2] + o[3] * o[3]); }
                    ss += __shfl_xor(ss, 16); ss += __shfl_xor(ss, 32);
                    if (fq == 0) *(LAS float*)(lds + L_SSQ + (wave * 64 + 16 * it + fr) * 4) = ss; }
                __syncthreads();
#pragma unroll
                for (int it = 0; it < 4; ++it) { const int tok = 16 * it + fr; float tot = 0.f;
#pragma unroll
                    for (int w8 = 0; w8 < 8; ++w8) tot += *(const LAS float*)(lds + L_SSQ + (w8 * 64 + tok) * 4);
                    const float rstd = rsqrtf(tot * (1.0f / DV) + EPS);
                    if (tok < tokv) { const size_t row = (size_t)(rbase + tok);
#pragma unroll
                        for (int vt = 0; vt < 2; ++vt) { const int vcol = h * DV + 32 * wave + 16 * vt + 4 * fq;
                            const u32x2 r2 = rcur[it][vt]; const f32x4 nw = *(const LAS f32x4*)(lds + L_NW + (32 * wave + 16 * vt + 4 * fq) * 4);
                            const f32x4 o = O[vt][it];
                            const float r0 = bf2f((unsigned short)(r2.x & 0xffffu)), r1 = bf2f((unsigned short)(r2.x >> 16)), r2f = bf2f((unsigned short)(r2.y & 0xffffu)), r3 = bf2f((unsigned short)(r2.y >> 16));
                            u32x2 w2; w2.x = pg8::cvt_pk_bf16(o[0] * rstd * nw[0] * pg8::silu_f(r0), o[1] * rstd * nw[1] * pg8::silu_f(r1));
                            w2.y = pg8::cvt_pk_bf16(o[2] * rstd * nw[2] * pg8::silu_f(r2f), o[3] * rstd * nw[3] * pg8::silu_f(r3));
                            *(u32x2*)(GOUT + row * DM + vcol) = w2; } }
                    __builtin_amdgcn_sched_barrier(0); }
            }
            __builtin_amdgcn_sched_barrier(0);
#pragma unroll
            for (int js = 0; js < 2; ++js)
#pragma unroll
                for (int vt = 0; vt < 2; ++vt) { const bf16x8 Yv = *(const LAS bf16x8*)(lds + L_VT + (32 * wave + 16 * vt + fr) * TSB + (32 * js + 8 * fq) * 2);
#pragma unroll
                    for (int dt = 0; dt < 8; ++dt) { const bf16x8 Xk = *(const LAS bf16x8*)(lds + L_KT + (16 * dt + fr) * TSB + (32 * js + 8 * fq) * 2);
                        S[dt][vt] = __builtin_amdgcn_mfma_f32_16x16x32_bf16(Xk, Yv, S[dt][vt], 0, 0, 0); }
                    __builtin_amdgcn_sched_barrier(0); }
            __syncthreads();
        }
        asm volatile("" : "+v"(tid)); lane = tid & 63; fr = lane & 15; fq = lane >> 4;
        if (phase == 0 && !samp) {
            float* dsp = DS + (size_t)(bh * 7 + sc) * DK * DV;
#pragma unroll
            for (int dt = 0; dt < 8; ++dt)
#pragma unroll
                for (int vt = 0; vt < 2; ++vt) *(f32x4*)(dsp + (size_t)(((wave * 8 + dt) * 2 + vt) * 64 + lane) * 4) = S[dt][vt];
            if (wave == 0) { DSC[(size_t)(bh * 7 + sc) * DK + 2 * (tid & 63)] = __builtin_amdgcn_exp2f(btot0); DSC[(size_t)(bh * 7 + sc) * DK + 2 * (tid & 63) + 1] = __builtin_amdgcn_exp2f(btot1); }
        } else if (samp || sc == 7) {
            float* so = samp ? out + O_NGS + ((size_t)(jl * NBS + b) * NH + h) * DK * DV : out + O_NGP + ((size_t)(jl * NBP + b) * NH + h) * DK * DV;
#pragma unroll
            for (int dt = 0; dt < 8; ++dt)
#pragma unroll
                for (int vt = 0; vt < 2; ++vt)
#pragma unroll
                    for (int e = 0; e < 4; ++e) so[(size_t)(16 * dt + 4 * fq + e) * DV + 32 * wave + 16 * vt + fr] = S[dt][vt][e];
        }
    }
}


__device__ __forceinline__ void gla_scan_phase(int gt, int NT, unsigned char* ws) {
    float* DS = (float*)(ws + WS_DS); const float* DSC = (const float*)(ws + WS_DSC);
    for (int c = gt; c < 32 * 8192; c += NT) {
        const int bh = c >> 13, e4 = c & 8191, ln = e4 & 63, dt = (e4 >> 7) & 7, dcol = 16 * dt + 4 * (ln >> 4);
        f32x4 ds[7], dv[7];
#pragma unroll
        for (int k = 0; k < 7; ++k) { ds[k] = *(const f32x4*)(DS + (size_t)(bh * 7 + k) * DK * DV + (size_t)e4 * 4); dv[k] = *(const f32x4*)(DSC + (size_t)(bh * 7 + k) * DK + dcol); }
        f32x4 run = (f32x4){0.f, 0.f, 0.f, 0.f};
#pragma unroll
        for (int k = 0; k < 7; ++k) { run = run * dv[k] + ds[k]; *(f32x4*)(DS + (size_t)(bh * 7 + k) * DK * DV + (size_t)e4 * 4) = run; }
    }
}

struct Args { const float* in[17]; float* out; unsigned char* ws; int ph_lo, ph_hi; };
constexpr int N_PHASES = 29;
__global__ void __launch_bounds__(NWAVES * 64, 2) mk_fwd(Args args) {
    extern __shared__ __attribute__((aligned(16))) unsigned char lds_raw[];
    LAS unsigned char* lds = (LAS unsigned char*)lds_raw;
    volatile LAS unsigned* MISC = (volatile LAS unsigned*)(lds + MISC_OFF);
    for (int u = threadIdx.x; u < (LDS_BYTES - LDSCTL_OFF) / 4; u += NWAVES * 64) ((LAS unsigned*)(lds + LDSCTL_OFF))[u] = 0u;
    __syncthreads();
    XcdBarrier bar = xcd_barrier_post((unsigned*)(args.ws + WS_CTL) + CW_BAR, MISC + 8);
    const int lo = args.ph_lo, hi = args.ph_hi;
    const int wave0 = __builtin_amdgcn_readfirstlane(threadIdx.x >> 6);
#define PH_BEGIN(k) if ((k) >= lo && (k) < hi) { int tid = wave0 * 64 + (int)__builtin_amdgcn_mbcnt_hi(~0u, __builtin_amdgcn_mbcnt_lo(~0u, 0u)); asm volatile("" : "+v"(tid)); const int lane = tid & 63, wave = wave0; \
        const int G = gridDim.x, bid = blockIdx.x; const int vcu = (G % 8 == 0) ? (bid % 8) * (G / 8) + bid / 8 : bid; const int gw = vcu * NWAVES + wave, NGW = G * NWAVES; \
        unsigned char* ws = args.ws; float* out = args.out; const float* const* in = args.in; bf16* Hb = (bf16*)(ws + WS_H); bf16* BIG = (bf16*)(ws + WS_BIG); float* Xs_ = out + O_YS; \
        (void)lane; (void)gw; (void)NGW; (void)Hb; (void)BIG; (void)Xs_; (void)in;
#define PH_END(k)   if ((k) + 1 < hi) xcd_barrier(bar); }

#define POOL_GEMM(k, L) PH_BEGIN(k) { constexpr int jl = (L) >> 1; \
        pg8::Gemm g{BIG, (const bf16*)(ws + WS_WP + jl * SZ_WP), 4 * M, 1024, 256}; pg8::PoolOrder S{G, bid}; \
        pg8::EpiRes<true> E{(L) == 0 ? in[0] : out, (L) == 0 ? in[1] : Xs_, out, in[8] + jl * DM}; \
        pg8::gemm_phase<pg8::EpiRes<true>, pg8::PoolOrder, true, true>(lds, g, S, E, tid); } PH_END(k)
#define RMS_PH(k, gain) PH_BEGIN(k) rms_phase(gw, NGW, lane, out, (gain), Hb); PH_END(k)
#define FFN1(k, L) PH_BEGIN(k) { pg8::Gemm g{Hb, (const bf16*)(ws + WS_W13 + (L) * SZ_W13), M, NG1, DM}; pg8::StaticOrder S; S.init(M, NG1, G, bid, DM); \
        pg8::EpiSwiglu E{BIG}; pg8::gemm_phase<pg8::EpiSwiglu, pg8::StaticOrder, true, true>(lds, g, S, E, tid); } PH_END(k)
#define FFN2(k, L) PH_BEGIN(k) { pg8::Gemm g{BIG, (const bf16*)(ws + WS_W2 + (L) * SZ_W2), M, DM, FF}; pg8::PanelOrder S{G, bid, FF / 64}; \
        pg8::EpiRes<false> E{out, Xs_, out, nullptr}; pg8::gemm_phase<pg8::EpiRes<false>, pg8::PanelOrder, true, true>(lds, g, S, E, tid); \
        small_gemm_res(lds, BIG + (size_t)MP * FF, (const bf16*)(ws + WS_W2 + (L) * SZ_W2), FF, Xs_, tid, wave, G, bid); } PH_END(k)
#define PROJ_PH(k, jl) PH_BEGIN(k) { pg8::Gemm g{Hb, (const bf16*)(ws + WS_WIN + (jl) * SZ_WIN), M, NINP, DM}; pg8::StaticOrder S; S.init(M, NINP, G, bid, DM); \
        pg8::EpiProj E{BIG, (float*)(ws + WS_ALOW)}; pg8::gemm_phase<pg8::EpiProj, pg8::StaticOrder, true, true>(lds, g, S, E, tid); } PH_END(k)
#define WO_PH(k, jl) PH_BEGIN(k) { pg8::Gemm g{Hb, (const bf16*)(ws + WS_WO + (jl) * SZ_WO), M, DM, DM}; pg8::PanelOrder S{G, bid, DM / 64}; \
        pg8::EpiRes<false> E{out, Xs_, out, nullptr}; pg8::gemm_phase<pg8::EpiRes<false>, pg8::PanelOrder, true, true>(lds, g, S, E, tid); \
        small_gemm_res(lds, Hb + (size_t)MP * DM, (const bf16*)(ws + WS_WO + (jl) * SZ_WO), DM, Xs_, tid, wave, G, bid); } PH_END(k)
#define GLA_PH(k, sub, jl) PH_BEGIN(k) gla_phase(lds, tid, wave, lane, G, bid, (sub), (jl), in, out, ws); PH_END(k)

#ifdef NO_GLA
#undef GLA_PH
#define GLA_PH(k, sub, jl)
#endif
#ifdef NO_GEMM
#undef POOL_GEMM
#undef FFN1
#undef FFN2
#undef PROJ_PH
#undef WO_PH
#define POOL_GEMM(k, L)
#define FFN1(k, L)
#define FFN2(k, L)
#define PROJ_PH(k, jl)
#define WO_PH(k, jl)
#endif
#ifdef ONLY_FFN1
#undef POOL_GEMM
#undef FFN2
#undef PROJ_PH
#undef WO_PH
#define POOL_GEMM(k, L)
#define FFN2(k, L)
#define PROJ_PH(k, jl)
#define WO_PH(k, jl)
#endif
    PH_BEGIN(0)
        p0_weights(lds, wave, lane, gw, NGW, in, ws);
        __syncthreads();
        pool_prep(lds, tid, wave, lane, G, bid, in[0], in[1], in[4] + 0 * DM, in[2], BIG, out + O_NPP, out + O_NPS);
    PH_END(0)
    POOL_GEMM(1, 0)
    RMS_PH(2, in[5] + 0 * DM)
    FFN1(3, 0)
    FFN2(4, 0)
    RMS_PH(5, in[4] + 1 * DM)
    PROJ_PH(6, 0)
    GLA_PH(7, 0, 0)
    PH_BEGIN(8)
        gla_scan_phase(vcu * (NWAVES * 64) + tid, G * NWAVES * 64, ws);
    PH_END(8)
    GLA_PH(9, 1, 0)
    WO_PH(10, 0)
    RMS_PH(11, in[5] + 1 * DM)
    FFN1(12, 1)
    FFN2(13, 1)
    PH_BEGIN(14)
        pool_prep(lds, tid, wave, lane, G, bid, out, Xs_, in[4] + 2 * DM, in[2] + (size_t)NBS * 15 * DM, BIG, out + O_NPP + (size_t)NBP * 15 * DM, out + O_NPS + (size_t)NBS * 15 * DM);
    PH_END(14)
    POOL_GEMM(15, 2)
    RMS_PH(16, in[5] + 2 * DM)
    FFN1(17, 2)
    FFN2(18, 2)
    RMS_PH(19, in[4] + 3 * DM)
    PROJ_PH(20, 1)
    GLA_PH(21, 0, 1)
    PH_BEGIN(22)
        gla_scan_phase(vcu * (NWAVES * 64) + tid, G * NWAVES * 64, ws);
    PH_END(22)
    GLA_PH(23, 1, 1)
    WO_PH(24, 1)
    RMS_PH(25, in[5] + 3 * DM)
    FFN1(26, 3)
    FFN2(27, 3)
    PH_BEGIN(28)
        final_norm_phase(gw, NGW, lane, out, in[6]);
    PH_END(28)
}

#ifndef MK_SPLIT
#define MK_SPLIT 0
#endif
extern "C" void kernel_launch(void* const* d_in, const int* in_sizes, int n_in, void* d_out, int out_size, void* d_ws, size_t ws_size, hipStream_t stream) {
    static int grid = 0;
    if (grid == 0) {
        if (n_in != 17 || (size_t)out_size != O_END || ws_size < WS_END) { fprintf(stderr, "kernel_launch: unexpected shapes (n_in %d out %d ws %zu)\n", n_in, out_size, ws_size); grid = -1; return; }
        int dev = 0, cus = 0, per_cu = 0;
        if (hipGetDevice(&dev) != hipSuccess || hipDeviceGetAttribute(&cus, hipDeviceAttributeMultiprocessorCount, dev) != hipSuccess) { grid = -1; return; }
        if (hipFuncSetAttribute((const void*)mk_fwd, hipFuncAttributeMaxDynamicSharedMemorySize, LDS_BYTES) != hipSuccess) { fprintf(stderr, "kernel_launch: hipFuncSetAttribute failed\n"); grid = -1; return; }
        if (hipOccupancyMaxActiveBlocksPerMultiprocessor(&per_cu, (const void*)mk_fwd, NWAVES * 64, LDS_BYTES) != hipSuccess || per_cu < 1) { fprintf(stderr, "kernel_launch: occupancy query failed (%d)\n", per_cu); (void)hipGetLastError(); per_cu = 1; }
        grid = cus;
        if (grid > cus * per_cu) grid = cus * per_cu;
    }
    if (grid < 0) return;
    if (hipMemsetAsync((char*)d_ws + WS_CTL, 0, CTL_ZERO_BYTES, stream) != hipSuccess) { fprintf(stderr, "kernel_launch: memset failed\n"); return; }
    Args a{};
    for (int i = 0; i < 17; ++i) a.in[i] = (const float*)d_in[i];
    a.out = (float*)d_out; a.ws = (unsigned char*)d_ws;
#if MK_SPLIT
    for (int p = 0; p < N_PHASES; ++p) { a.ph_lo = p; a.ph_hi = p + 1; hipLaunchKernelGGL(mk_fwd, dim3(grid), dim3(NWAVES * 64), LDS_BYTES, stream, a); }
#else
    a.ph_lo = 0; a.ph_hi = N_PHASES;
    void* kargs[] = {&a};
    hipError_t e = hipLaunchCooperativeKernel((const void*)mk_fwd, dim3(grid), dim3(NWAVES * 64), kargs, LDS_BYTES, stream);
    if (e != hipSuccess) fprintf(stderr, "kernel_launch: cooperative launch failed: %s (grid %d)\n", hipGetErrorString(e), grid);
#endif
}
```

```cpp
#include <hip/hip_runtime.h>
#include <cstdio>
#include <cstdint>
namespace pg8 {
#define PG8_LAS __attribute__((address_space(3)))
typedef unsigned short bf16_t;
typedef short bf16x8 __attribute__((ext_vector_type(8)));
typedef float f32x4 __attribute__((ext_vector_type(4)));
typedef unsigned u32x4 __attribute__((ext_vector_type(4)));
constexpr int BM = 256, BK = 64, HALF = 128, HTB = HALF * BK * 2  , STAGE_BYTES = 8 * HTB, NXCD = 8, WGM = 8;

__host__ __device__ __forceinline__ int lds_byte(int r, int c) { const int st = (r >> 4) * 2 + (c >> 5), rr = r & 15, cc = c & 31, ob = rr * 64 + cc * 2; return st * 1024 + (ob ^ (((ob >> 9) & 1) << 5)); }
__host__ __device__ __forceinline__ void stage_rc(int b, int& R, int& C) { const int st = b / 1024, sb = b % 1024, swz = sb ^ (((sb >> 9) & 1) << 5); R = (st >> 1) * 16 + swz / 64; C = (st & 1) * 32 + (swz % 64) / 2; }
__host__ __device__ __forceinline__ int perm32(int rho) { const int n = rho >> 4, i = rho & 15; return 8 * (i >> 2) + 4 * n + (i & 3); }

struct Unit { int pm, pn, k0, nt, part; };
struct Gemm { const bf16_t* A; const bf16_t* Bt; int M, N, K; };

struct StaticOrder {
    int nM, nN, nwg, G, c, ntk;
    __host__ __device__ void init(int M, int N, int G_, int c_, int K_) { nM = M / BM; nN = N / BM; nwg = nM * nN; G = G_; c = c_; ntk = K_ / BK; }
    __host__ __device__ bool next(int i, Unit& u) const {
        const long L = (long)i * G + c; if (L >= nwg) return false;
        int wgid = (int)L; { const int q = nwg / NXCD, r = nwg % NXCD, xcd = wgid % NXCD, off = wgid / NXCD; wgid = (xcd < r ? xcd * (q + 1) : r * (q + 1) + (xcd - r) * q) + off; }
        const int nig = WGM * nN, gid = wgid / nig, fm = gid * WGM, gsz = (nM - fm) < WGM ? (nM - fm) : WGM;
        u.pm = fm + ((wgid % nig) % gsz); u.pn = (wgid % nig) / gsz; u.k0 = 0; u.nt = ntk; u.part = 0; return true;
    }
    __device__ __forceinline__ void a_ready(const Unit&) const {}
    __device__ __forceinline__ void done(const Unit&) const {}
};

__device__ __forceinline__ unsigned cvt_pk_bf16(float lo, float hi) { unsigned r; asm volatile("v_cvt_pk_bf16_f32 %0, %1, %2" : "=v"(r) : "v"(lo), "v"(hi)); return r; }
typedef float f32x2 __attribute__((ext_vector_type(2)));
typedef unsigned u32x2 __attribute__((ext_vector_type(2)));
__device__ __forceinline__ float silu_f(float x) { return x * __builtin_amdgcn_rcpf(1.0f + __builtin_amdgcn_exp2f(x * -1.4426950408889634f)); }
constexpr int P_DM = 1024, P_FF = 2816, P_NT = 68  , P_PROJ = 3072;

__device__ __forceinline__ unsigned swiglu_pk(f32x2 g, f32x2 u) {
    const f32x2 t = g * -1.4426950408889634f; f32x2 e; e.x = __builtin_amdgcn_exp2f(t.x); e.y = __builtin_amdgcn_exp2f(t.y);
    const f32x2 d = e + 1.0f; f32x2 r; r.x = __builtin_amdgcn_rcpf(d.x); r.y = __builtin_amdgcn_rcpf(d.y);
    const f32x2 o = (g * u) * r; return cvt_pk_bf16(o.x, o.y);
}
struct EpiSwiglu {
    static constexpr bool PERM = true, AFTER_DRAIN = false;
    bf16_t* U;
    __device__ __forceinline__ void operator()(const f32x4 (&acc)[2][2][4][2], const Unit& u, int wr, int wc, int fr, int fq) const {
        const int row0 = u.pm * BM + wr * 64 + fr, col0 = u.pn * 128 + wc * 32 + 8 * fq;
#pragma unroll
        for (int ai = 0; ai < 2; ++ai)
#pragma unroll
            for (int m = 0; m < 4; ++m) { bf16_t* rowp = U + (size_t)(row0 + ai * HALF + m * 16) * P_FF + col0;
                const f32x4 g0 = acc[ai][0][m][0], g1 = acc[ai][0][m][1], u0 = acc[ai][1][m][0], u1 = acc[ai][1][m][1];
                u32x4 w; w.x = swiglu_pk((f32x2){g0[0], g0[1]}, (f32x2){u0[0], u0[1]}); w.y = swiglu_pk((f32x2){g0[2], g0[3]}, (f32x2){u0[2], u0[3]});
                w.z = swiglu_pk((f32x2){g1[0], g1[1]}, (f32x2){u1[0], u1[1]}); w.w = swiglu_pk((f32x2){g1[2], g1[3]}, (f32x2){u1[2], u1[3]});
                *(u32x4*)rowp = w; }
    }
};
struct EpiProj {
    static constexpr bool PERM = true, AFTER_DRAIN = false;
    bf16_t* P; float* AL;
    __device__ __forceinline__ void operator()(const f32x4 (&acc)[2][2][4][2], const Unit& u, int wr, int wc, int fr, int fq) const {
        const int row0 = u.pm * BM + wr * 64 + fr;
        if (u.pn < 12) {
            const float sc = u.pn < 2 ? 0.08838834764831845f : 1.0f;
            const int col0 = u.pn * BM + wc * 32 + 8 * fq;
#pragma unroll
            for (int ai = 0; ai < 2; ++ai)
#pragma unroll
                for (int m = 0; m < 4; ++m) { bf16_t* rowp = P + (size_t)(row0 + ai * HALF + m * 16) * P_PROJ + col0;
#pragma unroll
                    for (int bj = 0; bj < 2; ++bj) { const f32x4 v0 = acc[ai][bj][m][0] * sc, v1 = acc[ai][bj][m][1] * sc;
                        u32x4 w; w.x = cvt_pk_bf16(v0[0], v0[1]); w.y = cvt_pk_bf16(v0[2], v0[3]); w.z = cvt_pk_bf16(v1[0], v1[1]); w.w = cvt_pk_bf16(v1[2], v1[3]);
                        *(u32x4*)(rowp + bj * HALF) = w; } }
        } else if (wc == 0 && fq < 2) {
#pragma unroll
            for (int ai = 0; ai < 2; ++ai)
#pragma unroll
                for (int m = 0; m < 4; ++m) { float* rowp = AL + (size_t)(row0 + ai * HALF + m * 16) * 16 + 8 * fq;
                    *(f32x4*)rowp = acc[ai][0][m][0]; *(f32x4*)(rowp + 4) = acc[ai][0][m][1]; }
        }
    }
};
template <bool POOL> struct EpiRes {
    static constexpr bool PERM = false, AFTER_DRAIN = false;
    const float* bp; const float* bs; float* out; const float* scale;
    __device__ __forceinline__ void operator()(const f32x4 (&acc)[2][2][4][2], const Unit& u, int wr, int wc, int fr, int fq) const {
        const int pm = POOL ? (u.pm - P_NT * u.pn) : u.pm, pn = u.pn;
        const float* base = pm < 64 ? bp + (size_t)pm * BM * P_DM : bs + (size_t)(pm - 64) * BM * P_DM;
        float* o = out + (size_t)pm * BM * P_DM;
        int frq = fr + 16 * fq; asm volatile("" : "+v"(frq));
        const unsigned col0 = (unsigned)(pn * BM + wc * 32 + 4 * (frq >> 4));
        const unsigned roff = (unsigned)(wr * 64 + (frq & 15)) * P_DM + col0;
#pragma unroll
        for (int ai = 0; ai < 2; ++ai)
#pragma unroll
            for (int m = 0; m < 4; ++m) { const unsigned off = roff + (unsigned)(ai * HALF + m * 16) * P_DM;
#pragma unroll
                for (int bj = 0; bj < 2; ++bj)
#pragma unroll
                    for (int n = 0; n < 2; ++n) { f32x4 a = acc[ai][bj][m][n]; if (POOL) a = a * *(const f32x4*)(scale + col0 + bj * HALF + n * 16);
                        const f32x4 b = *(const f32x4*)(base + off + bj * HALF + n * 16); *(f32x4*)(o + off + bj * HALF + n * 16) = a + b; } }
    }
};
struct PoolOrder {
    int G, c;
    __device__ bool next(int i, Unit& u) const { const int L = i * G + c; if (L >= 4 * P_NT) return false; const int g = L & 3, pm = L >> 2; u.pm = g * P_NT + pm; u.pn = g; u.k0 = 0; u.nt = 4; u.part = 0; return true; }
    __device__ __forceinline__ void a_ready(const Unit&) const {}
    __device__ __forceinline__ void done(const Unit&) const {}
};
struct PanelOrder {
    int G, c, ntk;
    __device__ bool next(int i, Unit& u) const {
        const int L = i * G + c; if (L >= 256) return false;
        const int x = L & 7, idx = L >> 3; u.pm = x * 8 + (idx >> 2); u.pn = idx & 3; u.k0 = 0; u.nt = ntk; u.part = 0; return true;
    }
    __device__ __forceinline__ void a_ready(const Unit&) const {}
    __device__ __forceinline__ void done(const Unit&) const {}
};
template <class Epi, class Sched, bool ALIGN_EPI = false, bool SP2 = false>
__device__ __forceinline__ void gemm_phase(PG8_LAS unsigned char* lds, const Gemm g, const Sched& S, const Epi& E, const int tid_in) {
    int tid_raw = tid_in; asm volatile("" : "+v"(tid_raw));
    const int tid = tid_raw, wid = __builtin_amdgcn_readfirstlane(tid >> 6), lane = tid & 63, wr = wid >> 2, wc = wid & 3, fr = lane & 15, fq = lane >> 4;
    const int K = g.K;
    unsigned voffA[2], voffB[2];
#pragma unroll
    for (int i = 0; i < 2; ++i) { int R, C; stage_rc(tid * 16 + i * 8192, R, C); const int Rb = Epi::PERM ? ((R & ~31) + perm32(R & 31)) : R;
        voffA[i] = (unsigned)(R * K + C) * 2u; voffB[i] = (unsigned)(Rb * K + C) * 2u; }
    const size_t kstep = (size_t)(BK * 2);
    const size_t hstep = (size_t)HALF * K * 2;
    const size_t tstep = 2 * hstep;
    const unsigned ldsw = (unsigned)wid * 1024u;
    const int aoff = lds_byte(wr * 64 + fr, fq * 8), boff = lds_byte(wc * 32 + fr, fq * 8);
#define PG8_SA(b, h) (((b) * 2 + (h)) * HTB)
#define PG8_SB(b, h) ((4 + (b) * 2 + (h)) * HTB)
#define PG8_STAGE(bufoff, gbase, voff) do { _Pragma("unroll") for (int _i = 0; _i < 2; ++_i) \
        __builtin_amdgcn_global_load_lds((const unsigned*)((const char*)(gbase) + (voff)[_i]), (PG8_LAS unsigned*)(lds + (bufoff) + ldsw + _i * 8192), 16, 0, 0); } while (0)
#define PG8_LDA(dst, b, h) do { _Pragma("unroll") for (int m = 0; m < 4; ++m) _Pragma("unroll") for (int k = 0; k < 2; ++k) dst[m][k] = *(const PG8_LAS bf16x8*)(lds + PG8_SA(b, h) + aoff + m * 2048 + k * 1024); } while (0)
#define PG8_LDB(dst, b, h) do { _Pragma("unroll") for (int n = 0; n < 2; ++n) _Pragma("unroll") for (int k = 0; k < 2; ++k) dst[n][k] = *(const PG8_LAS bf16x8*)(lds + PG8_SB(b, h) + boff + n * 2048 + k * 1024); } while (0)
#define PG8_MMA(ai, bj, At, Bt) do { __builtin_amdgcn_s_setprio(1); _Pragma("unroll") for (int m = 0; m < 4; ++m) _Pragma("unroll") for (int n = 0; n < 2; ++n) _Pragma("unroll") for (int k = 0; k < 2; ++k) \
        acc[ai][bj][m][n] = __builtin_amdgcn_mfma_f32_16x16x32_bf16(Bt[n][k], At[m][k], acc[ai][bj][m][n], 0, 0, 0); __builtin_amdgcn_s_setprio(0); } while (0)
#define PG8_WAIT_V(n) asm volatile("s_waitcnt vmcnt(" #n ")" ::: "memory")
#define PG8_WAIT_L(n) asm volatile("s_waitcnt lgkmcnt(" #n ")" ::: "memory")
#define PG8_BAR __builtin_amdgcn_s_barrier()
#define PG8_SCHED __builtin_amdgcn_sched_barrier(0)
    Unit cur, nxt; int ui = 0;
    if (!S.next(0, cur)) return;
    f32x4 acc[2][2][4][2];
#pragma unroll
    for (int a = 0; a < 2; ++a)
#pragma unroll
        for (int b = 0; b < 2; ++b)
#pragma unroll
            for (int m = 0; m < 4; ++m)
#pragma unroll
                for (int n = 0; n < 2; ++n) acc[a][b][m][n] = (f32x4){0.f, 0.f, 0.f, 0.f};
    bf16x8 At[4][2], B0[2][2], B1[2][2];
    const char* cA = (const char*)g.A + (size_t)cur.pm * tstep + (size_t)cur.k0 * 2; const char* cB = (const char*)g.Bt + (size_t)cur.pn * tstep + (size_t)cur.k0 * 2;
    S.a_ready(cur);
    if constexpr (SP2) {
        PG8_STAGE(PG8_SB(0, 0), cB, voffB); PG8_STAGE(PG8_SB(0, 1), cB + hstep, voffB); PG8_STAGE(PG8_SA(0, 0), cA, voffA); PG8_STAGE(PG8_SA(0, 1), cA + hstep, voffA);
        if (wr == 1) PG8_BAR;
        PG8_WAIT_V(2); PG8_BAR;
        PG8_STAGE(PG8_SB(1, 0), cB + kstep, voffB); PG8_STAGE(PG8_SA(1, 0), cA + kstep, voffA); PG8_STAGE(PG8_SB(1, 1), cB + hstep + kstep, voffB);
        PG8_WAIT_V(6); PG8_BAR;
    } else {
        PG8_STAGE(PG8_SB(0, 0), cB, voffB); PG8_STAGE(PG8_SA(0, 0), cA, voffA); PG8_STAGE(PG8_SB(0, 1), cB + hstep, voffB); PG8_STAGE(PG8_SA(0, 1), cA + hstep, voffA);
        if (wr == 1) PG8_BAR;
        PG8_WAIT_V(4); PG8_BAR;
        PG8_STAGE(PG8_SB(1, 0), cB + kstep, voffB); PG8_STAGE(PG8_SA(1, 0), cA + kstep, voffA); PG8_STAGE(PG8_SB(1, 1), cB + hstep + kstep, voffB);
        PG8_WAIT_V(6); PG8_BAR;
    }
    for (;;) {
        const bool has_next = S.next(ui + 1, nxt);
        const char* nA = has_next ? (const char*)g.A + (size_t)nxt.pm * tstep + (size_t)nxt.k0 * 2 : cA; const char* nB = has_next ? (const char*)g.Bt + (size_t)nxt.pn * tstep + (size_t)nxt.k0 * 2 : cB;
        const int nt = cur.nt;
        for (int t = 0; t < nt; t += 2) {
            const bool last = (t == nt - 2);
            const char* a1 = cA + (size_t)(t + 1) * kstep;
            const char* a2 = last ? nA : cA + (size_t)(t + 2) * kstep; const char* b2 = last ? nB : cB + (size_t)(t + 2) * kstep;
            const char* a3 = a2 + kstep; const char* b3 = b2 + kstep;
            if (last && has_next) S.a_ready(nxt);
            if constexpr (SP2) {
            PG8_LDB(B0, 0, 0); PG8_LDB(B1, 0, 1); PG8_SCHED; PG8_LDA(At, 0, 0); PG8_STAGE(PG8_SA(1, 1), a1 + hstep, voffA);
            PG8_WAIT_V(8); PG8_WAIT_L(0); PG8_BAR; PG8_MMA(0, 0, At, B0); PG8_MMA(0, 1, At, B1); PG8_BAR; PG8_SCHED;
            PG8_LDA(At, 0, 1); PG8_STAGE(PG8_SB(0, 0), b2, voffB); PG8_STAGE(PG8_SB(0, 1), b2 + hstep, voffB); PG8_STAGE(PG8_SA(0, 0), a2, voffA);
            PG8_WAIT_V(8); PG8_WAIT_L(0); PG8_BAR; PG8_MMA(1, 0, At, B0); PG8_MMA(1, 1, At, B1); PG8_BAR; PG8_SCHED;
            PG8_LDB(B0, 1, 0); PG8_LDB(B1, 1, 1); PG8_SCHED; PG8_LDA(At, 1, 0); PG8_STAGE(PG8_SA(0, 1), a2 + hstep, voffA);
            PG8_WAIT_V(8); PG8_WAIT_L(0); PG8_BAR; PG8_MMA(0, 0, At, B0); PG8_MMA(0, 1, At, B1); PG8_BAR; PG8_SCHED;
            PG8_LDA(At, 1, 1); PG8_STAGE(PG8_SB(1, 0), b3, voffB); PG8_STAGE(PG8_SB(1, 1), b3 + hstep, voffB); PG8_STAGE(PG8_SA(1, 0), a3, voffA);
            PG8_WAIT_V(8); PG8_WAIT_L(0); PG8_BAR; PG8_MMA(1, 0, At, B0); PG8_MMA(1, 1, At, B1); PG8_BAR; PG8_SCHED;
            } else {
            PG8_LDB(B0, 0, 0); PG8_SCHED; PG8_LDA(At, 0, 0); PG8_STAGE(PG8_SA(1, 1), a1 + hstep, voffA);
            PG8_WAIT_L(8); PG8_BAR; PG8_WAIT_L(0); PG8_MMA(0, 0, At, B0); PG8_BAR; PG8_SCHED;
            PG8_LDB(B1, 0, 1); PG8_STAGE(PG8_SB(0, 0), b2, voffB);
            PG8_BAR; PG8_WAIT_L(0); PG8_MMA(0, 1, At, B1); PG8_BAR;
            PG8_LDA(At, 0, 1); PG8_STAGE(PG8_SA(0, 0), a2, voffA);
            PG8_BAR; PG8_WAIT_L(0); PG8_MMA(1, 0, At, B0); PG8_BAR; PG8_SCHED;
            PG8_STAGE(PG8_SB(0, 1), b2 + hstep, voffB);
            PG8_WAIT_V(6); PG8_BAR; PG8_MMA(1, 1, At, B1); PG8_BAR;
            PG8_LDB(B0, 1, 0); PG8_SCHED; PG8_LDA(At, 1, 0); PG8_STAGE(PG8_SA(0, 1), a2 + hstep, voffA);
            PG8_WAIT_L(8); PG8_BAR; PG8_WAIT_L(0); PG8_MMA(0, 0, At, B0); PG8_BAR; PG8_SCHED;
            PG8_LDB(B1, 1, 1); PG8_STAGE(PG8_SB(1, 0), b3, voffB);
            PG8_BAR; PG8_WAIT_L(0); PG8_MMA(0, 1, At, B1); PG8_BAR;
            PG8_LDA(At, 1, 1); PG8_STAGE(PG8_SA(1, 0), a3, voffA);
            PG8_BAR; PG8_WAIT_L(0); PG8_MMA(1, 0, At, B0); PG8_BAR; PG8_SCHED;
            PG8_STAGE(PG8_SB(1, 1), b3 + hstep, voffB);
            PG8_WAIT_V(6); PG8_BAR; PG8_MMA(1, 1, At, B1); PG8_BAR;
            }
        }
        if constexpr (ALIGN_EPI) { if (wr == 0) PG8_BAR; }
        if constexpr (!Epi::AFTER_DRAIN) { E(acc, cur, wr, wc, fr, fq); S.done(cur); }
        if (!has_next) break;
#pragma unroll
        for (int a = 0; a < 2; ++a)
#pragma unroll
            for (int b = 0; b < 2; ++b)
#pragma unroll
                for (int m = 0; m < 4; ++m)
#pragma unroll
                    for (int n = 0; n < 2; ++n) acc[a][b][m][n] = (f32x4){0.f, 0.f, 0.f, 0.f};
        cur = nxt; cA = nA; cB = nB; ++ui;
        if constexpr (ALIGN_EPI) { if (wr == 1) PG8_BAR; }
    }
    PG8_WAIT_V(0);
    if constexpr (!ALIGN_EPI) { if (wr == 0) PG8_BAR; }
    PG8_BAR;
    if constexpr (Epi::AFTER_DRAIN) { E.fused(acc, cur, wr, wc, fr, fq, lds, wid, lane); S.done(cur); }
#undef PG8_SA
#undef PG8_SB
#undef PG8_STAGE
#undef PG8_LDA
#undef PG8_LDB
#undef PG8_MMA
#undef PG8_WAIT_V
#undef PG8_WAIT_L
#undef PG8_BAR
#undef PG8_SCHED
}
}
#define GAS __attribute__((address_space(1)))
#define LAS __attribute__((address_space(3)))
typedef unsigned short bf16;
typedef unsigned v4u __attribute__((ext_vector_type(4)));
typedef float f32x4 __attribute__((ext_vector_type(4)));
typedef short bf16x8 __attribute__((ext_vector_type(8)));
typedef GAS unsigned gu32;
typedef GAS unsigned long long gu64;
#define RLX_AGENT __ATOMIC_RELAXED, __HIP_MEMORY_SCOPE_AGENT
#define LDS_WAIT() asm volatile("s_waitcnt lgkmcnt(0)" ::: "memory")
#define VM_WAIT() asm volatile("s_waitcnt vmcnt(0)" ::: "memory")
__device__ __forceinline__ unsigned long long rt() { return __builtin_amdgcn_s_memrealtime(); }
__device__ __forceinline__ unsigned f2bf(float f) { unsigned u = __builtin_bit_cast(unsigned, f); return (u + 0x7fffu + ((u >> 16) & 1u)) >> 16; }
__device__ __forceinline__ unsigned pk2(float lo, float hi) { return f2bf(lo) | (f2bf(hi) << 16); }

#define XB_TMO      128
#define XB_XCNT(j)  (256  + 64 * (j))
#define XB_XSUB(j)  (1280 + 64 * (j))
#define XB_XGEN(j)  (2304 + 64 * (j))
#define XB_TOP      3328
#define XB_TOPGEN   3392
#define XCD_BAR_WORDS 3456
#define XB_SPIN_CAP (1u << 18)

__device__ __forceinline__ unsigned xb_ld(unsigned* p)              { return __hip_atomic_load(p, __ATOMIC_RELAXED, __HIP_MEMORY_SCOPE_AGENT); }
__device__ __forceinline__ unsigned xb_add(unsigned* p, unsigned v) { return __hip_atomic_fetch_add(p, v, __ATOMIC_RELAXED, __HIP_MEMORY_SCOPE_AGENT); }
__device__ __forceinline__ unsigned xb_xcc_id() { return (unsigned)__builtin_amdgcn_s_getreg((3 << 11) | 20) & 0xFu; }
#define XB_SPIN(cond, bar) do { unsigned _sp = 0; while (cond) { __builtin_amdgcn_s_sleep(1); \
    if ((++_sp & 255u) == 0u) { if (xb_ld(&(bar)[XB_TMO])) break; if (_sp > XB_SPIN_CAP) { atomicAdd(&(bar)[XB_TMO], 1u); break; } } } } while (0)

struct XcdBarrier {
    unsigned* bar; unsigned x;
    volatile LAS unsigned* st;
};

__device__ __forceinline__ XcdBarrier xcd_barrier_post(unsigned* bar, volatile LAS unsigned* st) {
    XcdBarrier b; b.bar = bar; b.x = xb_xcc_id(); b.st = st;
    if (threadIdx.x == 0) (void)xb_add(&bar[XB_XCNT(b.x)], 1u);
    return b;
}
__device__ __forceinline__ void xcd_barrier_complete(unsigned* bar, unsigned x, unsigned& nloc, unsigned& nx) {
    const unsigned G = gridDim.x * gridDim.y * gridDim.z;
    unsigned sum, cnt, mine, sp = 0u;
    for (;;) {
        sum = 0u; cnt = 0u; mine = 0u;
#pragma unroll
        for (unsigned j = 0; j < 16; ++j) { const unsigned c = xb_ld(&bar[XB_XCNT(j)]); sum += c; cnt += (c > 0u) ? 1u : 0u; mine = (j == x) ? c : mine; }
        if (sum == G) break;
        __builtin_amdgcn_s_sleep(1);
        if ((++sp & 255u) == 0u) { if (xb_ld(&bar[XB_TMO])) break; if (sp > XB_SPIN_CAP) { atomicAdd(&bar[XB_TMO], 1u); break; } }
    }
    nloc = mine > 0u ? mine : 1u; nx = cnt > 0u ? cnt : 1u;
}

__device__ __forceinline__ void xcd_barrier(const XcdBarrier& b) {
    asm volatile("s_waitcnt vmcnt(0)" ::: "memory");
    __syncthreads();
    if (threadIdx.x == 0) {
        unsigned* bar = b.bar;
        __builtin_amdgcn_s_waitcnt(0);
        unsigned nloc = b.st[0], nx = b.st[1];
        if (nloc == 0u) { xcd_barrier_complete(bar, b.x, nloc, nx); b.st[0] = nloc; b.st[1] = nx; }
        const unsigned old = xb_add(&bar[XB_XSUB(b.x)], 1u);
        const unsigned gen = old / nloc;
        if (old + 1u == (gen + 1u) * nloc) {
            __builtin_amdgcn_fence(__ATOMIC_RELEASE, "agent");
            asm volatile("s_waitcnt vmcnt(0)" ::: "memory");
            const unsigned og = xb_add(&bar[XB_TOP], 1u);
            const unsigned tg = og / nx;
            if (og + 1u == (tg + 1u) * nx) xb_add(&bar[XB_TOPGEN], 1u);
            else XB_SPIN(xb_ld(&bar[XB_TOPGEN]) == tg, bar);
            __builtin_amdgcn_fence(__ATOMIC_ACQUIRE, "agent");
            xb_add(&bar[XB_XGEN(b.x)], 1u);
            asm volatile("s_waitcnt vmcnt(0)" ::: "memory");
        } else {
            XB_SPIN(xb_ld(&bar[XB_XGEN(b.x)]) == gen, bar);
            __builtin_amdgcn_fence(__ATOMIC_ACQUIRE, "agent");
            asm volatile("s_waitcnt vmcnt(0)" ::: "memory");
        }
    }
    __syncthreads();
}
constexpr int NWAVES = 8;
constexpr int DM = 1024, TP = 2048, NBP = 8, MP = NBP * TP, NBS = 128, TS = 8, MS = NBS * TS, M = MP + MS, FF = 2816, NG1 = 2 * FF;
constexpr int NIN = 3088, NINP = 3328, NPROJ = 3072, DK = 128, DV = 256, NH = 4;
constexpr float EPS = 1e-6f;
static_assert(M == 68 * 256, "row tiles");
constexpr size_t O_YP = 0, O_YS = (size_t)MP * DM, O_NPP = O_YS + (size_t)MS * DM, O_NGP = O_NPP + (size_t)2 * NBP * 15 * DM, O_NPS = O_NGP + (size_t)2 * NBP * NH * DK * DV,
                 O_NGS = O_NPS + (size_t)2 * NBS * 15 * DM, O_END = O_NGS + (size_t)2 * NBS * NH * DK * DV;
constexpr size_t MiB = 1u << 20;
constexpr size_t WS_CTL = 0, CTL_ZERO_BYTES = 1 * MiB;
constexpr size_t SZ_W13 = (size_t)NG1 * DM * 2, SZ_W2 = (size_t)DM * FF * 2, SZ_WIN = (size_t)NINP * DM * 2, SZ_WO = (size_t)DM * DM * 2, SZ_WP = (size_t)4 * 256 * 256 * 2;
constexpr size_t WS_W13 = 1 * MiB, WS_W2 = WS_W13 + 4 * SZ_W13, WS_WIN = WS_W2 + 4 * SZ_W2, WS_WO = WS_WIN + 2 * SZ_WIN, WS_WP = WS_WO + 2 * SZ_WO;
constexpr size_t WS_H = WS_WP + 2 * SZ_WP;
constexpr size_t WS_BIG = WS_H + (size_t)M * DM * 2;
constexpr size_t WS_ALOW = WS_BIG + (size_t)M * NPROJ * 2;
constexpr size_t WS_DS = WS_ALOW + (size_t)M * 16 * 4;
constexpr size_t WS_DSC = WS_DS + (size_t)32 * 7 * DK * DV * 4;
constexpr size_t WS_END = WS_DSC + (size_t)32 * 7 * DK * 4;
static_assert(WS_END <= 256 * MiB, "d_ws map");
static_assert(WS_H % 256 == 0 && WS_BIG % 256 == 0 && WS_ALOW % 256 == 0 && WS_DS % 256 == 0 && WS_DSC % 256 == 0, "alignment");
constexpr int CW_BAR = 4096;
constexpr int RING_BYTES = 131072, LDSCTL_OFF = RING_BYTES, MISC_OFF = LDSCTL_OFF + 320, LDS_BYTES = 147456;

__device__ __forceinline__ float wave_sum(float v) {
#pragma unroll
    for (int o = 1; o < 64; o <<= 1) v += __shfl_xor(v, o);
    return v;
}
__device__ __forceinline__ float bf2f(unsigned short b) { return __builtin_bit_cast(float, (unsigned)b << 16); }

__device__ __forceinline__ void tr_item(const float* W, int K, int N, bf16* WT, int mode, int row_off, LAS float* scr, int item, int lane) {
    const int nblk = (N + 31) >> 5, kb = item / nblk, nb = item - kb * nblk, k0 = 64 * kb, n0 = 32 * nb;
    const int nn = n0 + (lane & 31); const bool ok = nn < N;
    float wv[32];
#pragma unroll
    for (int i = 0; i < 32; ++i) { const int kk = 2 * i + (lane >> 5); wv[i] = ok ? W[(size_t)(k0 + kk) * N + nn] : 0.f; }
#pragma unroll
    for (int i = 0; i < 32; ++i) { const int kk = 2 * i + (lane >> 5); scr[kk * 33 + (lane & 31)] = wv[i]; }
    LDS_WAIT(); asm volatile("" ::: "memory");
    const int c = lane & 7;
#pragma unroll
    for (int j = 0; j < 4; ++j) { const int n = (lane >> 3) + 8 * j; const LAS float* s = scr + (8 * c) * 33 + n;
        v4u o; o.x = pk2(s[0 * 33], s[1 * 33]); o.y = pk2(s[2 * 33], s[3 * 33]); o.z = pk2(s[4 * 33], s[5 * 33]); o.w = pk2(s[6 * 33], s[7 * 33]);
        const int ng = n0 + n; const int row = mode ? (((ng >> 7) << 8) + (ng & 127) + row_off) : (row_off + ng);
        *(v4u*)(WT + (size_t)row * K + k0 + 8 * c) = o; }
    LDS_WAIT(); asm volatile("" ::: "memory");
}
__device__ __forceinline__ void p0_weights(LAS unsigned char* lds, int wave, int lane, int gw, int NGW, const float* const* in, unsigned char* ws) {
    LAS float* scr = (LAS float*)(lds + wave * 16384);
    constexpr int I_W1 = (DM / 64) * (FF / 32), I_W2 = (FF / 64) * (DM / 32), I_WIN = (DM / 64) * ((NIN + 31) / 32), I_WO = (DM / 64) * (DM / 32), I_WP = (256 / 64) * (256 / 32);
    constexpr int N_FFN = 4 * (2 * I_W1 + I_W2), N_GLA = 2 * (I_WIN + I_WO), N_POOL = 8 * I_WP, NITEMS = N_FFN + N_GLA + N_POOL;
    for (int it = gw; it < NITEMS; it += NGW) {
        int r = it;
        if (r < N_FFN) { const int L = r / (2 * I_W1 + I_W2); r -= L * (2 * I_W1 + I_W2);
            if (r < I_W1) { tr_item(in[14] + (size_t)L * DM * FF, DM, FF, (bf16*)(ws + WS_W13 + L * SZ_W13), 1, 0, scr, r, lane); continue; } r -= I_W1;
            if (r < I_W1) { tr_item(in[15] + (size_t)L * DM * FF, DM, FF, (bf16*)(ws + WS_W13 + L * SZ_W13), 1, 128, scr, r, lane); continue; } r -= I_W1;
            tr_item(in[16] + (size_t)L * FF * DM, FF, DM, (bf16*)(ws + WS_W2 + L * SZ_W2), 0, 0, scr, r, lane); continue; }
        r -= N_FFN;
        if (r < N_GLA) { const int L = r / (I_WIN + I_WO); r -= L * (I_WIN + I_WO);
            if (r < I_WIN) { tr_item(in[9] + (size_t)L * DM * NIN, DM, NIN, (bf16*)(ws + WS_WIN + L * SZ_WIN), 0, 0, scr, r, lane); continue; } r -= I_WIN;
            tr_item(in[13] + (size_t)L * DM * DM, DM, DM, (bf16*)(ws + WS_WO + L * SZ_WO), 0, 0, scr, r, lane); continue; }
        r -= N_GLA;
        { const int jg = r / I_WP; r -= jg * I_WP;
          tr_item(in[7] + (size_t)jg * 65536, 256, 256, (bf16*)(ws + WS_WP + (jg >> 2) * SZ_WP), 0, (jg & 3) * 256, scr, r, lane); }
    }
    constexpr int PADV = (NINP - 3104) * DM * 2 / 16;
    for (int i = gw * 64 + lane; i < 2 * PADV; i += NGW * 64) { const int L = i / PADV, e = i - L * PADV;
        ((v4u*)(ws + WS_WIN + L * SZ_WIN + (size_t)3104 * DM * 2))[e] = (v4u){0u, 0u, 0u, 0u}; }
}

__device__ __forceinline__ void rms_row_bf16(const float* xrow, const float* g, bf16* orow, int lane) {
    const f32x4* xr = (const f32x4*)xrow + lane; const f32x4* gr = (const f32x4*)g + lane;
    f32x4 v[4]; float s = 0.f;
#pragma unroll
    for (int j = 0; j < 4; ++j) { v[j] = xr[64 * j]; s += (v[j].x * v[j].x + v[j].y * v[j].y) + (v[j].z * v[j].z + v[j].w * v[j].w); }
    const float rstd = rsqrtf(wave_sum(s) * (1.f / DM) + EPS);
    unsigned long long* o8 = (unsigned long long*)orow + lane;
#pragma unroll
    for (int j = 0; j < 4; ++j) { const f32x4 gg = gr[64 * j]; const f32x4 y = v[j] * rstd * gg;
        o8[64 * j] = (unsigned long long)pk2(y.x, y.y) | ((unsigned long long)pk2(y.z, y.w) << 32); }
}
__device__ __forceinline__ void rms_phase(int gw, int NGW, int lane, const float* X, const float* g, bf16* H) {
    for (int m = gw; m < M; m += NGW) rms_row_bf16(X + (size_t)m * DM, g, H + (size_t)m * DM, lane);
}
__device__ __forceinline__ void final_norm_phase(int gw, int NGW, int lane, float* X, const float* g) {
    for (int m = gw; m < M; m += NGW) {
        f32x4* xr = (f32x4*)(X + (size_t)m * DM) + lane; const f32x4* gr = (const f32x4*)g + lane;
        f32x4 v[4]; float s = 0.f;
#pragma unroll
        for (int j = 0; j < 4; ++j) { v[j] = xr[64 * j]; s += (v[j].x * v[j].x + v[j].y * v[j].y) + (v[j].z * v[j].z + v[j].w * v[j].w); }
        const float rstd = rsqrtf(wave_sum(s) * (1.f / DM) + EPS);
#pragma unroll
        for (int j = 0; j < 4; ++j) xr[64 * j] = v[j] * rstd * gr[64 * j];
    }
}

__device__ __forceinline__ void small_gemm_res(LAS unsigned char* lds, const bf16* A, const bf16* Bt, int K, float* X, int tid, int wave, int G, int bid) {
    constexpr int RS = 272, BUF = 2 * 64 * RS;
    const int lane = tid & 63, fr = lane & 15, fq = lane >> 4, rt = wave & 3, ch = wave >> 2;
    const int lr = tid >> 3, lc = (tid & 7) * 16;
    const int nch = K >> 7;
    for (int L = bid; L < 256; L += G) {
        const int tm = L >> 4, tn = L & 15;
        const v4u* ag = (const v4u*)(A + (size_t)(tm * 64 + lr) * K + lc); const v4u* bg = (const v4u*)(Bt + (size_t)(tn * 64 + lr) * K + lc);
        LAS unsigned char* wa = lds + lr * RS + lc * 2; LAS unsigned char* wb = wa + 64 * RS;
        v4u pa[2], pb[2], qa[2], qb[2];
        { const v4u a0 = ag[0], a1 = ag[1], b0 = bg[0], b1 = bg[1];
          pa[0] = ag[16]; pa[1] = ag[17]; pb[0] = bg[16]; pb[1] = bg[17];
          qa[0] = ag[32]; qa[1] = ag[33]; qb[0] = bg[32]; qb[1] = bg[33];
          *(LAS v4u*)wa = a0; *(LAS v4u*)(wa + 16) = a1; *(LAS v4u*)wb = b0; *(LAS v4u*)(wb + 16) = b1; }
        __syncthreads();
        f32x4 acc0 = (f32x4){0.f, 0.f, 0.f, 0.f}, acc1 = (f32x4){0.f, 0.f, 0.f, 0.f};
#define SG_COMPUTE(bufoff) { _Pragma("unroll") for (int ks = 0; ks < 4; ++ks) { const bf16x8 a = *(const LAS bf16x8*)(lds + (bufoff) + (16 * rt + fr) * RS + (32 * ks + 8 * fq) * 2); \
            const bf16x8 b0 = *(const LAS bf16x8*)(lds + (bufoff) + 64 * RS + (32 * ch + fr) * RS + (32 * ks + 8 * fq) * 2), b1 = *(const LAS bf16x8*)(lds + (bufoff) + 64 * RS + (32 * ch + 16 + fr) * RS + (32 * ks + 8 * fq) * 2); \
            acc0 = __builtin_amdgcn_mfma_f32_16x16x32_bf16(b0, a, acc0, 0, 0, 0); acc1 = __builtin_amdgcn_mfma_f32_16x16x32_bf16(b1, a, acc1, 0, 0, 0); } }
        for (int kc = 0; kc < nch; kc += 2) {
            SG_COMPUTE(0)
            *(LAS v4u*)(wa + BUF) = pa[0]; *(LAS v4u*)(wa + BUF + 16) = pa[1]; *(LAS v4u*)(wb + BUF) = pb[0]; *(LAS v4u*)(wb + BUF + 16) = pb[1];
            if (kc + 3 < nch) { pa[0] = ag[16 * (kc + 3)]; pa[1] = ag[16 * (kc + 3) + 1]; pb[0] = bg[16 * (kc + 3)]; pb[1] = bg[16 * (kc + 3) + 1]; }
            __syncthreads();
            SG_COMPUTE(BUF)
            if (kc + 2 < nch) { *(LAS v4u*)wa = qa[0]; *(LAS v4u*)(wa + 16) = qa[1]; *(LAS v4u*)wb = qb[0]; *(LAS v4u*)(wb + 16) = qb[1]; }
            if (kc + 4 < nch) { qa[0] = ag[16 * (kc + 4)]; qa[1] = ag[16 * (kc + 4) + 1]; qb[0] = bg[16 * (kc + 4)]; qb[1] = bg[16 * (kc + 4) + 1]; }
            __syncthreads();
        }
#undef SG_COMPUTE
        float* o = X + (size_t)(tm * 64 + 16 * rt + fr) * DM + tn * 64 + 32 * ch + 4 * fq;
        *(f32x4*)o = *(const f32x4*)o + acc0; *(f32x4*)(o + 16) = *(const f32x4*)(o + 16) + acc1;
    }
    __syncthreads();
}

__device__ __forceinline__ void pool_prep(LAS unsigned char* lds, int tid, int wave, int lane, int G, int bid,
                                          const float* xp, const float* xs, const float* gmix, const float* spool, bf16* DIFF, float* onp, float* ons) {
    typedef float f32x2 __attribute__((ext_vector_type(2)));
    LAS float* hb = (LAS float*)lds;
    for (int u = bid; u < 1024 + NBS; u += G) {
        const bool pr = u < 1024; const int b = pr ? (u >> 7) : (u - 1024); const int t0 = pr ? (u & 127) * 16 : 0; const int ntok = pr ? 16 : 8;
        {
            f32x4 v[4][4]; bool has[4], donorm[4];
#pragma unroll
            for (int k = 0; k < 4; ++k) { const int r = wave + 8 * k; const float* src = nullptr; donorm[k] = true;
                if (r < 15 + ntok) {
                    if (pr) { const int t = t0 - 15 + r; if (t >= 0) src = xp + ((size_t)b * TP + t) * DM; }
                    else { if (r < 15) { src = spool + ((size_t)b * 15 + r) * DM; donorm[k] = false; } else src = xs + ((size_t)b * TS + (r - 15)) * DM; } }
                has[k] = src != nullptr;
#pragma unroll
                for (int j = 0; j < 4; ++j) v[k][j] = has[k] ? ((const f32x4*)src + lane)[64 * j] : (f32x4){0.f, 0.f, 0.f, 0.f}; }
            const f32x4* gr = (const f32x4*)gmix + lane;
#pragma unroll
            for (int k = 0; k < 4; ++k) { const int r = wave + 8 * k;
                if (r < 15 + ntok) { float s = 0.f;
#pragma unroll
                    for (int j = 0; j < 4; ++j) s += (v[k][j].x * v[k][j].x + v[k][j].y * v[k][j].y) + (v[k][j].z * v[k][j].z + v[k][j].w * v[k][j].w);
                    const float rstd = (has[k] && donorm[k]) ? rsqrtf(wave_sum(s) * (1.f / DM) + EPS) : 1.f;
                    LAS f32x4* hrow = (LAS f32x4*)(hb + r * DM) + lane;
#pragma unroll
                    for (int j = 0; j < 4; ++j) hrow[64 * j] = (has[k] && donorm[k]) ? v[k][j] * rstd * gr[64 * j] : v[k][j]; } }
        }
        __syncthreads();
        const int c = 2 * tid, gi = tid >> 7, w = 2 << gi;
        f32x2 sum = (f32x2){0.f, 0.f};
        for (int l = 1; l < w; ++l) sum += *(const LAS f32x2*)(hb + (15 - l) * DM + c);
        for (int i = 0; i < ntok; ++i) {
            const f32x2 cur = *(const LAS f32x2*)(hb + (15 + i) * DM + c); sum += cur;
            const int cnt = pr ? ((t0 + i + 1) < w ? (t0 + i + 1) : w) : w; const float inv = 1.0f / (float)cnt;
            const f32x2 d = sum * inv - cur;
            const size_t row = pr ? ((size_t)b * TP + t0 + i) : ((size_t)MP + b * TS + i);
            *(unsigned*)(DIFF + ((size_t)gi * M + row) * 256 + (c & 255)) = pk2(d.x, d.y);
            sum -= *(const LAS f32x2*)(hb + (15 + i - w + 1) * DM + c);
        }
        if (pr) { if (t0 == TP - 16) for (int i = 1; i < 16; ++i) *(f32x2*)(onp + ((size_t)b * 15 + (i - 1)) * DM + c) = *(const LAS f32x2*)(hb + (15 + i) * DM + c); }
        else for (int i = 0; i < 15; ++i) *(f32x2*)(ons + ((size_t)b * 15 + i) * DM + c) = *(const LAS f32x2*)(hb + (8 + i) * DM + c);
        __syncthreads();
    }
}

constexpr int L_QH = 0, L_KH = 17408, L_KT = 34816, L_VT = 53248, L_AL = 90112, L_ALOW = 99328, L_DL = 105472, L_SSQ = 105984, L_TOT = 108032, L_WA = 112128, L_BA = 120320, L_NW = 120832, L_GLA_END = 121856;
constexpr int QS = 272, TSB = 144;
static_assert(L_GLA_END <= RING_BYTES, "GLA LDS");
__device__ __forceinline__ bf16x8 pack8(const f32x4 a, const f32x4 b) {
    v4u w; w.x = pg8::cvt_pk_bf16(a[0], a[1]); w.y = pg8::cvt_pk_bf16(a[2], a[3]); w.z = pg8::cvt_pk_bf16(b[0], b[1]); w.w = pg8::cvt_pk_bf16(b[2], b[3]);
    return __builtin_bit_cast(bf16x8, w);
}
__device__ __forceinline__ void gla_phase(LAS unsigned char* lds, int tid, int wave, int lane, int G, int bid, int phase, int jl,
                                          const float* const* in, float* out, unsigned char* ws) {
    typedef unsigned u32x2 __attribute__((ext_vector_type(2)));
    const bf16* PROJ = (const bf16*)(ws + WS_BIG); const float* ALOW = (const float*)(ws + WS_ALOW); bf16* GOUT = (bf16*)(ws + WS_H);
    float* DS = (float*)(ws + WS_DS); float* DSC = (float*)(ws + WS_DSC);
    const int nitems = phase == 0 ? (224 + 4 * NBS) : 256;
    const int tid_in = tid;
    for (int item = bid; item < nitems; item += G) {
        int tid = tid_in; asm volatile("" : "+v"(tid));
        int lane = tid & 63, fr = lane & 15, fq = lane >> 4;
        int b, h, row0, ntok, sc = 0; bool want_out, samp = false;
        if (phase == 0) { if (item < 224) { const int bh = item / 7; sc = item - bh * 7; b = bh >> 2; h = bh & 3; row0 = b * TP + sc * 256; ntok = 256; want_out = false; }
                          else { const int q = item - 224; b = q >> 2; h = q & 3; row0 = MP + b * TS; ntok = TS; want_out = true; samp = true; } }
        else { const int bh = item >> 3; sc = item & 7; b = bh >> 2; h = bh & 3; row0 = b * TP + sc * 256; ntok = 256; want_out = true; }
        const int bh = b * 4 + h;
        f32x4 S[8][2];
#pragma unroll
        for (int dt = 0; dt < 8; ++dt)
#pragma unroll
            for (int vt = 0; vt < 2; ++vt) S[dt][vt] = (f32x4){0.f, 0.f, 0.f, 0.f};
        if (samp) {
            const float* s0 = in[3] + ((size_t)(jl * NBS + b) * NH + h) * DK * DV;
#pragma unroll
            for (int dt = 0; dt < 8; ++dt)
#pragma unroll
                for (int vt = 0; vt < 2; ++vt)
#pragma unroll
                    for (int e = 0; e < 4; ++e) S[dt][vt][e] = s0[(size_t)(16 * dt + 4 * fq + e) * DV + 32 * wave + 16 * vt + fr];
        } else if (phase == 1 && sc > 0) {
            const float* dsp = DS + (size_t)(bh * 7 + sc - 1) * DK * DV;
#pragma unroll
            for (int dt = 0; dt < 8; ++dt)
#pragma unroll
                for (int vt = 0; vt < 2; ++vt) S[dt][vt] = *(const f32x4*)(dsp + (size_t)(((wave * 8 + dt) * 2 + vt) * 64 + lane) * 4);
        }
        { const int r = tid >> 5, d4 = (tid & 31) * 4;
          *(LAS f32x4*)(lds + L_WA + (r * 128 + d4) * 4) = *(const f32x4*)(in[10] + (size_t)jl * 16 * 512 + r * 512 + h * DK + d4) * 1.4426950408889634f;
          if (tid < 32) *(LAS f32x4*)(lds + L_BA + tid * 16) = *(const f32x4*)(in[11] + jl * 512 + h * DK + tid * 4) * 1.4426950408889634f;
          if (tid < 64) *(LAS f32x4*)(lds + L_NW + tid * 16) = *(const f32x4*)(in[12] + jl * DM + h * DV + tid * 4); }
        float btot0 = 0.f, btot1 = 0.f;
        const int nsub = (ntok + 63) >> 6;
        unsigned qn[8], kn[8]; v4u vn[4]; f32x4 aln;
#define GLA_LOAD(sbx) { const int tokv_ = (ntok - 64 * (sbx)) < 64 ? (ntok - 64 * (sbx)) : 64; const int rb_ = row0 + 64 * (sbx); const int dp_ = tid & 63, jp_ = tid & 31, vg_ = tid >> 5; \
            _Pragma("unroll") for (int i = 0; i < 8; ++i) { const int tok = 8 * wave + i; qn[i] = 0u; kn[i] = 0u; \
                if (tok < tokv_) { const unsigned* pr = (const unsigned*)(PROJ + (size_t)(rb_ + tok) * NPROJ + h * DK) + dp_; qn[i] = pr[0]; kn[i] = pr[256]; } } \
            _Pragma("unroll") for (int i = 0; i < 2; ++i) { const int tok = 2 * jp_ + i; vn[2 * i] = (v4u){0u, 0u, 0u, 0u}; vn[2 * i + 1] = (v4u){0u, 0u, 0u, 0u}; \
                if (tok < tokv_) { const v4u* pv = (const v4u*)(PROJ + (size_t)(rb_ + tok) * NPROJ + 1024 + h * DV + 16 * vg_); vn[2 * i] = pv[0]; vn[2 * i + 1] = pv[1]; } } \
            aln = (f32x4){0.f, 0.f, 0.f, 0.f}; if (tid < 256) { const int tok = tid >> 2; if (tok < tokv_) aln = *(const f32x4*)(ALOW + (size_t)(rb_ + tok) * 16 + 4 * (tid & 3)); } }
        GLA_LOAD(0)
        for (int sb = 0; sb < nsub; ++sb) {
            typedef float f32x2 __attribute__((ext_vector_type(2)));
            const int tokv = (ntok - 64 * sb) < 64 ? (ntok - 64 * sb) : 64; const int rbase = row0 + 64 * sb;
            asm volatile("" : "+v"(tid)); lane = tid & 63; fr = lane & 15; fq = lane >> 4;
            const int dp = tid & 63, jp = tid & 31, vg = tid >> 5;
            if (tid < 256) *(LAS f32x4*)(lds + L_ALOW + (tid >> 2) * 64 + 16 * (tid & 3)) = aln;
            __syncthreads();
            f32x2 bj[8];
            { f32x2 x[8]; const f32x2 bav = *(const LAS f32x2*)(lds + L_BA + dp * 8);
#pragma unroll
              for (int i = 0; i < 8; ++i) x[i] = bav;
#pragma unroll
              for (int r4 = 0; r4 < 4; ++r4) { const f32x2 w0 = *(const LAS f32x2*)(lds + L_WA + ((4 * r4 + 0) * 128 + 2 * dp) * 4), w1 = *(const LAS f32x2*)(lds + L_WA + ((4 * r4 + 1) * 128 + 2 * dp) * 4),
                                                            w2 = *(const LAS f32x2*)(lds + L_WA + ((4 * r4 + 2) * 128 + 2 * dp) * 4), w3 = *(const LAS f32x2*)(lds + L_WA + ((4 * r4 + 3) * 128 + 2 * dp) * 4);
                  f32x4 al[8];
#pragma unroll
                  for (int i = 0; i < 8; ++i) al[i] = *(const LAS f32x4*)(lds + L_ALOW + (8 * wave + i) * 64 + 16 * r4);
#pragma unroll
                  for (int i = 0; i < 8; ++i) x[i] = w0 * al[i][0] + x[i];
#pragma unroll
                  for (int i = 0; i < 8; ++i) x[i] = w1 * al[i][1] + x[i];
#pragma unroll
                  for (int i = 0; i < 8; ++i) x[i] = w2 * al[i][2] + x[i];
#pragma unroll
                  for (int i = 0; i < 8; ++i) x[i] = w3 * al[i][3] + x[i]; }
              f32x2 run = (f32x2){0.f, 0.f};
#pragma unroll
              for (int i = 0; i < 8; ++i) { f32x2 g;
                  g.x = (fminf(x[i].x, 0.f) - __builtin_amdgcn_logf(1.0f + __builtin_amdgcn_exp2f(-fabsf(x[i].x)))) * (1.0f / 16.0f); g.y = (fminf(x[i].y, 0.f) - __builtin_amdgcn_logf(1.0f + __builtin_amdgcn_exp2f(-fabsf(x[i].y)))) * (1.0f / 16.0f);
                  if (tokv < 64 && 8 * wave + i >= tokv) g = (f32x2){0.f, 0.f};
                  run += g; bj[i] = run; }
              *(LAS f32x2*)(lds + L_TOT + (wave * 128 + 2 * dp) * 4) = run; }
            __syncthreads();
            f32x2 pre = (f32x2){0.f, 0.f}, blast = (f32x2){0.f, 0.f};
#pragma unroll
            for (int q = 0; q < 8; ++q) { const f32x2 t = *(const LAS f32x2*)(lds + L_TOT + (q * 128 + 2 * dp) * 4); blast += t; if (q < wave) pre += t; }
            btot0 += blast.x; btot1 += blast.y;
            if (wave == 0) *(LAS f32x2*)(lds + L_DL + dp * 8) = (f32x2){__builtin_amdgcn_exp2f(blast.x), __builtin_amdgcn_exp2f(blast.y)};
            { unsigned kb[8];
#pragma unroll
              for (int i = 0; i < 8; ++i) { const int tok = 8 * wave + i; const f32x2 bb = bj[i] + pre;
                  const float e1x = __builtin_amdgcn_exp2f(blast.x - bb.x), e1y = __builtin_amdgcn_exp2f(blast.y - bb.y), e2x = __builtin_amdgcn_exp2f(bb.x - blast.x), e2y = __builtin_amdgcn_exp2f(bb.y - blast.y);
                  const unsigned qh = pg8::cvt_pk_bf16(bf2f((unsigned short)(qn[i] & 0xffffu)) * e2x, bf2f((unsigned short)(qn[i] >> 16)) * e2y);
                  const unsigned kh = pg8::cvt_pk_bf16(bf2f((unsigned short)(kn[i] & 0xffffu)) * e1x, bf2f((unsigned short)(kn[i] >> 16)) * e1y);
                  *(LAS unsigned*)(lds + L_QH + tok * QS + dp * 4) = qh; *(LAS unsigned*)(lds + L_KH + tok * QS + dp * 4) = kh; kb[i] = kh; }
              v4u k0, k1;
              k0.x = (kb[0] & 0xffffu) | (kb[1] << 16); k0.y = (kb[2] & 0xffffu) | (kb[3] << 16); k0.z = (kb[4] & 0xffffu) | (kb[5] << 16); k0.w = (kb[6] & 0xffffu) | (kb[7] << 16);
              k1.x = (kb[0] >> 16) | (kb[1] & 0xffff0000u); k1.y = (kb[2] >> 16) | (kb[3] & 0xffff0000u); k1.z = (kb[4] >> 16) | (kb[5] & 0xffff0000u); k1.w = (kb[6] >> 16) | (kb[7] & 0xffff0000u);
              *(LAS v4u*)(lds + L_KT + (2 * dp) * TSB + wave * 16) = k0; *(LAS v4u*)(lds + L_KT + (2 * dp + 1) * TSB + wave * 16) = k1; }
            {
#pragma unroll
              for (int hv = 0; hv < 2; ++hv) { const unsigned a4[4] = {vn[hv].x, vn[hv].y, vn[hv].z, vn[hv].w}, b4[4] = {vn[2 + hv].x, vn[2 + hv].y, vn[2 + hv].z, vn[2 + hv].w};
#pragma unroll
                  for (int k = 0; k < 4; ++k) { LAS unsigned char* p = lds + L_VT + (16 * vg + 8 * hv + 2 * k) * TSB + jp * 4;
                      *(LAS unsigned*)p = (a4[k] & 0xffffu) | (b4[k] << 16); *(LAS unsigned*)(p + TSB) = (a4[k] >> 16) | (b4[k] & 0xffff0000u); } } }
            __syncthreads();
            u32x2 rcur[4][2];
            if (want_out) {
#pragma unroll
                for (int it = 0; it < 4; ++it)
#pragma unroll
                    for (int vt = 0; vt < 2; ++vt) { rcur[it][vt] = (u32x2){0u, 0u};
                        if (16 * it + fr < tokv) rcur[it][vt] = *(const u32x2*)(PROJ + (size_t)(rbase + 16 * it + fr) * NPROJ + 2048 + h * DV + 32 * wave + 16 * vt + 4 * fq); } }
            if (sb + 1 < nsub) GLA_LOAD(sb + 1)
#pragma unroll
            for (int dt = 0; dt < 8; ++dt) { const f32x4 dv = *(const LAS f32x4*)(lds + L_DL + (16 * dt + 4 * fq) * 4); S[dt][0] = S[dt][0] * dv; S[dt][1] = S[dt][1] * dv; }
            if (want_out) {
                f32x4 O[2][4];
#pragma unroll
                for (int tt = 0; tt < 2; ++tt) { const int idx = 2 * wave + tt, it = idx >> 2, jt = idx & 3; f32x4 a = (f32x4){0.f, 0.f, 0.f, 0.f};
                    if (jt <= it) {
#pragma unroll
                        for (int ks = 0; ks < 4; ++ks) { const bf16x8 X = *(const LAS bf16x8*)(lds + L_KH + (16 * jt + fr) * QS + (32 * ks + 8 * fq) * 2);
                            const bf16x8 Y = *(const LAS bf16x8*)(lds + L_QH + (16 * it + fr) * QS + (32 * ks + 8 * fq) * 2);
                            a = __builtin_amdgcn_mfma_f32_16x16x32_bf16(X, Y, a, 0, 0, 0); }
                        const int ii = 16 * it + fr, j0 = 16 * jt + 4 * fq;
#pragma unroll
                        for (int e = 0; e < 4; ++e) if (j0 + e > ii) a[e] = 0.f;
                    }
                    u32x2 w2; w2.x = pg8::cvt_pk_bf16(a[0], a[1]); w2.y = pg8::cvt_pk_bf16(a[2], a[3]);
                    *(LAS u32x2*)(lds + L_AL + (16 * it + fr) * TSB + (16 * jt + 4 * fq) * 2) = w2; }
                __syncthreads();
                {
                bf16x8 Xs[2][4];
#pragma unroll
                for (int vt = 0; vt < 2; ++vt)
#pragma unroll
                    for (int dp = 0; dp < 4; ++dp) Xs[vt][dp] = pack8(S[2 * dp][vt], S[2 * dp + 1][vt]);
                bf16x8 XV[2][2];
#pragma unroll
                for (int vt = 0; vt < 2; ++vt)
#pragma unroll
                    for (int js = 0; js < 2; ++js) XV[vt][js] = *(const LAS bf16x8*)(lds + L_VT + (32 * wave + 16 * vt + fr) * TSB + (32 * js + 8 * fq) * 2);
#pragma unroll
                for (int it = 0; it < 4; ++it) {
                    bf16x8 YQ[4], YA[2];
#pragma unroll
                    for (int dp = 0; dp < 4; ++dp) { const u32x2 lo = *(const LAS u32x2*)(lds + L_QH + (16 * it + fr) * QS + (32 * dp + 4 * fq) * 2);
                        const u32x2 hi = *(const LAS u32x2*)(lds + L_QH + (16 * it + fr) * QS + (32 * dp + 16 + 4 * fq) * 2);
                        YQ[dp] = __builtin_bit_cast(bf16x8, (v4u){lo.x, lo.y, hi.x, hi.y}); }
#pragma unroll
                    for (int js = 0; js < 2; ++js) YA[js] = *(const LAS bf16x8*)(lds + L_AL + (16 * it + fr) * TSB + (32 * js + 8 * fq) * 2);
#pragma unroll
                    for (int vt = 0; vt < 2; ++vt) { f32x4 o = (f32x4){0.f, 0.f, 0.f, 0.f};
#pragma unroll
                        for (int dp = 0; dp < 4; ++dp) o = __builtin_amdgcn_mfma_f32_16x16x32_bf16(Xs[vt][dp], YQ[dp], o, 0, 0, 0);
#pragma unroll
                        for (int js = 0; js < 2; ++js) o = __builtin_amdgcn_mfma_f32_16x16x32_bf16(XV[vt][js], YA[js], o, 0, 0, 0);
                        O[vt][it] = o; }
                    __builtin_amdgcn_sched_barrier(0);
                }
                }
#pragma unroll
                for (int it = 0; it < 4; ++it) { float ss = 0.f;
#pragma unroll
                    for (int vt = 0; vt < 2; ++vt) { const f32x4 o = O[vt][it]; ss += (o[0] * o[0] + o[1] * o[1]) + (o[2] * o[2] + o[3] * o[3]); }
                    ss += __shfl_xor(ss, 16); ss += __shfl_xor(ss, 32);
                    if (fq == 0) *(LAS float*)(lds + L_SSQ + (wave * 64 + 16 * it + fr) * 4) = ss; }
                __syncthreads();
#pragma unroll
                for (int it = 0; it < 4; ++it) { const int tok = 16 * it + fr; float tot = 0.f;
#pragma unroll
                    for (int w8 = 0; w8 < 8; ++w8) tot += *(const LAS float*)(lds + L_SSQ + (w8 * 64 + tok) * 4);
                    const float rstd = rsqrtf(tot * (1.0f / DV) + EPS);
                    if (tok < tokv) { const size_t row = (size_t)(rbase + tok);
#pragma unroll
                        for (int vt = 0; vt < 2; ++vt) { const int vcol = h * DV + 32 * wave + 16 * vt + 4 * fq;
                            const u32x2 r2 = rcur[it][vt]; const f32x4 nw = *(const LAS f32x4*)(lds + L_NW + (32 * wave + 16 * vt + 4 * fq) * 4);
                            const f32x4 o = O[vt][it];
                            const float r0 = bf2f((unsigned short)(r2.x & 0xffffu)), r1 = bf2f((unsigned short)(r2.x >> 16)), r2f = bf2f((unsigned short)(r2.y & 0xffffu)), r3 = bf2f((unsigned short)(r2.y >> 16));
                            u32x2 w2; w2.x = pg8::cvt_pk_bf16(o[0] * rstd * nw[0] * pg8::silu_f(r0), o[1] * rstd * nw[1] * pg8::silu_f(r1));
                            w2.y = pg8::cvt_pk_bf16(o[2] * rstd * nw[2] * pg8::silu_f(r2f), o[3] * rstd * nw[3] * pg8::silu_f(r3));
                            *(u32x2*)(GOUT + row * DM + vcol) = w2; } }
                    __builtin_amdgcn_sched_barrier(0); }
            }
            __builtin_amdgcn_sched_barrier(0);
#pragma unroll
            for (int js = 0; js < 2; ++js)
#pragma unroll
                for (int vt = 0; vt < 2; ++vt) { const bf16x8 Yv = *(const LAS bf16x8*)(lds + L_VT + (32 * wave + 16 * vt + fr) * TSB + (32 * js + 8 * fq) * 2);
#pragma unroll
                    for (int dt = 0; dt < 8; ++dt) { const bf16x8 Xk = *(const LAS bf16x8*)(lds + L_KT + (16 * dt + fr) * TSB + (32 * js + 8 * fq) * 2);
                        S[dt][vt] = __builtin_amdgcn_mfma_f32_16x16x32_bf16(Xk, Yv, S[dt][vt], 0, 0, 0); }
                    __builtin_amdgcn_sched_barrier(0); }
            __syncthreads();
        }
        asm volatile("" : "+v"(tid)); lane = tid & 63; fr = lane & 15; fq = lane >> 4;
        if (phase == 0 && !samp) {
            float* dsp = DS + (size_t)(bh * 7 + sc) * DK * DV;
#pragma unroll
            for (int dt = 0; dt < 8; ++dt)
#pragma unroll
                for (int vt = 0; vt < 2; ++vt) *(f32x4*)(dsp + (size_t)(((wave * 8 + dt) * 2 + vt) * 64 + lane) * 4) = S[dt][vt];
            if (wave == 0) { DSC[(size_t)(bh * 7 + sc) * DK + 2 * (tid & 63)] = __builtin_amdgcn_exp2f(btot0); DSC[(size_t)(bh * 7 + sc) * DK + 2 * (tid & 63) + 1] = __builtin_amdgcn_exp2f(btot1); }
        } else if (samp || sc == 7) {
            float* so = samp ? out + O_NGS + ((size_t)(jl * NBS + b) * NH + h) * DK * DV : out + O_NGP + ((size_t)(jl * NBP + b) * NH + h) * DK * DV;
#pragma unroll
            for (int dt = 0; dt < 8; ++dt)
#pragma unroll
                for (int vt = 0; vt < 2; ++vt)
#pragma unroll
                    for (int e = 0; e < 4; ++e) so[(size_t)(16 * dt + 4 * fq + e) * DV + 32 * wave + 16 * vt + fr] = S[dt][vt][e];
        }
    }
}


__device__ __forceinline__ void gla_scan_phase(int gt, int NT, unsigned char* ws) {
    float* DS = (float*)(ws + WS_DS); const float* DSC = (const float*)(ws + WS_DSC);
    for (int c = gt; c < 32 * 8192; c += NT) {
        const int bh = c >> 13, e4 = c & 8191, ln = e4 & 63, dt = (e4 >> 7) & 7, dcol = 16 * dt + 4 * (ln >> 4);
        f32x4 ds[7], dv[7];
#pragma unroll
        for (int k = 0; k < 7; ++k) { ds[k] = *(const f32x4*)(DS + (size_t)(bh * 7 + k) * DK * DV + (size_t)e4 * 4); dv[k] = *(const f32x4*)(DSC + (size_t)(bh * 7 + k) * DK + dcol); }
        f32x4 run = (f32x4){0.f, 0.f, 0.f, 0.f};
#pragma unroll
        for (int k = 0; k < 7; ++k) { run = run * dv[k] + ds[k]; *(f32x4*)(DS + (size_t)(bh * 7 + k) * DK * DV + (size_t)e4 * 4) = run; }
    }
}

struct Args { const float* in[17]; float* out; unsigned char* ws; int ph_lo, ph_hi; };
constexpr int N_PHASES = 29;
__global__ void __launch_bounds__(NWAVES * 64, 2) mk_fwd(Args args) {
    extern __shared__ __attribute__((aligned(16))) unsigned char lds_raw[];
    LAS unsigned char* lds = (LAS unsigned char*)lds_raw;
    volatile LAS unsigned* MISC = (volatile LAS unsigned*)(lds + MISC_OFF);
    for (int u = threadIdx.x; u < (LDS_BYTES - LDSCTL_OFF) / 4; u += NWAVES * 64) ((LAS unsigned*)(lds + LDSCTL_OFF))[u] = 0u;
    __syncthreads();
    XcdBarrier bar = xcd_barrier_post((unsigned*)(args.ws + WS_CTL) + CW_BAR, MISC + 8);
    const int lo = args.ph_lo, hi = args.ph_hi;
    const int wave0 = __builtin_amdgcn_readfirstlane(threadIdx.x >> 6);
#define PH_BEGIN(k) if ((k) >= lo && (k) < hi) { int tid = wave0 * 64 + (int)__builtin_amdgcn_mbcnt_hi(~0u, __builtin_amdgcn_mbcnt_lo(~0u, 0u)); asm volatile("" : "+v"(tid)); const int lane = tid & 63, wave = wave0; \
        const int G = gridDim.x, bid = blockIdx.x; const int vcu = (G % 8 == 0) ? (bid % 8) * (G / 8) + bid / 8 : bid; const int gw = vcu * NWAVES + wave, NGW = G * NWAVES; \
        unsigned char* ws = args.ws; float* out = args.out; const float* const* in = args.in; bf16* Hb = (bf16*)(ws + WS_H); bf16* BIG = (bf16*)(ws + WS_BIG); float* Xs_ = out + O_YS; \
        (void)lane; (void)gw; (void)NGW; (void)Hb; (void)BIG; (void)Xs_; (void)in;
#define PH_END(k)   if ((k) + 1 < hi) xcd_barrier(bar); }

#define POOL_GEMM(k, L) PH_BEGIN(k) { constexpr int jl = (L) >> 1; \
        pg8::Gemm g{BIG, (const bf16*)(ws + WS_WP + jl * SZ_WP), 4 * M, 1024, 256}; pg8::PoolOrder S{G, bid}; \
        pg8::EpiRes<true> E{(L) == 0 ? in[0] : out, (L) == 0 ? in[1] : Xs_, out, in[8] + jl * DM}; \
        pg8::gemm_phase<pg8::EpiRes<true>, pg8::PoolOrder, true, true>(lds, g, S, E, tid); } PH_END(k)
#define RMS_PH(k, gain) PH_BEGIN(k) rms_phase(gw, NGW, lane, out, (gain), Hb); PH_END(k)
#define FFN1(k, L) PH_BEGIN(k) { pg8::Gemm g{Hb, (const bf16*)(ws + WS_W13 + (L) * SZ_W13), M, NG1, DM}; pg8::StaticOrder S; S.init(M, NG1, G, bid, DM); \
        pg8::EpiSwiglu E{BIG}; pg8::gemm_phase<pg8::EpiSwiglu, pg8::StaticOrder, true, true>(lds, g, S, E, tid); } PH_END(k)
#define FFN2(k, L) PH_BEGIN(k) { pg8::Gemm g{BIG, (const bf16*)(ws + WS_W2 + (L) * SZ_W2), M, DM, FF}; pg8::PanelOrder S{G, bid, FF / 64}; \
        pg8::EpiRes<false> E{out, Xs_, out, nullptr}; pg8::gemm_phase<pg8::EpiRes<false>, pg8::PanelOrder, true, true>(lds, g, S, E, tid); \
        small_gemm_res(lds, BIG + (size_t)MP * FF, (const bf16*)(ws + WS_W2 + (L) * SZ_W2), FF, Xs_, tid, wave, G, bid); } PH_END(k)
#define PROJ_PH(k, jl) PH_BEGIN(k) { pg8::Gemm g{Hb, (const bf16*)(ws + WS_WIN + (jl) * SZ_WIN), M, NINP, DM}; pg8::StaticOrder S; S.init(M, NINP, G, bid, DM); \
        pg8::EpiProj E{BIG, (float*)(ws + WS_ALOW)}; pg8::gemm_phase<pg8::EpiProj, pg8::StaticOrder, true, true>(lds, g, S, E, tid); } PH_END(k)
#define WO_PH(k, jl) PH_BEGIN(k) { pg8::Gemm g{Hb, (const bf16*)(ws + WS_WO + (jl) * SZ_WO), M, DM, DM}; pg8::PanelOrder S{G, bid, DM / 64}; \
        pg8::EpiRes<false> E{out, Xs_, out, nullptr}; pg8::gemm_phase<pg8::EpiRes<false>, pg8::PanelOrder, true, true>(lds, g, S, E, tid); \
        small_gemm_res(lds, Hb + (size_t)MP * DM, (const bf16*)(ws + WS_WO + (jl) * SZ_WO), DM, Xs_, tid, wave, G, bid); } PH_END(k)
#define GLA_PH(k, sub, jl) PH_BEGIN(k) gla_phase(lds, tid, wave, lane, G, bid, (sub), (jl), in, out, ws); PH_END(k)

#ifdef NO_GLA
#undef GLA_PH
#define GLA_PH(k, sub, jl)
#endif
#ifdef NO_GEMM
#undef POOL_GEMM
#undef FFN1
#undef FFN2
#undef PROJ_PH
#undef WO_PH
#define POOL_GEMM(k, L)
#define FFN1(k, L)
#define FFN2(k, L)
#define PROJ_PH(k, jl)
#define WO_PH(k, jl)
#endif
#ifdef ONLY_FFN1
#undef POOL_GEMM
#undef FFN2
#undef PROJ_PH
#undef WO_PH
#define POOL_GEMM(k, L)
#define FFN2(k, L)
#define PROJ_PH(k, jl)
#define WO_PH(k, jl)
#endif
    PH_BEGIN(0)
        p0_weights(lds, wave, lane, gw, NGW, in, ws);
        __syncthreads();
        pool_prep(lds, tid, wave, lane, G, bid, in[0], in[1], in[4] + 0 * DM, in[2], BIG, out + O_NPP, out + O_NPS);
    PH_END(0)
    POOL_GEMM(1, 0)
    RMS_PH(2, in[5] + 0 * DM)
    FFN1(3, 0)
    FFN2(4, 0)
    RMS_PH(5, in[4] + 1 * DM)
    PROJ_PH(6, 0)
    GLA_PH(7, 0, 0)
    PH_BEGIN(8)
        gla_scan_phase(vcu * (NWAVES * 64) + tid, G * NWAVES * 64, ws);
    PH_END(8)
    GLA_PH(9, 1, 0)
    WO_PH(10, 0)
    RMS_PH(11, in[5] + 1 * DM)
    FFN1(12, 1)
    FFN2(13, 1)
    PH_BEGIN(14)
        pool_prep(lds, tid, wave, lane, G, bid, out, Xs_, in[4] + 2 * DM, in[2] + (size_t)NBS * 15 * DM, BIG, out + O_NPP + (size_t)NBP * 15 * DM, out + O_NPS + (size_t)NBS * 15 * DM);
    PH_END(14)
    POOL_GEMM(15, 2)
    RMS_PH(16, in[5] + 2 * DM)
    FFN1(17, 2)
    FFN2(18, 2)
    RMS_PH(19, in[4] + 3 * DM)
    PROJ_PH(20, 1)
    GLA_PH(21, 0, 1)
    PH_BEGIN(22)
        gla_scan_phase(vcu * (NWAVES * 64) + tid, G * NWAVES * 64, ws);
    PH_END(22)
    GLA_PH(23, 1, 1)
    WO_PH(24, 1)
    RMS_PH(25, in[5] + 3 * DM)
    FFN1(26, 3)
    FFN2(27, 3)
    PH_BEGIN(28)
        final_norm_phase(gw, NGW, lane, out, in[6]);
    PH_END(28)
}

#ifndef MK_SPLIT
#define MK_SPLIT 0
#endif
extern "C" void kernel_launch(void* const* d_in, const int* in_sizes, int n_in, void* d_out, int out_size, void* d_ws, size_t ws_size, hipStream_t stream) {
    static int grid = 0;
    if (grid == 0) {
        if (n_in != 17 || (size_t)out_size != O_END || ws_size < WS_END) { fprintf(stderr, "kernel_launch: unexpected shapes (n_in %d out %d ws %zu)\n", n_in, out_size, ws_size); grid = -1; return; }
        int dev = 0, cus = 0, per_cu = 0;
        if (hipGetDevice(&dev) != hipSuccess || hipDeviceGetAttribute(&cus, hipDeviceAttributeMultiprocessorCount, dev) != hipSuccess) { grid = -1; return; }
        if (hipFuncSetAttribute((const void*)mk_fwd, hipFuncAttributeMaxDynamicSharedMemorySize, LDS_BYTES) != hipSuccess) { fprintf(stderr, "kernel_launch: hipFuncSetAttribute failed\n"); grid = -1; return; }
        if (hipOccupancyMaxActiveBlocksPerMultiprocessor(&per_cu, (const void*)mk_fwd, NWAVES * 64, LDS_BYTES) != hipSuccess || per_cu < 1) { fprintf(stderr, "kernel_launch: occupancy query failed (%d)\n", per_cu); (void)hipGetLastError(); per_cu = 1; }
        grid = cus;
        if (grid > cus * per_cu) grid = cus * per_cu;
    }
    if (grid < 0) return;
    if (hipMemsetAsync((char*)d_ws + WS_CTL, 0, CTL_ZERO_BYTES, stream) != hipSuccess) { fprintf(stderr, "kernel_launch: memset failed\n"); return; }
    Args a{};
    for (int i = 0; i < 17; ++i) a.in[i] = (const float*)d_in[i];
    a.out = (float*)d_out; a.ws = (unsigned char*)d_ws;
#if MK_SPLIT
    for (int p = 0; p < N_PHASES; ++p) { a.ph_lo = p; a.ph_hi = p + 1; hipLaunchKernelGGL(mk_fwd, dim3(grid), dim3(NWAVES * 64), LDS_BYTES, stream, a); }
#else
    a.ph_lo = 0; a.ph_hi = N_PHASES;
    void* kargs[] = {&a};
    hipError_t e = hipLaunchCooperativeKernel((const void*)mk_fwd, dim3(grid), dim3(NWAVES * 64), kargs, LDS_BYTES, stream);
    if (e != hipSuccess) fprintf(stderr, "kernel_launch: cooperative launch failed: %s (grid %d)\n", hipGetErrorString(e), grid);
#endif
}
```

```cpp
#include <hip/hip_runtime.h>
#include <cstdio>
#include <cstdint>
namespace pg8 {
#define PG8_LAS __attribute__((address_space(3)))
typedef unsigned short bf16_t;
typedef short bf16x8 __attribute__((ext_vector_type(8)));
typedef float f32x4 __attribute__((ext_vector_type(4)));
typedef unsigned u32x4 __attribute__((ext_vector_type(4)));
constexpr int BM = 256, BK = 64, HALF = 128, HTB = HALF * BK * 2  , STAGE_BYTES = 8 * HTB, NXCD = 8, WGM = 8;

__host__ __device__ __forceinline__ int lds_byte(int r, int c) { const int st = (r >> 4) * 2 + (c >> 5), rr = r & 15, cc = c & 31, ob = rr * 64 + cc * 2; return st * 1024 + (ob ^ (((ob >> 9) & 1) << 5)); }
__host__ __device__ __forceinline__ void stage_rc(int b, int& R, int& C) { const int st = b / 1024, sb = b % 1024, swz = sb ^ (((sb >> 9) & 1) << 5); R = (st >> 1) * 16 + swz / 64; C = (st & 1) * 32 + (swz % 64) / 2; }
__host__ __device__ __forceinline__ int perm32(int rho) { const int n = rho >> 4, i = rho & 15; return 8 * (i >> 2) + 4 * n + (i & 3); }

struct Unit { int pm, pn, k0, nt, part; };
struct Gemm { const bf16_t* A; const bf16_t* Bt; int M, N, K; };

struct StaticOrder {
    int nM, nN, nwg, G, c, ntk;
    __host__ __device__ void init(int M, int N, int G_, int c_, int K_) { nM = M / BM; nN = N / BM; nwg = nM * nN; G = G_; c = c_; ntk = K_ / BK; }
    __host__ __device__ bool next(int i, Unit& u) const {
        const long L = (long)i * G + c; if (L >= nwg) return false;
        int wgid = (int)L; { const int q = nwg / NXCD, r = nwg % NXCD, xcd = wgid % NXCD, off = wgid / NXCD; wgid = (xcd < r ? xcd * (q + 1) : r * (q + 1) + (xcd - r) * q) + off; }
        const int nig = WGM * nN, gid = wgid / nig, fm = gid * WGM, gsz = (nM - fm) < WGM ? (nM - fm) : WGM;
        u.pm = fm + ((wgid % nig) % gsz); u.pn = (wgid % nig) / gsz; u.k0 = 0; u.nt = ntk; u.part = 0; return true;
    }
    __device__ __forceinline__ void a_ready(const Unit&) const {}
    __device__ __forceinline__ void done(const Unit&) const {}
};

__device__ __forceinline__ unsigned cvt_pk_bf16(float lo, float hi) { unsigned r; asm volatile("v_cvt_pk_bf16_f32 %0, %1, %2" : "=v"(r) : "v"(lo), "v"(hi)); return r; }
typedef float f32x2 __attribute__((ext_vector_type(2)));
typedef unsigned u32x2 __attribute__((ext_vector_type(2)));
__device__ __forceinline__ float silu_f(float x) { return x * __builtin_amdgcn_rcpf(1.0f + __builtin_amdgcn_exp2f(x * -1.4426950408889634f)); }
constexpr int P_DM = 1024, P_FF = 2816, P_NT = 68  , P_PROJ = 3072;

__device__ __forceinline__ unsigned swiglu_pk(f32x2 g, f32x2 u) {
    const f32x2 t = g * -1.4426950408889634f; f32x2 e; e.x = __builtin_amdgcn_exp2f(t.x); e.y = __builtin_amdgcn_exp2f(t.y);
    const f32x2 d = e + 1.0f; f32x2 r; r.x = __builtin_amdgcn_rcpf(d.x); r.y = __builtin_amdgcn_rcpf(d.y);
    const f32x2 o = (g * u) * r; return cvt_pk_bf16(o.x, o.y);
}
struct EpiSwiglu {
    static constexpr bool PERM = true, AFTER_DRAIN = false;
    bf16_t* U;
    __device__ __forceinline__ void operator()(const f32x4 (&acc)[2][2][4][2], const Unit& u, int wr, int wc, int fr, int fq) const {
        const int row0 = u.pm * BM + wr * 64 + fr, col0 = u.pn * 128 + wc * 32 + 8 * fq;
#pragma unroll
        for (int ai = 0; ai < 2; ++ai)
#pragma unroll
            for (int m = 0; m < 4; ++m) { bf16_t* rowp = U + (size_t)(row0 + ai * HALF + m * 16) * P_FF + col0;
                const f32x4 g0 = acc[ai][0][m][0], g1 = acc[ai][0][m][1], u0 = acc[ai][1][m][0], u1 = acc[ai][1][m][1];
                u32x4 w; w.x = swiglu_pk((f32x2){g0[0], g0[1]}, (f32x2){u0[0], u0[1]}); w.y = swiglu_pk((f32x2){g0[2], g0[3]}, (f32x2){u0[2], u0[3]});
                w.z = swiglu_pk((f32x2){g1[0], g1[1]}, (f32x2){u1[0], u1[1]}); w.w = swiglu_pk((f32x2){g1[2], g1[3]}, (f32x2){u1[2], u1[3]});
                *(u32x4*)rowp = w; }
    }
};
struct EpiProj {
    static constexpr bool PERM = true, AFTER_DRAIN = false;
    bf16_t* P; float* AL;
    __device__ __forceinline__ void operator()(const f32x4 (&acc)[2][2][4][2], const Unit& u, int wr, int wc, int fr, int fq) const {
        const int row0 = u.pm * BM + wr * 64 + fr;
        if (u.pn >= 8 && u.pn < 12) {
            const int col0 = u.pn * BM + wc * 32 + 8 * fq; const f32x2 one = (f32x2){1.f, 1.f};
#pragma unroll
            for (int ai = 0; ai < 2; ++ai)
#pragma unroll
                for (int m = 0; m < 4; ++m) { bf16_t* rowp = P + (size_t)(row0 + ai * HALF + m * 16) * P_PROJ + col0;
#pragma unroll
                    for (int bj = 0; bj < 2; ++bj) { const f32x4 v0 = acc[ai][bj][m][0], v1 = acc[ai][bj][m][1];
                        u32x4 w; w.x = swiglu_pk((f32x2){v0[0], v0[1]}, one); w.y = swiglu_pk((f32x2){v0[2], v0[3]}, one); w.z = swiglu_pk((f32x2){v1[0], v1[1]}, one); w.w = swiglu_pk((f32x2){v1[2], v1[3]}, one);
                        *(u32x4*)(rowp + bj * HALF) = w; } }
        } else if (u.pn < 12) {
            const float sc = u.pn < 2 ? 0.08838834764831845f : 1.0f;
            const int col0 = u.pn * BM + wc * 32 + 8 * fq;
#pragma unroll
            for (int ai = 0; ai < 2; ++ai)
#pragma unroll
                for (int m = 0; m < 4; ++m) { bf16_t* rowp = P + (size_t)(row0 + ai * HALF + m * 16) * P_PROJ + col0;
#pragma unroll
                    for (int bj = 0; bj < 2; ++bj) { const f32x4 v0 = acc[ai][bj][m][0] * sc, v1 = acc[ai][bj][m][1] * sc;
                        u32x4 w; w.x = cvt_pk_bf16(v0[0], v0[1]); w.y = cvt_pk_bf16(v0[2], v0[3]); w.z = cvt_pk_bf16(v1[0], v1[1]); w.w = cvt_pk_bf16(v1[2], v1[3]);
                        *(u32x4*)(rowp + bj * HALF) = w; } }
        } else if (wc == 0 && fq < 2) {
#pragma unroll
            for (int ai = 0; ai < 2; ++ai)
#pragma unroll
                for (int m = 0; m < 4; ++m) { float* rowp = AL + (size_t)(row0 + ai * HALF + m * 16) * 16 + 8 * fq;
                    *(f32x4*)rowp = acc[ai][0][m][0]; *(f32x4*)(rowp + 4) = acc[ai][0][m][1]; }
        }
    }
};
template <bool POOL> struct EpiRes {
    static constexpr bool PERM = false, AFTER_DRAIN = false;
    const float* bp; const float* bs; float* out; const float* scale;
    __device__ __forceinline__ void operator()(const f32x4 (&acc)[2][2][4][2], const Unit& u, int wr, int wc, int fr, int fq) const {
        const int pm = POOL ? (u.pm - P_NT * u.pn) : u.pm, pn = u.pn;
        const float* base = pm < 64 ? bp + (size_t)pm * BM * P_DM : bs + (size_t)(pm - 64) * BM * P_DM;
        float* o = out + (size_t)pm * BM * P_DM;
        int frq = fr + 16 * fq; asm volatile("" : "+v"(frq));
        const unsigned col0 = (unsigned)(pn * BM + wc * 32 + 4 * (frq >> 4));
        const unsigned roff = (unsigned)(wr * 64 + (frq & 15)) * P_DM + col0;
#pragma unroll
        for (int ai = 0; ai < 2; ++ai)
#pragma unroll
            for (int m = 0; m < 4; ++m) { const unsigned off = roff + (unsigned)(ai * HALF + m * 16) * P_DM;
#pragma unroll
                for (int bj = 0; bj < 2; ++bj)
#pragma unroll
                    for (int n = 0; n < 2; ++n) { f32x4 a = acc[ai][bj][m][n]; if (POOL) a = a * *(const f32x4*)(scale + col0 + bj * HALF + n * 16);
                        const f32x4 b = *(const f32x4*)(base + off + bj * HALF + n * 16); *(f32x4*)(o + off + bj * HALF + n * 16) = a + b; } }
    }
};
struct PoolOrder {
    int G, c;
    __device__ bool next(int i, Unit& u) const { const int L = i * G + c; if (L >= 4 * P_NT) return false; const int g = L & 3, pm = L >> 2; u.pm = g * P_NT + pm; u.pn = g; u.k0 = 0; u.nt = 4; u.part = 0; return true; }
    __device__ __forceinline__ void a_ready(const Unit&) const {}
    __device__ __forceinline__ void done(const Unit&) const {}
};
struct PanelOrder {
    int G, c, ntk;
    __device__ bool next(int i, Unit& u) const {
        const int L = i * G + c; if (L >= 256) return false;
        const int x = L & 7, idx = L >> 3; u.pm = x * 8 + (idx >> 2); u.pn = idx & 3; u.k0 = 0; u.nt = ntk; u.part = 0; return true;
    }
    __device__ __forceinline__ void a_ready(const Unit&) const {}
    __device__ __forceinline__ void done(const Unit&) const {}
};
template <class Epi, class Sched, bool ALIGN_EPI = false, bool SP2 = false>
__device__ __forceinline__ void gemm_phase(PG8_LAS unsigned char* lds, const Gemm g, const Sched& S, const Epi& E, const int tid_in) {
    int tid_raw = tid_in; asm volatile("" : "+v"(tid_raw));
    const int tid = tid_raw, wid = __builtin_amdgcn_readfirstlane(tid >> 6), lane = tid & 63, wr = wid >> 2, wc = wid & 3, fr = lane & 15, fq = lane >> 4;
    const int K = g.K;
    unsigned voffA[2], voffB[2];
#pragma unroll
    for (int i = 0; i < 2; ++i) { int R, C; stage_rc(tid * 16 + i * 8192, R, C); const int Rb = Epi::PERM ? ((R & ~31) + perm32(R & 31)) : R;
        voffA[i] = (unsigned)(R * K + C) * 2u; voffB[i] = (unsigned)(Rb * K + C) * 2u; }
    const size_t kstep = (size_t)(BK * 2);
    const size_t hstep = (size_t)HALF * K * 2;
    const size_t tstep = 2 * hstep;
    const unsigned ldsw = (unsigned)wid * 1024u;
    const int aoff = lds_byte(wr * 64 + fr, fq * 8), boff = lds_byte(wc * 32 + fr, fq * 8);
#define PG8_SA(b, h) (((b) * 2 + (h)) * HTB)
#define PG8_SB(b, h) ((4 + (b) * 2 + (h)) * HTB)
#define PG8_STAGE(bufoff, gbase, voff) do { _Pragma("unroll") for (int _i = 0; _i < 2; ++_i) \
        __builtin_amdgcn_global_load_lds((const unsigned*)((const char*)(gbase) + (voff)[_i]), (PG8_LAS unsigned*)(lds + (bufoff) + ldsw + _i * 8192), 16, 0, 0); } while (0)
#define PG8_LDA(dst, b, h) do { _Pragma("unroll") for (int m = 0; m < 4; ++m) _Pragma("unroll") for (int k = 0; k < 2; ++k) dst[m][k] = *(const PG8_LAS bf16x8*)(lds + PG8_SA(b, h) + aoff + m * 2048 + k * 1024); } while (0)
#define PG8_LDB(dst, b, h) do { _Pragma("unroll") for (int n = 0; n < 2; ++n) _Pragma("unroll") for (int k = 0; k < 2; ++k) dst[n][k] = *(const PG8_LAS bf16x8*)(lds + PG8_SB(b, h) + boff + n * 2048 + k * 1024); } while (0)
#define PG8_MMA(ai, bj, At, Bt) do { __builtin_amdgcn_s_setprio(1); _Pragma("unroll") for (int m = 0; m < 4; ++m) _Pragma("unroll") for (int n = 0; n < 2; ++n) _Pragma("unroll") for (int k = 0; k < 2; ++k) \
        acc[ai][bj][m][n] = __builtin_amdgcn_mfma_f32_16x16x32_bf16(Bt[n][k], At[m][k], acc[ai][bj][m][n], 0, 0, 0); __builtin_amdgcn_s_setprio(0); } while (0)
#define PG8_WAIT_V(n) asm volatile("s_waitcnt vmcnt(" #n ")" ::: "memory")
#define PG8_WAIT_L(n) asm volatile("s_waitcnt lgkmcnt(" #n ")" ::: "memory")
#define PG8_BAR __builtin_amdgcn_s_barrier()
#define PG8_SCHED __builtin_amdgcn_sched_barrier(0)
    Unit cur, nxt; int ui = 0;
    if (!S.next(0, cur)) return;
    f32x4 acc[2][2][4][2];
#pragma unroll
    for (int a = 0; a < 2; ++a)
#pragma unroll
        for (int b = 0; b < 2; ++b)
#pragma unroll
            for (int m = 0; m < 4; ++m)
#pragma unroll
                for (int n = 0; n < 2; ++n) acc[a][b][m][n] = (f32x4){0.f, 0.f, 0.f, 0.f};
    bf16x8 At[4][2], B0[2][2], B1[2][2];
    const char* cA = (const char*)g.A + (size_t)cur.pm * tstep + (size_t)cur.k0 * 2; const char* cB = (const char*)g.Bt + (size_t)cur.pn * tstep + (size_t)cur.k0 * 2;
    S.a_ready(cur);
    if constexpr (SP2) {
        PG8_STAGE(PG8_SB(0, 0), cB, voffB); PG8_STAGE(PG8_SB(0, 1), cB + hstep, voffB); PG8_STAGE(PG8_SA(0, 0), cA, voffA); PG8_STAGE(PG8_SA(0, 1), cA + hstep, voffA);
        if (wr == 1) PG8_BAR;
        PG8_WAIT_V(2); PG8_BAR;
        PG8_STAGE(PG8_SB(1, 0), cB + kstep, voffB); PG8_STAGE(PG8_SA(1, 0), cA + kstep, voffA); PG8_STAGE(PG8_SB(1, 1), cB + hstep + kstep, voffB);
        PG8_WAIT_V(6); PG8_BAR;
    } else {
        PG8_STAGE(PG8_SB(0, 0), cB, voffB); PG8_STAGE(PG8_SA(0, 0), cA, voffA); PG8_STAGE(PG8_SB(0, 1), cB + hstep, voffB); PG8_STAGE(PG8_SA(0, 1), cA + hstep, voffA);
        if (wr == 1) PG8_BAR;
        PG8_WAIT_V(4); PG8_BAR;
        PG8_STAGE(PG8_SB(1, 0), cB + kstep, voffB); PG8_STAGE(PG8_SA(1, 0), cA + kstep, voffA); PG8_STAGE(PG8_SB(1, 1), cB + hstep + kstep, voffB);
        PG8_WAIT_V(6); PG8_BAR;
    }
    for (;;) {
        const bool has_next = S.next(ui + 1, nxt);
        const char* nA = has_next ? (const char*)g.A + (size_t)nxt.pm * tstep + (size_t)nxt.k0 * 2 : cA; const char* nB = has_next ? (const char*)g.Bt + (size_t)nxt.pn * tstep + (size_t)nxt.k0 * 2 : cB;
        const int nt = cur.nt;
        for (int t = 0; t < nt; t += 2) {
            const bool last = (t == nt - 2);
            const char* a1 = cA + (size_t)(t + 1) * kstep;
            const char* a2 = last ? nA : cA + (size_t)(t + 2) * kstep; const char* b2 = last ? nB : cB + (size_t)(t + 2) * kstep;
            const char* a3 = a2 + kstep; const char* b3 = b2 + kstep;
            if (last && has_next) S.a_ready(nxt);
            if constexpr (SP2) {
            PG8_LDB(B0, 0, 0); PG8_LDB(B1, 0, 1); PG8_SCHED; PG8_LDA(At, 0, 0); PG8_STAGE(PG8_SA(1, 1), a1 + hstep, voffA);
            PG8_WAIT_V(8); PG8_WAIT_L(0); PG8_BAR; PG8_MMA(0, 0, At, B0); PG8_MMA(0, 1, At, B1); PG8_BAR; PG8_SCHED;
            PG8_LDA(At, 0, 1); PG8_STAGE(PG8_SB(0, 0), b2, voffB); PG8_STAGE(PG8_SB(0, 1), b2 + hstep, voffB); PG8_STAGE(PG8_SA(0, 0), a2, voffA);
            PG8_WAIT_V(8); PG8_WAIT_L(0); PG8_BAR; PG8_MMA(1, 0, At, B0); PG8_MMA(1, 1, At, B1); PG8_BAR; PG8_SCHED;
            PG8_LDB(B0, 1, 0); PG8_LDB(B1, 1, 1); PG8_SCHED; PG8_LDA(At, 1, 0); PG8_STAGE(PG8_SA(0, 1), a2 + hstep, voffA);
            PG8_WAIT_V(8); PG8_WAIT_L(0); PG8_BAR; PG8_MMA(0, 0, At, B0); PG8_MMA(0, 1, At, B1); PG8_BAR; PG8_SCHED;
            PG8_LDA(At, 1, 1); PG8_STAGE(PG8_SB(1, 0), b3, voffB); PG8_STAGE(PG8_SB(1, 1), b3 + hstep, voffB); PG8_STAGE(PG8_SA(1, 0), a3, voffA);
            PG8_WAIT_V(8); PG8_WAIT_L(0); PG8_BAR; PG8_MMA(1, 0, At, B0); PG8_MMA(1, 1, At, B1); PG8_BAR; PG8_SCHED;
            } else {
            PG8_LDB(B0, 0, 0); PG8_SCHED; PG8_LDA(At, 0, 0); PG8_STAGE(PG8_SA(1, 1), a1 + hstep, voffA);
            PG8_WAIT_L(8); PG8_BAR; PG8_WAIT_L(0); PG8_MMA(0, 0, At, B0); PG8_BAR; PG8_SCHED;
            PG8_LDB(B1, 0, 1); PG8_STAGE(PG8_SB(0, 0), b2, voffB);
            PG8_BAR; PG8_WAIT_L(0); PG8_MMA(0, 1, At, B1); PG8_BAR;
            PG8_LDA(At, 0, 1); PG8_STAGE(PG8_SA(0, 0), a2, voffA);
            PG8_BAR; PG8_WAIT_L(0); PG8_MMA(1, 0, At, B0); PG8_BAR; PG8_SCHED;
            PG8_STAGE(PG8_SB(0, 1), b2 + hstep, voffB);
            PG8_WAIT_V(6); PG8_BAR; PG8_MMA(1, 1, At, B1); PG8_BAR;
            PG8_LDB(B0, 1, 0); PG8_SCHED; PG8_LDA(At, 1, 0); PG8_STAGE(PG8_SA(0, 1), a2 + hstep, voffA);
            PG8_WAIT_L(8); PG8_BAR; PG8_WAIT_L(0); PG8_MMA(0, 0, At, B0); PG8_BAR; PG8_SCHED;
            PG8_LDB(B1, 1, 1); PG8_STAGE(PG8_SB(1, 0), b3, voffB);
            PG8_BAR; PG8_WAIT_L(0); PG8_MMA(0, 1, At, B1); PG8_BAR;
            PG8_LDA(At, 1, 1); PG8_STAGE(PG8_SA(1, 0), a3, voffA);
            PG8_BAR; PG8_WAIT_L(0); PG8_MMA(1, 0, At, B0); PG8_BAR; PG8_SCHED;
            PG8_STAGE(PG8_SB(1, 1), b3 + hstep, voffB);
            PG8_WAIT_V(6); PG8_BAR; PG8_MMA(1, 1, At, B1); PG8_BAR;
            }
        }
        if constexpr (ALIGN_EPI) { if (wr == 0) PG8_BAR; }
        if constexpr (!Epi::AFTER_DRAIN) { E(acc, cur, wr, wc, fr, fq); S.done(cur); }
        if (!has_next) break;
#pragma unroll
        for (int a = 0; a < 2; ++a)
#pragma unroll
            for (int b = 0; b < 2; ++b)
#pragma unroll
                for (int m = 0; m < 4; ++m)
#pragma unroll
                    for (int n = 0; n < 2; ++n) acc[a][b][m][n] = (f32x4){0.f, 0.f, 0.f, 0.f};
        cur = nxt; cA = nA; cB = nB; ++ui;
        if constexpr (ALIGN_EPI) { if (wr == 1) PG8_BAR; }
    }
    PG8_WAIT_V(0);
    if constexpr (!ALIGN_EPI) { if (wr == 0) PG8_BAR; }
    PG8_BAR;
    if constexpr (Epi::AFTER_DRAIN) { E.fused(acc, cur, wr, wc, fr, fq, lds, wid, lane); S.done(cur); }
#undef PG8_SA
#undef PG8_SB
#undef PG8_STAGE
#undef PG8_LDA
#undef PG8_LDB
#undef PG8_MMA
#undef PG8_WAIT_V
#undef PG8_WAIT_L
#undef PG8_BAR
#undef PG8_SCHED
}
}
#define GAS __attribute__((address_space(1)))
#define LAS __attribute__((address_space(3)))
typedef unsigned short bf16;
typedef unsigned v4u __attribute__((ext_vector_type(4)));
typedef float f32x4 __attribute__((ext_vector_type(4)));
typedef short bf16x8 __attribute__((ext_vector_type(8)));
typedef GAS unsigned gu32;
typedef GAS unsigned long long gu64;
#define RLX_AGENT __ATOMIC_RELAXED, __HIP_MEMORY_SCOPE_AGENT
#define LDS_WAIT() asm volatile("s_waitcnt lgkmcnt(0)" ::: "memory")
#define VM_WAIT() asm volatile("s_waitcnt vmcnt(0)" ::: "memory")
__device__ __forceinline__ unsigned long long rt() { return __builtin_amdgcn_s_memrealtime(); }
__device__ __forceinline__ unsigned f2bf(float f) { unsigned u = __builtin_bit_cast(unsigned, f); return (u + 0x7fffu + ((u >> 16) & 1u)) >> 16; }
__device__ __forceinline__ unsigned pk2(float lo, float hi) { return f2bf(lo) | (f2bf(hi) << 16); }

#define XB_TMO      128
#define XB_XCNT(j)  (256  + 64 * (j))
#define XB_XSUB(j)  (1280 + 64 * (j))
#define XB_XGEN(j)  (2304 + 64 * (j))
#define XB_TOP      3328
#define XB_TOPGEN   3392
#define XCD_BAR_WORDS 3456
#define XB_SPIN_CAP (1u << 18)

__device__ __forceinline__ unsigned xb_ld(unsigned* p)              { return __hip_atomic_load(p, __ATOMIC_RELAXED, __HIP_MEMORY_SCOPE_AGENT); }
__device__ __forceinline__ unsigned xb_add(unsigned* p, unsigned v) { return __hip_atomic_fetch_add(p, v, __ATOMIC_RELAXED, __HIP_MEMORY_SCOPE_AGENT); }
__device__ __forceinline__ unsigned xb_xcc_id() { return (unsigned)__builtin_amdgcn_s_getreg((3 << 11) | 20) & 0xFu; }
#define XB_SPIN(cond, bar) do { unsigned _sp = 0; while (cond) { __builtin_amdgcn_s_sleep(1); \
    if ((++_sp & 255u) == 0u) { if (xb_ld(&(bar)[XB_TMO])) break; if (_sp > XB_SPIN_CAP) { atomicAdd(&(bar)[XB_TMO], 1u); break; } } } } while (0)

struct XcdBarrier {
    unsigned* bar; unsigned x;
    volatile LAS unsigned* st;
};

__device__ __forceinline__ XcdBarrier xcd_barrier_post(unsigned* bar, volatile LAS unsigned* st) {
    XcdBarrier b; b.bar = bar; b.x = xb_xcc_id(); b.st = st;
    if (threadIdx.x == 0) (void)xb_add(&bar[XB_XCNT(b.x)], 1u);
    return b;
}
__device__ __forceinline__ void xcd_barrier_complete(unsigned* bar, unsigned x, unsigned& nloc, unsigned& nx) {
    const unsigned G = gridDim.x * gridDim.y * gridDim.z;
    unsigned sum, cnt, mine, sp = 0u;
    for (;;) {
        sum = 0u; cnt = 0u; mine = 0u;
#pragma unroll
        for (unsigned j = 0; j < 16; ++j) { const unsigned c = xb_ld(&bar[XB_XCNT(j)]); sum += c; cnt += (c > 0u) ? 1u : 0u; mine = (j == x) ? c : mine; }
        if (sum == G) break;
        __builtin_amdgcn_s_sleep(1);
        if ((++sp & 255u) == 0u) { if (xb_ld(&bar[XB_TMO])) break; if (sp > XB_SPIN_CAP) { atomicAdd(&bar[XB_TMO], 1u); break; } }
    }
    nloc = mine > 0u ? mine : 1u; nx = cnt > 0u ? cnt : 1u;
}

__device__ __forceinline__ void xcd_barrier(const XcdBarrier& b) {
    asm volatile("s_waitcnt vmcnt(0)" ::: "memory");
    __syncthreads();
    if (threadIdx.x == 0) {
        unsigned* bar = b.bar;
        __builtin_amdgcn_s_waitcnt(0);
        unsigned nloc = b.st[0], nx = b.st[1];
        if (nloc == 0u) { xcd_barrier_complete(bar, b.x, nloc, nx); b.st[0] = nloc; b.st[1] = nx; }
        const unsigned old = xb_add(&bar[XB_XSUB(b.x)], 1u);
        const unsigned gen = old / nloc;
        if (old + 1u == (gen + 1u) * nloc) {
            __builtin_amdgcn_fence(__ATOMIC_RELEASE, "agent");
            asm volatile("s_waitcnt vmcnt(0)" ::: "memory");
            const unsigned og = xb_add(&bar[XB_TOP], 1u);
            const unsigned tg = og / nx;
            if (og + 1u == (tg + 1u) * nx) xb_add(&bar[XB_TOPGEN], 1u);
            else XB_SPIN(xb_ld(&bar[XB_TOPGEN]) == tg, bar);
            __builtin_amdgcn_fence(__ATOMIC_ACQUIRE, "agent");
            xb_add(&bar[XB_XGEN(b.x)], 1u);
            asm volatile("s_waitcnt vmcnt(0)" ::: "memory");
        } else {
            XB_SPIN(xb_ld(&bar[XB_XGEN(b.x)]) == gen, bar);
            __builtin_amdgcn_fence(__ATOMIC_ACQUIRE, "agent");
            asm volatile("s_waitcnt vmcnt(0)" ::: "memory");
        }
    }
    __syncthreads();
}
constexpr int NWAVES = 8;
constexpr int DM = 1024, TP = 2048, NBP = 8, MP = NBP * TP, NBS = 128, TS = 8, MS = NBS * TS, M = MP + MS, FF = 2816, NG1 = 2 * FF;
constexpr int NIN = 3088, NINP = 3328, NPROJ = 3072, DK = 128, DV = 256, NH = 4;
constexpr float EPS = 1e-6f;
static_assert(M == 68 * 256, "row tiles");
constexpr size_t O_YP = 0, O_YS = (size_t)MP * DM, O_NPP = O_YS + (size_t)MS * DM, O_NGP = O_NPP + (size_t)2 * NBP * 15 * DM, O_NPS = O_NGP + (size_t)2 * NBP * NH * DK * DV,
                 O_NGS = O_NPS + (size_t)2 * NBS * 15 * DM, O_END = O_NGS + (size_t)2 * NBS * NH * DK * DV;
constexpr size_t MiB = 1u << 20;
constexpr size_t WS_CTL = 0, CTL_ZERO_BYTES = 1 * MiB;
constexpr size_t SZ_W13 = (size_t)NG1 * DM * 2, SZ_W2 = (size_t)DM * FF * 2, SZ_WIN = (size_t)NINP * DM * 2, SZ_WO = (size_t)DM * DM * 2, SZ_WP = (size_t)4 * 256 * 256 * 2;
constexpr size_t WS_W13 = 1 * MiB, WS_W2 = WS_W13 + 4 * SZ_W13, WS_WIN = WS_W2 + 4 * SZ_W2, WS_WO = WS_WIN + 2 * SZ_WIN, WS_WP = WS_WO + 2 * SZ_WO;
constexpr size_t WS_H = WS_WP + 2 * SZ_WP;
constexpr size_t WS_BIG = WS_H + (size_t)M * DM * 2;
constexpr size_t WS_ALOW = WS_BIG + (size_t)M * NPROJ * 2;
constexpr size_t WS_DS = WS_ALOW + (size_t)M * 16 * 4;
constexpr size_t WS_DSC = WS_DS + (size_t)32 * 7 * DK * DV * 4;
constexpr size_t WS_END = WS_DSC + (size_t)32 * 7 * DK * 4;
static_assert(WS_END <= 256 * MiB, "d_ws map");
static_assert(WS_H % 256 == 0 && WS_BIG % 256 == 0 && WS_ALOW % 256 == 0 && WS_DS % 256 == 0 && WS_DSC % 256 == 0, "alignment");
constexpr int CW_BAR = 4096;
constexpr int RING_BYTES = 131072, LDSCTL_OFF = RING_BYTES, MISC_OFF = LDSCTL_OFF + 320, LDS_BYTES = 147456;

__device__ __forceinline__ float wave_sum(float v) {
#pragma unroll
    for (int o = 1; o < 64; o <<= 1) v += __shfl_xor(v, o);
    return v;
}
__device__ __forceinline__ float bf2f(unsigned short b) { return __builtin_bit_cast(float, (unsigned)b << 16); }

__device__ __forceinline__ void tr_item(const float* W, int K, int N, bf16* WT, int mode, int row_off, LAS float* scr, int item, int lane) {
    const int nblk = (N + 31) >> 5, kb = item / nblk, nb = item - kb * nblk, k0 = 64 * kb, n0 = 32 * nb;
    const int nn = n0 + (lane & 31); const bool ok = nn < N;
    float wv[32];
#pragma unroll
    for (int i = 0; i < 32; ++i) { const int kk = 2 * i + (lane >> 5); wv[i] = ok ? W[(size_t)(k0 + kk) * N + nn] : 0.f; }
#pragma unroll
    for (int i = 0; i < 32; ++i) { const int kk = 2 * i + (lane >> 5); scr[kk * 33 + (lane & 31)] = wv[i]; }
    LDS_WAIT(); asm volatile("" ::: "memory");
    const int c = lane & 7;
#pragma unroll
    for (int j = 0; j < 4; ++j) { const int n = (lane >> 3) + 8 * j; const LAS float* s = scr + (8 * c) * 33 + n;
        v4u o; o.x = pk2(s[0 * 33], s[1 * 33]); o.y = pk2(s[2 * 33], s[3 * 33]); o.z = pk2(s[4 * 33], s[5 * 33]); o.w = pk2(s[6 * 33], s[7 * 33]);
        const int ng = n0 + n; const int row = mode ? (((ng >> 7) << 8) + (ng & 127) + row_off) : (row_off + ng);
        *(v4u*)(WT + (size_t)row * K + k0 + 8 * c) = o; }
    LDS_WAIT(); asm volatile("" ::: "memory");
}
__device__ __forceinline__ void p0_weights(LAS unsigned char* lds, int wave, int lane, int gw, int NGW, const float* const* in, unsigned char* ws) {
    LAS float* scr = (LAS float*)(lds + wave * 16384);
    constexpr int I_W1 = (DM / 64) * (FF / 32), I_W2 = (FF / 64) * (DM / 32), I_WIN = (DM / 64) * ((NIN + 31) / 32), I_WO = (DM / 64) * (DM / 32), I_WP = (256 / 64) * (256 / 32);
    constexpr int N_FFN = 4 * (2 * I_W1 + I_W2), N_GLA = 2 * (I_WIN + I_WO), N_POOL = 8 * I_WP, NITEMS = N_FFN + N_GLA + N_POOL;
    for (int it = gw; it < NITEMS; it += NGW) {
        int r = it;
        if (r < N_FFN) { const int L = r / (2 * I_W1 + I_W2); r -= L * (2 * I_W1 + I_W2);
            if (r < I_W1) { tr_item(in[14] + (size_t)L * DM * FF, DM, FF, (bf16*)(ws + WS_W13 + L * SZ_W13), 1, 0, scr, r, lane); continue; } r -= I_W1;
            if (r < I_W1) { tr_item(in[15] + (size_t)L * DM * FF, DM, FF, (bf16*)(ws + WS_W13 + L * SZ_W13), 1, 128, scr, r, lane); continue; } r -= I_W1;
            tr_item(in[16] + (size_t)L * FF * DM, FF, DM, (bf16*)(ws + WS_W2 + L * SZ_W2), 0, 0, scr, r, lane); continue; }
        r -= N_FFN;
        if (r < N_GLA) { const int L = r / (I_WIN + I_WO); r -= L * (I_WIN + I_WO);
            if (r < I_WIN) { tr_item(in[9] + (size_t)L * DM * NIN, DM, NIN, (bf16*)(ws + WS_WIN + L * SZ_WIN), 0, 0, scr, r, lane); continue; } r -= I_WIN;
            tr_item(in[13] + (size_t)L * DM * DM, DM, DM, (bf16*)(ws + WS_WO + L * SZ_WO), 0, 0, scr, r, lane); continue; }
        r -= N_GLA;
        { const int jg = r / I_WP; r -= jg * I_WP;
          tr_item(in[7] + (size_t)jg * 65536, 256, 256, (bf16*)(ws + WS_WP + (jg >> 2) * SZ_WP), 0, (jg & 3) * 256, scr, r, lane); }
    }
    constexpr int PADV = (NINP - 3104) * DM * 2 / 16;
    for (int i = gw * 64 + lane; i < 2 * PADV; i += NGW * 64) { const int L = i / PADV, e = i - L * PADV;
        ((v4u*)(ws + WS_WIN + L * SZ_WIN + (size_t)3104 * DM * 2))[e] = (v4u){0u, 0u, 0u, 0u}; }
}

__device__ __forceinline__ void rms_row_bf16(const float* xrow, const float* g, bf16* orow, int lane) {
    const f32x4* xr = (const f32x4*)xrow + lane; const f32x4* gr = (const f32x4*)g + lane;
    f32x4 v[4]; float s = 0.f;
#pragma unroll
    for (int j = 0; j < 4; ++j) { v[j] = xr[64 * j]; s += (v[j].x * v[j].x + v[j].y * v[j].y) + (v[j].z * v[j].z + v[j].w * v[j].w); }
    const float rstd = rsqrtf(wave_sum(s) * (1.f / DM) + EPS);
    unsigned long long* o8 = (unsigned long long*)orow + lane;
#pragma unroll
    for (int j = 0; j < 4; ++j) { const f32x4 gg = gr[64 * j]; const f32x4 y = v[j] * rstd * gg;
        o8[64 * j] = (unsigned long long)pk2(y.x, y.y) | ((unsigned long long)pk2(y.z, y.w) << 32); }
}
__device__ __forceinline__ void rms_phase(int gw, int NGW, int lane, const float* X, const float* g, bf16* H) {
    for (int m = gw; m < M; m += NGW) rms_row_bf16(X + (size_t)m * DM, g, H + (size_t)m * DM, lane);
}
__device__ __forceinline__ void final_norm_phase(int gw, int NGW, int lane, float* X, const float* g) {
    for (int m = gw; m < M; m += NGW) {
        f32x4* xr = (f32x4*)(X + (size_t)m * DM) + lane; const f32x4* gr = (const f32x4*)g + lane;
        f32x4 v[4]; float s = 0.f;
#pragma unroll
        for (int j = 0; j < 4; ++j) { v[j] = xr[64 * j]; s += (v[j].x * v[j].x + v[j].y * v[j].y) + (v[j].z * v[j].z + v[j].w * v[j].w); }
        const float rstd = rsqrtf(wave_sum(s) * (1.f / DM) + EPS);
#pragma unroll
        for (int j = 0; j < 4; ++j) xr[64 * j] = v[j] * rstd * gr[64 * j];
    }
}

__device__ __forceinline__ void small_gemm_res(LAS unsigned char* lds, const bf16* A, const bf16* Bt, int K, float* X, int tid, int wave, int G, int bid) {
    constexpr int RS = 272, BUF = 2 * 64 * RS;
    const int lane = tid & 63, fr = lane & 15, fq = lane >> 4, rt = wave & 3, ch = wave >> 2;
    const int lr = tid >> 3, lc = (tid & 7) * 16;
    const int nch = K >> 7;
    for (int L = bid; L < 256; L += G) {
        const int tm = L >> 4, tn = L & 15;
        const v4u* ag = (const v4u*)(A + (size_t)(tm * 64 + lr) * K + lc); const v4u* bg = (const v4u*)(Bt + (size_t)(tn * 64 + lr) * K + lc);
        LAS unsigned char* wa = lds + lr * RS + lc * 2; LAS unsigned char* wb = wa + 64 * RS;
        v4u pa[2], pb[2], qa[2], qb[2];
        { const v4u a0 = ag[0], a1 = ag[1], b0 = bg[0], b1 = bg[1];
          pa[0] = ag[16]; pa[1] = ag[17]; pb[0] = bg[16]; pb[1] = bg[17];
          qa[0] = ag[32]; qa[1] = ag[33]; qb[0] = bg[32]; qb[1] = bg[33];
          *(LAS v4u*)wa = a0; *(LAS v4u*)(wa + 16) = a1; *(LAS v4u*)wb = b0; *(LAS v4u*)(wb + 16) = b1; }
        __syncthreads();
        f32x4 acc0 = (f32x4){0.f, 0.f, 0.f, 0.f}, acc1 = (f32x4){0.f, 0.f, 0.f, 0.f};
#define SG_COMPUTE(bufoff) { _Pragma("unroll") for (int ks = 0; ks < 4; ++ks) { const bf16x8 a = *(const LAS bf16x8*)(lds + (bufoff) + (16 * rt + fr) * RS + (32 * ks + 8 * fq) * 2); \
            const bf16x8 b0 = *(const LAS bf16x8*)(lds + (bufoff) + 64 * RS + (32 * ch + fr) * RS + (32 * ks + 8 * fq) * 2), b1 = *(const LAS bf16x8*)(lds + (bufoff) + 64 * RS + (32 * ch + 16 + fr) * RS + (32 * ks + 8 * fq) * 2); \
            acc0 = __builtin_amdgcn_mfma_f32_16x16x32_bf16(b0, a, acc0, 0, 0, 0); acc1 = __builtin_amdgcn_mfma_f32_16x16x32_bf16(b1, a, acc1, 0, 0, 0); } }
        for (int kc = 0; kc < nch; kc += 2) {
            SG_COMPUTE(0)
            *(LAS v4u*)(wa + BUF) = pa[0]; *(LAS v4u*)(wa + BUF + 16) = pa[1]; *(LAS v4u*)(wb + BUF) = pb[0]; *(LAS v4u*)(wb + BUF + 16) = pb[1];
            if (kc + 3 < nch) { pa[0] = ag[16 * (kc + 3)]; pa[1] = ag[16 * (kc + 3) + 1]; pb[0] = bg[16 * (kc + 3)]; pb[1] = bg[16 * (kc + 3) + 1]; }
            __syncthreads();
            SG_COMPUTE(BUF)
            if (kc + 2 < nch) { *(LAS v4u*)wa = qa[0]; *(LAS v4u*)(wa + 16) = qa[1]; *(LAS v4u*)wb = qb[0]; *(LAS v4u*)(wb + 16) = qb[1]; }
            if (kc + 4 < nch) { qa[0] = ag[16 * (kc + 4)]; qa[1] = ag[16 * (kc + 4) + 1]; qb[0] = bg[16 * (kc + 4)]; qb[1] = bg[16 * (kc + 4) + 1]; }
            __syncthreads();
        }
#undef SG_COMPUTE
        float* o = X + (size_t)(tm * 64 + 16 * rt + fr) * DM + tn * 64 + 32 * ch + 4 * fq;
        *(f32x4*)o = *(const f32x4*)o + acc0; *(f32x4*)(o + 16) = *(const f32x4*)(o + 16) + acc1;
    }
    __syncthreads();
}

__device__ __forceinline__ void pool_prep(LAS unsigned char* lds, int tid, int wave, int lane, int G, int bid,
                                          const float* xp, const float* xs, const float* gmix, const float* spool, bf16* DIFF, float* onp, float* ons) {
    typedef float f32x2 __attribute__((ext_vector_type(2)));
    LAS float* hb = (LAS float*)lds;
    for (int u = bid; u < 1024 + NBS; u += G) {
        const bool pr = u < 1024; const int b = pr ? (u >> 7) : (u - 1024); const int t0 = pr ? (u & 127) * 16 : 0; const int ntok = pr ? 16 : 8;
        {
            f32x4 v[4][4]; bool has[4], donorm[4];
#pragma unroll
            for (int k = 0; k < 4; ++k) { const int r = wave + 8 * k; const float* src = nullptr; donorm[k] = true;
                if (r < 15 + ntok) {
                    if (pr) { const int t = t0 - 15 + r; if (t >= 0) src = xp + ((size_t)b * TP + t) * DM; }
                    else { if (r < 15) { src = spool + ((size_t)b * 15 + r) * DM; donorm[k] = false; } else src = xs + ((size_t)b * TS + (r - 15)) * DM; } }
                has[k] = src != nullptr;
#pragma unroll
                for (int j = 0; j < 4; ++j) v[k][j] = has[k] ? ((const f32x4*)src + lane)[64 * j] : (f32x4){0.f, 0.f, 0.f, 0.f}; }
            const f32x4* gr = (const f32x4*)gmix + lane;
#pragma unroll
            for (int k = 0; k < 4; ++k) { const int r = wave + 8 * k;
                if (r < 15 + ntok) { float s = 0.f;
#pragma unroll
                    for (int j = 0; j < 4; ++j) s += (v[k][j].x * v[k][j].x + v[k][j].y * v[k][j].y) + (v[k][j].z * v[k][j].z + v[k][j].w * v[k][j].w);
                    const float rstd = (has[k] && donorm[k]) ? rsqrtf(wave_sum(s) * (1.f / DM) + EPS) : 1.f;
                    LAS f32x4* hrow = (LAS f32x4*)(hb + r * DM) + lane;
#pragma unroll
                    for (int j = 0; j < 4; ++j) hrow[64 * j] = (has[k] && donorm[k]) ? v[k][j] * rstd * gr[64 * j] : v[k][j]; } }
        }
        __syncthreads();
        const int c = 2 * tid, gi = tid >> 7, w = 2 << gi;
        f32x2 sum = (f32x2){0.f, 0.f};
        for (int l = 1; l < w; ++l) sum += *(const LAS f32x2*)(hb + (15 - l) * DM + c);
        for (int i = 0; i < ntok; ++i) {
            const f32x2 cur = *(const LAS f32x2*)(hb + (15 + i) * DM + c); sum += cur;
            const int cnt = pr ? ((t0 + i + 1) < w ? (t0 + i + 1) : w) : w; const float inv = 1.0f / (float)cnt;
            const f32x2 d = sum * inv - cur;
            const size_t row = pr ? ((size_t)b * TP + t0 + i) : ((size_t)MP + b * TS + i);
            *(unsigned*)(DIFF + ((size_t)gi * M + row) * 256 + (c & 255)) = pk2(d.x, d.y);
            sum -= *(const LAS f32x2*)(hb + (15 + i - w + 1) * DM + c);
        }
        if (pr) { if (t0 == TP - 16) for (int i = 1; i < 16; ++i) *(f32x2*)(onp + ((size_t)b * 15 + (i - 1)) * DM + c) = *(const LAS f32x2*)(hb + (15 + i) * DM + c); }
        else for (int i = 0; i < 15; ++i) *(f32x2*)(ons + ((size_t)b * 15 + i) * DM + c) = *(const LAS f32x2*)(hb + (8 + i) * DM + c);
        __syncthreads();
    }
}

constexpr int L_QH = 0, L_KH = 17408, L_KT = 34816, L_VT = 53248, L_AL = 90112, L_ALOW = 99328, L_DL = 105472, L_SSQ = 105984, L_TOT = 108032, L_WA = 112128, L_BA = 120320, L_NW = 120832, L_GLA_END = 121856;
constexpr int QS = 272, TSB = 144;
static_assert(L_GLA_END <= RING_BYTES, "GLA LDS");
__device__ __forceinline__ bf16x8 pack8(const f32x4 a, const f32x4 b) {
    v4u w; w.x = pg8::cvt_pk_bf16(a[0], a[1]); w.y = pg8::cvt_pk_bf16(a[2], a[3]); w.z = pg8::cvt_pk_bf16(b[0], b[1]); w.w = pg8::cvt_pk_bf16(b[2], b[3]);
    return __builtin_bit_cast(bf16x8, w);
}
__device__ __forceinline__ void gla_phase(LAS unsigned char* lds, int tid, int wave, int lane, int G, int bid, int phase, int jl,
                                          const float* const* in, float* out, unsigned char* ws) {
    typedef unsigned u32x2 __attribute__((ext_vector_type(2)));
    const bf16* PROJ = (const bf16*)(ws + WS_BIG); const float* ALOW = (const float*)(ws + WS_ALOW); bf16* GOUT = (bf16*)(ws + WS_H);
    float* DS = (float*)(ws + WS_DS); float* DSC = (float*)(ws + WS_DSC);
    const int nitems = phase == 0 ? (224 + 4 * NBS) : 256;
    const int tid_in = tid;
    for (int item = bid; item < nitems; item += G) {
        int tid = tid_in; asm volatile("" : "+v"(tid));
        int lane = tid & 63, fr = lane & 15, fq = lane >> 4;
        int b, h, row0, ntok, sc = 0; bool want_out, samp = false;
        if (phase == 0) { if (item < 224) { const int bh = item / 7; sc = item - bh * 7; b = bh >> 2; h = bh & 3; row0 = b * TP + sc * 256; ntok = 256; want_out = false; }
                          else { const int q = item - 224; b = q >> 2; h = q & 3; row0 = MP + b * TS; ntok = TS; want_out = true; samp = true; } }
        else { const int bh = item >> 3; sc = item & 7; b = bh >> 2; h = bh & 3; row0 = b * TP + sc * 256; ntok = 256; want_out = true; }
        const int bh = b * 4 + h;
        f32x4 S[8][2];
#pragma unroll
        for (int dt = 0; dt < 8; ++dt)
#pragma unroll
            for (int vt = 0; vt < 2; ++vt) S[dt][vt] = (f32x4){0.f, 0.f, 0.f, 0.f};
        if (samp) {
            const float* s0 = in[3] + ((size_t)(jl * NBS + b) * NH + h) * DK * DV;
#pragma unroll
            for (int dt = 0; dt < 8; ++dt)
#pragma unroll
                for (int vt = 0; vt < 2; ++vt)
#pragma unroll
                    for (int e = 0; e < 4; ++e) S[dt][vt][e] = s0[(size_t)(16 * dt + 4 * fq + e) * DV + 32 * wave + 16 * vt + fr];
        } else if (phase == 1 && sc > 0) {
            const float* dsp = DS + (size_t)(bh * 7 + sc - 1) * DK * DV;
#pragma unroll
            for (int dt = 0; dt < 8; ++dt)
#pragma unroll
                for (int vt = 0; vt < 2; ++vt) S[dt][vt] = *(const f32x4*)(dsp + (size_t)(((wave * 8 + dt) * 2 + vt) * 64 + lane) * 4);
        }
        { const int r = tid >> 5, d4 = (tid & 31) * 4;
          *(LAS f32x4*)(lds + L_WA + (r * 128 + d4) * 4) = *(const f32x4*)(in[10] + (size_t)jl * 16 * 512 + r * 512 + h * DK + d4) * 1.4426950408889634f;
          if (tid < 32) *(LAS f32x4*)(lds + L_BA + tid * 16) = *(const f32x4*)(in[11] + jl * 512 + h * DK + tid * 4) * 1.4426950408889634f;
          if (tid < 64) *(LAS f32x4*)(lds + L_NW + tid * 16) = *(const f32x4*)(in[12] + jl * DM + h * DV + tid * 4); }
        float btot0 = 0.f, btot1 = 0.f;
        const int nsub = (ntok + 63) >> 6;
        unsigned qn[8], kn[8]; v4u vn[4]; f32x4 aln;
#define GLA_LOAD(sbx) { const int tokv_ = (ntok - 64 * (sbx)) < 64 ? (ntok - 64 * (sbx)) : 64; const int rb_ = row0 + 64 * (sbx); const int dp_ = tid & 63, jp_ = tid & 31, vg_ = tid >> 5; \
            _Pragma("unroll") for (int i = 0; i < 8; ++i) { const int tok = 8 * wave + i; qn[i] = 0u; kn[i] = 0u; \
                if (tok < tokv_) { const unsigned* pr = (const unsigned*)(PROJ + (size_t)(rb_ + tok) * NPROJ + h * DK) + dp_; qn[i] = pr[0]; kn[i] = pr[256]; } } \
            _Pragma("unroll") for (int i = 0; i < 2; ++i) { const int tok = 2 * jp_ + i; vn[2 * i] = (v4u){0u, 0u, 0u, 0u}; vn[2 * i + 1] = (v4u){0u, 0u, 0u, 0u}; \
                if (tok < tokv_) { const v4u* pv = (const v4u*)(PROJ + (size_t)(rb_ + tok) * NPROJ + 1024 + h * DV + 16 * vg_); vn[2 * i] = pv[0]; vn[2 * i + 1] = pv[1]; } } \
            aln = (f32x4){0.f, 0.f, 0.f, 0.f}; if (tid < 256) { const int tok = tid >> 2; if (tok < tokv_) aln = *(const f32x4*)(ALOW + (size_t)(rb_ + tok) * 16 + 4 * (tid & 3)); } }
        GLA_LOAD(0)
        for (int sb = 0; sb < nsub; ++sb) {
            typedef float f32x2 __attribute__((ext_vector_type(2)));
            const int tokv = (ntok - 64 * sb) < 64 ? (ntok - 64 * sb) : 64; const int rbase = row0 + 64 * sb;
            asm volatile("" : "+v"(tid)); lane = tid & 63; fr = lane & 15; fq = lane >> 4;
            const int dp = tid & 63, jp = tid & 31, vg = tid >> 5;
            if (tid < 256) *(LAS f32x4*)(lds + L_ALOW + (tid >> 2) * 64 + 16 * (tid & 3)) = aln;
            __syncthreads();
            f32x2 bj[8];
            { f32x2 x[8]; const f32x2 bav = *(const LAS f32x2*)(lds + L_BA + dp * 8);
#pragma unroll
              for (int i = 0; i < 8; ++i) x[i] = bav;
#pragma unroll
              for (int r4 = 0; r4 < 4; ++r4) { const f32x2 w0 = *(const LAS f32x2*)(lds + L_WA + ((4 * r4 + 0) * 128 + 2 * dp) * 4), w1 = *(const LAS f32x2*)(lds + L_WA + ((4 * r4 + 1) * 128 + 2 * dp) * 4),
                                                            w2 = *(const LAS f32x2*)(lds + L_WA + ((4 * r4 + 2) * 128 + 2 * dp) * 4), w3 = *(const LAS f32x2*)(lds + L_WA + ((4 * r4 + 3) * 128 + 2 * dp) * 4);
                  f32x4 al[8];
#pragma unroll
                  for (int i = 0; i < 8; ++i) al[i] = *(const LAS f32x4*)(lds + L_ALOW + (8 * wave + i) * 64 + 16 * r4);
#pragma unroll
                  for (int i = 0; i < 8; ++i) x[i] = w0 * al[i][0] + x[i];
#pragma unroll
                  for (int i = 0; i < 8; ++i) x[i] = w1 * al[i][1] + x[i];
#pragma unroll
                  for (int i = 0; i < 8; ++i) x[i] = w2 * al[i][2] + x[i];
#pragma unroll
                  for (int i = 0; i < 8; ++i) x[i] = w3 * al[i][3] + x[i]; }
              f32x2 run = (f32x2){0.f, 0.f};
#pragma unroll
              for (int i = 0; i < 8; ++i) { f32x2 g;
                  g.x = (fminf(x[i].x, 0.f) - __builtin_amdgcn_logf(1.0f + __builtin_amdgcn_exp2f(-fabsf(x[i].x)))) * (1.0f / 16.0f); g.y = (fminf(x[i].y, 0.f) - __builtin_amdgcn_logf(1.0f + __builtin_amdgcn_exp2f(-fabsf(x[i].y)))) * (1.0f / 16.0f);
                  if (tokv < 64 && 8 * wave + i >= tokv) g = (f32x2){0.f, 0.f};
                  run += g; bj[i] = run; }
              *(LAS f32x2*)(lds + L_TOT + (wave * 128 + 2 * dp) * 4) = run; }
            __syncthreads();
            f32x2 pre = (f32x2){0.f, 0.f}, blast = (f32x2){0.f, 0.f};
#pragma unroll
            for (int q = 0; q < 8; ++q) { const f32x2 t = *(const LAS f32x2*)(lds + L_TOT + (q * 128 + 2 * dp) * 4); blast += t; if (q < wave) pre += t; }
            btot0 += blast.x; btot1 += blast.y;
            if (wave == 0) *(LAS f32x2*)(lds + L_DL + dp * 8) = (f32x2){__builtin_amdgcn_exp2f(blast.x), __builtin_amdgcn_exp2f(blast.y)};
            { unsigned kb[8];
#pragma unroll
              for (int i = 0; i < 8; ++i) { const int tok = 8 * wave + i; const f32x2 bb = bj[i] + pre;
                  const float e1x = __builtin_amdgcn_exp2f(blast.x - bb.x), e1y = __builtin_amdgcn_exp2f(blast.y - bb.y), e2x = __builtin_amdgcn_exp2f(bb.x - blast.x), e2y = __builtin_amdgcn_exp2f(bb.y - blast.y);
                  const unsigned qh = pg8::cvt_pk_bf16(bf2f((unsigned short)(qn[i] & 0xffffu)) * e2x, bf2f((unsigned short)(qn[i] >> 16)) * e2y);
                  const unsigned kh = pg8::cvt_pk_bf16(bf2f((unsigned short)(kn[i] & 0xffffu)) * e1x, bf2f((unsigned short)(kn[i] >> 16)) * e1y);
                  *(LAS unsigned*)(lds + L_QH + tok * QS + dp * 4) = qh; *(LAS unsigned*)(lds + L_KH + tok * QS + dp * 4) = kh; kb[i] = kh; }
              v4u k0, k1;
              k0.x = (kb[0] & 0xffffu) | (kb[1] << 16); k0.y = (kb[2] & 0xffffu) | (kb[3] << 16); k0.z = (kb[4] & 0xffffu) | (kb[5] << 16); k0.w = (kb[6] & 0xffffu) | (kb[7] << 16);
              k1.x = (kb[0] >> 16) | (kb[1] & 0xffff0000u); k1.y = (kb[2] >> 16) | (kb[3] & 0xffff0000u); k1.z = (kb[4] >> 16) | (kb[5] & 0xffff0000u); k1.w = (kb[6] >> 16) | (kb[7] & 0xffff0000u);
              *(LAS v4u*)(lds + L_KT + (2 * dp) * TSB + wave * 16) = k0; *(LAS v4u*)(lds + L_KT + (2 * dp + 1) * TSB + wave * 16) = k1; }
            {
#pragma unroll
              for (int hv = 0; hv < 2; ++hv) { const unsigned a4[4] = {vn[hv].x, vn[hv].y, vn[hv].z, vn[hv].w}, b4[4] = {vn[2 + hv].x, vn[2 + hv].y, vn[2 + hv].z, vn[2 + hv].w};
#pragma unroll
                  for (int k = 0; k < 4; ++k) { LAS unsigned char* p = lds + L_VT + (16 * vg + 8 * hv + 2 * k) * TSB + jp * 4;
                      *(LAS unsigned*)p = (a4[k] & 0xffffu) | (b4[k] << 16); *(LAS unsigned*)(p + TSB) = (a4[k] >> 16) | (b4[k] & 0xffff0000u); } } }
            __syncthreads();
            u32x2 rcur[4][2];
            if (want_out) {
#pragma unroll
                for (int it = 0; it < 4; ++it)
#pragma unroll
                    for (int vt = 0; vt < 2; ++vt) { rcur[it][vt] = (u32x2){0u, 0u};
                        if (16 * it + fr < tokv) rcur[it][vt] = *(const u32x2*)(PROJ + (size_t)(rbase + 16 * it + fr) * NPROJ + 2048 + h * DV + 32 * wave + 16 * vt + 4 * fq); } }
            if (sb + 1 < nsub) GLA_LOAD(sb + 1)
#pragma unroll
            for (int dt = 0; dt < 8; ++dt) { const f32x4 dv = *(const LAS f32x4*)(lds + L_DL + (16 * dt + 4 * fq) * 4); S[dt][0] = S[dt][0] * dv; S[dt][1] = S[dt][1] * dv; }
            if (want_out) {
                f32x4 O[2][4];
#pragma unroll
                for (int tt = 0; tt < 2; ++tt) { const int idx = 2 * wave + tt, it = idx >> 2, jt = idx & 3; f32x4 a = (f32x4){0.f, 0.f, 0.f, 0.f};
                    if (jt <= it) {
#pragma unroll
                        for (int ks = 0; ks < 4; ++ks) { const bf16x8 X = *(const LAS bf16x8*)(lds + L_KH + (16 * jt + fr) * QS + (32 * ks + 8 * fq) * 2);
                            const bf16x8 Y = *(const LAS bf16x8*)(lds + L_QH + (16 * it + fr) * QS + (32 * ks + 8 * fq) * 2);
                            a = __builtin_amdgcn_mfma_f32_16x16x32_bf16(X, Y, a, 0, 0, 0); }
                        const int ii = 16 * it + fr, j0 = 16 * jt + 4 * fq;
#pragma unroll
                        for (int e = 0; e < 4; ++e) if (j0 + e > ii) a[e] = 0.f;
                    }
                    u32x2 w2; w2.x = pg8::cvt_pk_bf16(a[0], a[1]); w2.y = pg8::cvt_pk_bf16(a[2], a[3]);
                    *(LAS u32x2*)(lds + L_AL + (16 * it + fr) * TSB + (16 * jt + 4 * fq) * 2) = w2; }
                __syncthreads();
                {
                bf16x8 Xs[2][4];
#pragma unroll
                for (int vt = 0; vt < 2; ++vt)
#pragma unroll
                    for (int dp = 0; dp < 4; ++dp) Xs[vt][dp] = pack8(S[2 * dp][vt], S[2 * dp + 1][vt]);
                bf16x8 XV[2][2];
#pragma unroll
                for (int vt = 0; vt < 2; ++vt)
#pragma unroll
                    for (int js = 0; js < 2; ++js) XV[vt][js] = *(const LAS bf16x8*)(lds + L_VT + (32 * wave + 16 * vt + fr) * TSB + (32 * js + 8 * fq) * 2);
#pragma unroll
                for (int it = 0; it < 4; ++it) {
                    bf16x8 YQ[4], YA[2];
#pragma unroll
                    for (int dp = 0; dp < 4; ++dp) { const u32x2 lo = *(const LAS u32x2*)(lds + L_QH + (16 * it + fr) * QS + (32 * dp + 4 * fq) * 2);
                        const u32x2 hi = *(const LAS u32x2*)(lds + L_QH + (16 * it + fr) * QS + (32 * dp + 16 + 4 * fq) * 2);
                        YQ[dp] = __builtin_bit_cast(bf16x8, (v4u){lo.x, lo.y, hi.x, hi.y}); }
#pragma unroll
                    for (int js = 0; js < 2; ++js) YA[js] = *(const LAS bf16x8*)(lds + L_AL + (16 * it + fr) * TSB + (32 * js + 8 * fq) * 2);
#pragma unroll
                    for (int vt = 0; vt < 2; ++vt) { f32x4 o = (f32x4){0.f, 0.f, 0.f, 0.f};
#pragma unroll
                        for (int dp = 0; dp < 4; ++dp) o = __builtin_amdgcn_mfma_f32_16x16x32_bf16(Xs[vt][dp], YQ[dp], o, 0, 0, 0);
#pragma unroll
                        for (int js = 0; js < 2; ++js) o = __builtin_amdgcn_mfma_f32_16x16x32_bf16(XV[vt][js], YA[js], o, 0, 0, 0);
                        O[vt][it] = o; }
                    __builtin_amdgcn_sched_barrier(0);
                }
                }
#pragma unroll
                for (int it = 0; it < 4; ++it) { float ss = 0.f;
#pragma unroll
                    for (int vt = 0; vt < 2; ++vt) { const f32x4 o = O[vt][it]; ss += (o[0] * o[0] + o[1] * o[1]) + (o[2] * o[2] + o[3] * o[3]); }
                    ss += __shfl_xor(ss, 16); ss += __shfl_xor(ss, 32);
                    if (fq == 0) *(LAS float*)(lds + L_SSQ + (wave * 64 + 16 * it + fr) * 4) = ss; }
                __syncthreads();
#pragma unroll
                for (int it = 0; it < 4; ++it) { const int tok = 16 * it + fr; float tot = 0.f;
#pragma unroll
                    for (int w8 = 0; w8 < 8; ++w8) tot += *(const LAS float*)(lds + L_SSQ + (w8 * 64 + tok) * 4);
                    const float rstd = rsqrtf(tot * (1.0f / DV) + EPS);
                    if (tok < tokv) { const size_t row = (size_t)(rbase + tok);
#pragma unroll
                        for (int vt = 0; vt < 2; ++vt) { const int vcol = h * DV + 32 * wave + 16 * vt + 4 * fq;
                            const u32x2 r2 = rcur[it][vt]; const f32x4 nw = *(const LAS f32x4*)(lds + L_NW + (32 * wave + 16 * vt + 4 * fq) * 4);
                            const f32x4 o = O[vt][it];
                            const float r0 = bf2f((unsigned short)(r2.x & 0xffffu)), r1 = bf2f((unsigned short)(r2.x >> 16)), r2f = bf2f((unsigned short)(r2.y & 0xffffu)), r3 = bf2f((unsigned short)(r2.y >> 16));
                            u32x2 w2; w2.x = pg8::cvt_pk_bf16(o[0] * rstd * nw[0] * r0, o[1] * rstd * nw[1] * r1);
                            w2.y = pg8::cvt_pk_bf16(o[2] * rstd * nw[2] * r2f, o[3] * rstd * nw[3] * r3);
                            *(u32x2*)(GOUT + row * DM + vcol) = w2; } }
                    __builtin_amdgcn_sched_barrier(0); }
            }
            __builtin_amdgcn_sched_barrier(0);
#pragma unroll
            for (int js = 0; js < 2; ++js)
#pragma unroll
                for (int vt = 0; vt < 2; ++vt) { const bf16x8 Yv = *(const LAS bf16x8*)(lds + L_VT + (32 * wave + 16 * vt + fr) * TSB + (32 * js + 8 * fq) * 2);
#pragma unroll
                    for (int dt = 0; dt < 8; ++dt) { const bf16x8 Xk = *(const LAS bf16x8*)(lds + L_KT + (16 * dt + fr) * TSB + (32 * js + 8 * fq) * 2);
                        S[dt][vt] = __builtin_amdgcn_mfma_f32_16x16x32_bf16(Xk, Yv, S[dt][vt], 0, 0, 0); }
                    __builtin_amdgcn_sched_barrier(0); }
            __syncthreads();
        }
        asm volatile("" : "+v"(tid)); lane = tid & 63; fr = lane & 15; fq = lane >> 4;
        if (phase == 0 && !samp) {
            float* dsp = DS + (size_t)(bh * 7 + sc) * DK * DV;
#pragma unroll
            for (int dt = 0; dt < 8; ++dt)
#pragma unroll
                for (int vt = 0; vt < 2; ++vt) *(f32x4*)(dsp + (size_t)(((wave * 8 + dt) * 2 + vt) * 64 + lane) * 4) = S[dt][vt];
            if (wave == 0) { DSC[(size_t)(bh * 7 + sc) * DK + 2 * (tid & 63)] = __builtin_amdgcn_exp2f(btot0); DSC[(size_t)(bh * 7 + sc) * DK + 2 * (tid & 63) + 1] = __builtin_amdgcn_exp2f(btot1); }
        } else if (samp || sc == 7) {
            float* so = samp ? out + O_NGS + ((size_t)(jl * NBS + b) * NH + h) * DK * DV : out + O_NGP + ((size_t)(jl * NBP + b) * NH + h) * DK * DV;
#pragma unroll
            for (int dt = 0; dt < 8; ++dt)
#pragma unroll
                for (int vt = 0; vt < 2; ++vt)
#pragma unroll
                    for (int e = 0; e < 4; ++e) so[(size_t)(16 * dt + 4 * fq + e) * DV + 32 * wave + 16 * vt + fr] = S[dt][vt][e];
        }
    }
}


__device__ __forceinline__ void gla_scan_phase(int gt, int NT, unsigned char* ws) {
    float* DS = (float*)(ws + WS_DS); const float* DSC = (const float*)(ws + WS_DSC);
    for (int c = gt; c < 32 * 8192; c += NT) {
        const int bh = c >> 13, e4 = c & 8191, ln = e4 & 63, dt = (e4 >> 7) & 7, dcol = 16 * dt + 4 * (ln >> 4);
        f32x4 ds[7], dv[7];
#pragma unroll
        for (int k = 0; k < 7; ++k) { ds[k] = *(const f32x4*)(DS + (size_t)(bh * 7 + k) * DK * DV + (size_t)e4 * 4); dv[k] = *(const f32x4*)(DSC + (size_t)(bh * 7 + k) * DK + dcol); }
        f32x4 run = (f32x4){0.f, 0.f, 0.f, 0.f};
#pragma unroll
        for (int k = 0; k < 7; ++k) { run = run * dv[k] + ds[k]; *(f32x4*)(DS + (size_t)(bh * 7 + k) * DK * DV + (size_t)e4 * 4) = run; }
    }
}

struct Args { const float* in[17]; float* out; unsigned char* ws; int ph_lo, ph_hi; };
constexpr int N_PHASES = 29;
__global__ void __launch_bounds__(NWAVES * 64, 2) mk_fwd(Args args) {
    extern __shared__ __attribute__((aligned(16))) unsigned char lds_raw[];
    LAS unsigned char* lds = (LAS unsigned char*)lds_raw;
    volatile LAS unsigned* MISC = (volatile LAS unsigned*)(lds + MISC_OFF);
    for (int u = threadIdx.x; u < (LDS_BYTES - LDSCTL_OFF) / 4; u += NWAVES * 64) ((LAS unsigned*)(lds + LDSCTL_OFF))[u] = 0u;
    __syncthreads();
    XcdBarrier bar = xcd_barrier_post((unsigned*)(args.ws + WS_CTL) + CW_BAR, MISC + 8);
    const int lo = args.ph_lo, hi = args.ph_hi;
    const int wave0 = __builtin_amdgcn_readfirstlane(threadIdx.x >> 6);
#define PH_BEGIN(k) if ((k) >= lo && (k) < hi) { int tid = wave0 * 64 + (int)__builtin_amdgcn_mbcnt_hi(~0u, __builtin_amdgcn_mbcnt_lo(~0u, 0u)); asm volatile("" : "+v"(tid)); const int lane = tid & 63, wave = wave0; \
        const int G = gridDim.x, bid = blockIdx.x; const int vcu = (G % 8 == 0) ? (bid % 8) * (G / 8) + bid / 8 : bid; const int gw = vcu * NWAVES + wave, NGW = G * NWAVES; \
        unsigned char* ws = args.ws; float* out = args.out; const float* const* in = args.in; bf16* Hb = (bf16*)(ws + WS_H); bf16* BIG = (bf16*)(ws + WS_BIG); float* Xs_ = out + O_YS; \
        (void)lane; (void)gw; (void)NGW; (void)Hb; (void)BIG; (void)Xs_; (void)in;
#define PH_END(k)   if ((k) + 1 < hi) xcd_barrier(bar); }

#define POOL_GEMM(k, L) PH_BEGIN(k) { constexpr int jl = (L) >> 1; \
        pg8::Gemm g{BIG, (const bf16*)(ws + WS_WP + jl * SZ_WP), 4 * M, 1024, 256}; pg8::PoolOrder S{G, bid}; \
        pg8::EpiRes<true> E{(L) == 0 ? in[0] : out, (L) == 0 ? in[1] : Xs_, out, in[8] + jl * DM}; \
        pg8::gemm_phase<pg8::EpiRes<true>, pg8::PoolOrder, true, true>(lds, g, S, E, tid); } PH_END(k)
#define RMS_PH(k, gain) PH_BEGIN(k) rms_phase(gw, NGW, lane, out, (gain), Hb); PH_END(k)
#define FFN1(k, L) PH_BEGIN(k) { pg8::Gemm g{Hb, (const bf16*)(ws + WS_W13 + (L) * SZ_W13), M, NG1, DM}; pg8::StaticOrder S; S.init(M, NG1, G, bid, DM); \
        pg8::EpiSwiglu E{BIG}; pg8::gemm_phase<pg8::EpiSwiglu, pg8::StaticOrder, true, true>(lds, g, S, E, tid); } PH_END(k)
#define FFN2(k, L) PH_BEGIN(k) { pg8::Gemm g{BIG, (const bf16*)(ws + WS_W2 + (L) * SZ_W2), M, DM, FF}; pg8::PanelOrder S{G, bid, FF / 64}; \
        pg8::EpiRes<false> E{out, Xs_, out, nullptr}; pg8::gemm_phase<pg8::EpiRes<false>, pg8::PanelOrder, true, true>(lds, g, S, E, tid); \
        small_gemm_res(lds, BIG + (size_t)MP * FF, (const bf16*)(ws + WS_W2 + (L) * SZ_W2), FF, Xs_, tid, wave, G, bid); } PH_END(k)
#define PROJ_PH(k, jl) PH_BEGIN(k) { pg8::Gemm g{Hb, (const bf16*)(ws + WS_WIN + (jl) * SZ_WIN), M, NINP, DM}; pg8::StaticOrder S; S.init(M, NINP, G, bid, DM); \
        pg8::EpiProj E{BIG, (float*)(ws + WS_ALOW)}; pg8::gemm_phase<pg8::EpiProj, pg8::StaticOrder, true, true>(lds, g, S, E, tid); } PH_END(k)
#define WO_PH(k, jl) PH_BEGIN(k) { pg8::Gemm g{Hb, (const bf16*)(ws + WS_WO + (jl) * SZ_WO), M, DM, DM}; pg8::PanelOrder S{G, bid, DM / 64}; \
        pg8::EpiRes<false> E{out, Xs_, out, nullptr}; pg8::gemm_phase<pg8::EpiRes<false>, pg8::PanelOrder, true, true>(lds, g, S, E, tid); \
        small_gemm_res(lds, Hb + (size_t)MP * DM, (const bf16*)(ws + WS_WO + (jl) * SZ_WO), DM, Xs_, tid, wave, G, bid); } PH_END(k)
#define GLA_PH(k, sub, jl) PH_BEGIN(k) gla_phase(lds, tid, wave, lane, G, bid, (sub), (jl), in, out, ws); PH_END(k)

#ifdef NO_GLA
#undef GLA_PH
#define GLA_PH(k, sub, jl)
#endif
#ifdef NO_GEMM
#undef POOL_GEMM
#undef FFN1
#undef FFN2
#undef PROJ_PH
#undef WO_PH
#define POOL_GEMM(k, L)
#define FFN1(k, L)
#define FFN2(k, L)
#define PROJ_PH(k, jl)
#define WO_PH(k, jl)
#endif
#ifdef ONLY_FFN1
#undef POOL_GEMM
#undef FFN2
#undef PROJ_PH
#undef WO_PH
#define POOL_GEMM(k, L)
#define FFN2(k, L)
#define PROJ_PH(k, jl)
#define WO_PH(k, jl)
#endif
    PH_BEGIN(0)
        p0_weights(lds, wave, lane, gw, NGW, in, ws);
        __syncthreads();
        pool_prep(lds, tid, wave, lane, G, bid, in[0], in[1], in[4] + 0 * DM, in[2], BIG, out + O_NPP, out + O_NPS);
    PH_END(0)
    POOL_GEMM(1, 0)
    RMS_PH(2, in[5] + 0 * DM)
    FFN1(3, 0)
    FFN2(4, 0)
    RMS_PH(5, in[4] + 1 * DM)
    PROJ_PH(6, 0)
    GLA_PH(7, 0, 0)
    PH_BEGIN(8)
        gla_scan_phase(vcu * (NWAVES * 64) + tid, G * NWAVES * 64, ws);
    PH_END(8)
    GLA_PH(9, 1, 0)
    WO_PH(10, 0)
    RMS_PH(11, in[5] + 1 * DM)
    FFN1(12, 1)
    FFN2(13, 1)
    PH_BEGIN(14)
        pool_prep(lds, tid, wave, lane, G, bid, out, Xs_, in[4] + 2 * DM, in[2] + (size_t)NBS * 15 * DM, BIG, out + O_NPP + (size_t)NBP * 15 * DM, out + O_NPS + (size_t)NBS * 15 * DM);
    PH_END(14)
    POOL_GEMM(15, 2)
    RMS_PH(16, in[5] + 2 * DM)
    FFN1(17, 2)
    FFN2(18, 2)
    RMS_PH(19, in[4] + 3 * DM)
    PROJ_PH(20, 1)
    GLA_PH(21, 0, 1)
    PH_BEGIN(22)
        gla_scan_phase(vcu * (NWAVES * 64) + tid, G * NWAVES * 64, ws);
    PH_END(22)
    GLA_PH(23, 1, 1)
    WO_PH(24, 1)
    RMS_PH(25, in[5] + 3 * DM)
    FFN1(26, 3)
    FFN2(27, 3)
    PH_BEGIN(28)
        final_norm_phase(gw, NGW, lane, out, in[6]);
    PH_END(28)
}

#ifndef MK_SPLIT
#define MK_SPLIT 0
#endif
extern "C" void kernel_launch(void* const* d_in, const int* in_sizes, int n_in, void* d_out, int out_size, void* d_ws, size_t ws_size, hipStream_t stream) {
    static int grid = 0;
    if (grid == 0) {
        if (n_in != 17 || (size_t)out_size != O_END || ws_size < WS_END) { fprintf(stderr, "kernel_launch: unexpected shapes (n_in %d out %d ws %zu)\n", n_in, out_size, ws_size); grid = -1; return; }
        int dev = 0, cus = 0, per_cu = 0;
        if (hipGetDevice(&dev) != hipSuccess || hipDeviceGetAttribute(&cus, hipDeviceAttributeMultiprocessorCount, dev) != hipSuccess) { grid = -1; return; }
        if (hipFuncSetAttribute((const void*)mk_fwd, hipFuncAttributeMaxDynamicSharedMemorySize, LDS_BYTES) != hipSuccess) { fprintf(stderr, "kernel_launch: hipFuncSetAttribute failed\n"); grid = -1; return; }
        if (hipOccupancyMaxActiveBlocksPerMultiprocessor(&per_cu, (const void*)mk_fwd, NWAVES * 64, LDS_BYTES) != hipSuccess || per_cu < 1) { fprintf(stderr, "kernel_launch: occupancy query failed (%d)\n", per_cu); (void)hipGetLastError(); per_cu = 1; }
        grid = cus;
        if (grid > cus * per_cu) grid = cus * per_cu;
    }
    if (grid < 0) return;
    if (hipMemsetAsync((char*)d_ws + WS_CTL, 0, CTL_ZERO_BYTES, stream) != hipSuccess) { fprintf(stderr, "kernel_launch: memset failed\n"); return; }
    Args a{};
    for (int i = 0; i < 17; ++i) a.in[i] = (const float*)d_in[i];
    a.out = (float*)d_out; a.ws = (unsigned char*)d_ws;
#if MK_SPLIT
    for (int p = 0; p < N_PHASES; ++p) { a.ph_lo = p; a.ph_hi = p + 1; hipLaunchKernelGGL(mk_fwd, dim3(grid), dim3(NWAVES * 64), LDS_BYTES, stream, a); }
#else
    a.ph_lo = 0; a.ph_hi = N_PHASES;
    void* kargs[] = {&a};
    hipError_t e = hipLaunchCooperativeKernel((const void*)mk_fwd, dim3(grid), dim3(NWAVES * 64), kargs, LDS_BYTES, stream);
    if (e != hipSuccess) fprintf(stderr, "kernel_launch: cooperative launch failed: %s (grid %d)\n", hipGetErrorString(e), grid);
#endif
}
```

```cpp
#include <hip/hip_runtime.h>
#include <cstdio>
#include <cstdint>
namespace pg8 {
#define PG8_LAS __attribute__((address_space(3)))
typedef unsigned short bf16_t;
typedef short bf16x8 __attribute__((ext_vector_type(8)));
typedef float f32x4 __attribute__((ext_vector_type(4)));
typedef unsigned u32x4 __attribute__((ext_vector_type(4)));
constexpr int BM = 256, BK = 64, HALF = 128, HTB = HALF * BK * 2  , STAGE_BYTES = 8 * HTB, NXCD = 8, WGM = 4;

__host__ __device__ __forceinline__ int lds_byte(int r, int c) { const int st = (r >> 4) * 2 + (c >> 5), rr = r & 15, cc = c & 31, ob = rr * 64 + cc * 2; return st * 1024 + (ob ^ (((ob >> 9) & 1) << 5)); }
__host__ __device__ __forceinline__ void stage_rc(int b, int& R, int& C) { const int st = b / 1024, sb = b % 1024, swz = sb ^ (((sb >> 9) & 1) << 5); R = (st >> 1) * 16 + swz / 64; C = (st & 1) * 32 + (swz % 64) / 2; }
__host__ __device__ __forceinline__ int perm32(int rho) { const int n = rho >> 4, i = rho & 15; return 8 * (i >> 2) + 4 * n + (i & 3); }

struct Unit { int pm, pn, k0, nt, part; };
struct Gemm { const bf16_t* A; const bf16_t* Bt; int M, N, K; };

struct StaticOrder {
    int nM, nN, nwg, G, c, ntk;
    __host__ __device__ void init(int M, int N, int G_, int c_, int K_) { nM = M / BM; nN = N / BM; nwg = nM * nN; G = G_; c = c_; ntk = K_ / BK; }
    __host__ __device__ bool next(int i, Unit& u) const {
        const long L = (long)i * G + c; if (L >= nwg) return false;
        int wgid = (int)L; { const int q = nwg / NXCD, r = nwg % NXCD, xcd = wgid % NXCD, off = wgid / NXCD; wgid = (xcd < r ? xcd * (q + 1) : r * (q + 1) + (xcd - r) * q) + off; }
        const int nig = WGM * nN, gid = wgid / nig, fm = gid * WGM, gsz = (nM - fm) < WGM ? (nM - fm) : WGM;
        u.pm = fm + ((wgid % nig) % gsz); u.pn = (wgid % nig) / gsz; u.k0 = 0; u.nt = ntk; u.part = 0; return true;
    }
    __device__ __forceinline__ void a_ready(const Unit&) const {}
    __device__ __forceinline__ void done(const Unit&) const {}
};

__device__ __forceinline__ unsigned cvt_pk_bf16(float lo, float hi) { unsigned r; asm volatile("v_cvt_pk_bf16_f32 %0, %1, %2" : "=v"(r) : "v"(lo), "v"(hi)); return r; }
typedef float f32x2 __attribute__((ext_vector_type(2)));
typedef unsigned u32x2 __attribute__((ext_vector_type(2)));
__device__ __forceinline__ float silu_f(float x) { return x * __builtin_amdgcn_rcpf(1.0f + __builtin_amdgcn_exp2f(x * -1.4426950408889634f)); }
constexpr int P_DM = 1024, P_FF = 2816, P_NT = 68  , P_PROJ = 3072;

__device__ __forceinline__ unsigned swiglu_pk(f32x2 g, f32x2 u) {
    const f32x2 t = g * -1.4426950408889634f; f32x2 e; e.x = __builtin_amdgcn_exp2f(t.x); e.y = __builtin_amdgcn_exp2f(t.y);
    const f32x2 d = e + 1.0f; f32x2 r; r.x = __builtin_amdgcn_rcpf(d.x); r.y = __builtin_amdgcn_rcpf(d.y);
    const f32x2 o = (g * u) * r; return cvt_pk_bf16(o.x, o.y);
}
struct EpiSwiglu {
    static constexpr bool PERM = true, AFTER_DRAIN = false;
    bf16_t* U;
    __device__ __forceinline__ void operator()(const f32x4 (&acc)[2][2][4][2], const Unit& u, int wr, int wc, int fr, int fq) const {
        const int row0 = u.pm * BM + wr * 64 + fr, col0 = u.pn * 128 + wc * 32 + 8 * fq;
#pragma unroll
        for (int ai = 0; ai < 2; ++ai)
#pragma unroll
            for (int m = 0; m < 4; ++m) { bf16_t* rowp = U + (size_t)(row0 + ai * HALF + m * 16) * P_FF + col0;
                const f32x4 g0 = acc[ai][0][m][0], g1 = acc[ai][0][m][1], u0 = acc[ai][1][m][0], u1 = acc[ai][1][m][1];
                u32x4 w; w.x = swiglu_pk((f32x2){g0[0], g0[1]}, (f32x2){u0[0], u0[1]}); w.y = swiglu_pk((f32x2){g0[2], g0[3]}, (f32x2){u0[2], u0[3]});
                w.z = swiglu_pk((f32x2){g1[0], g1[1]}, (f32x2){u1[0], u1[1]}); w.w = swiglu_pk((f32x2){g1[2], g1[3]}, (f32x2){u1[2], u1[3]});
                *(u32x4*)rowp = w; }
    }
};
struct EpiProj {
    static constexpr bool PERM = true, AFTER_DRAIN = false;
    bf16_t* P; float* AL;
    __device__ __forceinline__ void operator()(const f32x4 (&acc)[2][2][4][2], const Unit& u, int wr, int wc, int fr, int fq) const {
        const int row0 = u.pm * BM + wr * 64 + fr;
        if (u.pn >= 8 && u.pn < 12) {
            const int col0 = u.pn * BM + wc * 32 + 8 * fq; const f32x2 one = (f32x2){1.f, 1.f};
#pragma unroll
            for (int ai = 0; ai < 2; ++ai)
#pragma unroll
                for (int m = 0; m < 4; ++m) { bf16_t* rowp = P + (size_t)(row0 + ai * HALF + m * 16) * P_PROJ + col0;
#pragma unroll
                    for (int bj = 0; bj < 2; ++bj) { const f32x4 v0 = acc[ai][bj][m][0], v1 = acc[ai][bj][m][1];
                        u32x4 w; w.x = swiglu_pk((f32x2){v0[0], v0[1]}, one); w.y = swiglu_pk((f32x2){v0[2], v0[3]}, one); w.z = swiglu_pk((f32x2){v1[0], v1[1]}, one); w.w = swiglu_pk((f32x2){v1[2], v1[3]}, one);
                        *(u32x4*)(rowp + bj * HALF) = w; } }
        } else if (u.pn < 12) {
            const float sc = u.pn < 2 ? 0.08838834764831845f : 1.0f;
            const int col0 = u.pn * BM + wc * 32 + 8 * fq;
#pragma unroll
            for (int ai = 0; ai < 2; ++ai)
#pragma unroll
                for (int m = 0; m < 4; ++m) { bf16_t* rowp = P + (size_t)(row0 + ai * HALF + m * 16) * P_PROJ + col0;
#pragma unroll
                    for (int bj = 0; bj < 2; ++bj) { const f32x4 v0 = acc[ai][bj][m][0] * sc, v1 = acc[ai][bj][m][1] * sc;
                        u32x4 w; w.x = cvt_pk_bf16(v0[0], v0[1]); w.y = cvt_pk_bf16(v0[2], v0[3]); w.z = cvt_pk_bf16(v1[0], v1[1]); w.w = cvt_pk_bf16(v1[2], v1[3]);
                        *(u32x4*)(rowp + bj * HALF) = w; } }
        } else if (wc == 0 && fq < 2) {
#pragma unroll
            for (int ai = 0; ai < 2; ++ai)
#pragma unroll
                for (int m = 0; m < 4; ++m) { float* rowp = AL + (size_t)(row0 + ai * HALF + m * 16) * 16 + 8 * fq;
                    *(f32x4*)rowp = acc[ai][0][m][0]; *(f32x4*)(rowp + 4) = acc[ai][0][m][1]; }
        }
    }
};
template <bool POOL> struct EpiRes {
    static constexpr bool PERM = false, AFTER_DRAIN = false;
    const float* bp; const float* bs; float* out; const float* scale;
    __device__ __forceinline__ void operator()(const f32x4 (&acc)[2][2][4][2], const Unit& u, int wr, int wc, int fr, int fq) const {
        const int pm = POOL ? (u.pm - P_NT * u.pn) : u.pm, pn = u.pn;
        const float* base = pm < 64 ? bp + (size_t)pm * BM * P_DM : bs + (size_t)(pm - 64) * BM * P_DM;
        float* o = out + (size_t)pm * BM * P_DM;
        int frq = fr + 16 * fq; asm volatile("" : "+v"(frq));
        const unsigned col0 = (unsigned)(pn * BM + wc * 32 + 4 * (frq >> 4));
        const unsigned roff = (unsigned)(wr * 64 + (frq & 15)) * P_DM + col0;
#pragma unroll
        for (int ai = 0; ai < 2; ++ai)
#pragma unroll
            for (int m = 0; m < 4; ++m) { const unsigned off = roff + (unsigned)(ai * HALF + m * 16) * P_DM;
#pragma unroll
                for (int bj = 0; bj < 2; ++bj)
#pragma unroll
                    for (int n = 0; n < 2; ++n) { f32x4 a = acc[ai][bj][m][n]; if (POOL) a = a * *(const f32x4*)(scale + col0 + bj * HALF + n * 16);
                        const f32x4 b = *(const f32x4*)(base + off + bj * HALF + n * 16); *(f32x4*)(o + off + bj * HALF + n * 16) = a + b; } }
    }
};
struct PoolOrder {
    int G, c;
    __device__ bool next(int i, Unit& u) const { const int L = i * G + c; if (L >= 4 * P_NT) return false; const int g = L & 3, pm = L >> 2; u.pm = g * P_NT + pm; u.pn = g; u.k0 = 0; u.nt = 4; u.part = 0; return true; }
    __device__ __forceinline__ void a_ready(const Unit&) const {}
    __device__ __forceinline__ void done(const Unit&) const {}
};
struct PanelOrder {
    int G, c, ntk;
    __device__ bool next(int i, Unit& u) const {
        const int L = i * G + c; if (L >= 256) return false;
        const int x = L & 7, idx = L >> 3; u.pm = x * 8 + (idx >> 2); u.pn = idx & 3; u.k0 = 0; u.nt = ntk; u.part = 0; return true;
    }
    __device__ __forceinline__ void a_ready(const Unit&) const {}
    __device__ __forceinline__ void done(const Unit&) const {}
};
template <class Epi, class Sched, bool ALIGN_EPI = false, bool SP2 = false>
__device__ __forceinline__ void gemm_phase(PG8_LAS unsigned char* lds, const Gemm g, const Sched& S, const Epi& E, const int tid_in) {
    int tid_raw = tid_in; asm volatile("" : "+v"(tid_raw));
    const int tid = tid_raw, wid = __builtin_amdgcn_readfirstlane(tid >> 6), lane = tid & 63, wr = wid >> 2, wc = wid & 3, fr = lane & 15, fq = lane >> 4;
    const int K = g.K;
    unsigned voffA[2], voffB[2];
#pragma unroll
    for (int i = 0; i < 2; ++i) { int R, C; stage_rc(tid * 16 + i * 8192, R, C); const int Rb = Epi::PERM ? ((R & ~31) + perm32(R & 31)) : R;
        voffA[i] = (unsigned)(R * K + C) * 2u; voffB[i] = (unsigned)(Rb * K + C) * 2u; }
    const size_t kstep = (size_t)(BK * 2);
    const size_t hstep = (size_t)HALF * K * 2;
    const size_t tstep = 2 * hstep;
    const unsigned ldsw = (unsigned)wid * 1024u;
    const int aoff = lds_byte(wr * 64 + fr, fq * 8), boff = lds_byte(wc * 32 + fr, fq * 8);
#define PG8_SA(b, h) (((b) * 2 + (h)) * HTB)
#define PG8_SB(b, h) ((4 + (b) * 2 + (h)) * HTB)
#define PG8_STAGE(bufoff, gbase, voff) do { _Pragma("unroll") for (int _i = 0; _i < 2; ++_i) \
        __builtin_amdgcn_global_load_lds((const unsigned*)((const char*)(gbase) + (voff)[_i]), (PG8_LAS unsigned*)(lds + (bufoff) + ldsw + _i * 8192), 16, 0, 0); } while (0)
#define PG8_LDA(dst, b, h) do { _Pragma("unroll") for (int m = 0; m < 4; ++m) _Pragma("unroll") for (int k = 0; k < 2; ++k) dst[m][k] = *(const PG8_LAS bf16x8*)(lds + PG8_SA(b, h) + aoff + m * 2048 + k * 1024); } while (0)
#define PG8_LDB(dst, b, h) do { _Pragma("unroll") for (int n = 0; n < 2; ++n) _Pragma("unroll") for (int k = 0; k < 2; ++k) dst[n][k] = *(const PG8_LAS bf16x8*)(lds + PG8_SB(b, h) + boff + n * 2048 + k * 1024); } while (0)
#define PG8_MMA(ai, bj, At, Bt) do { __builtin_amdgcn_s_setprio(1); _Pragma("unroll") for (int m = 0; m < 4; ++m) _Pragma("unroll") for (int n = 0; n < 2; ++n) _Pragma("unroll") for (int k = 0; k < 2; ++k) \
        acc[ai][bj][m][n] = __builtin_amdgcn_mfma_f32_16x16x32_bf16(Bt[n][k], At[m][k], acc[ai][bj][m][n], 0, 0, 0); __builtin_amdgcn_s_setprio(0); } while (0)
#define PG8_WAIT_V(n) asm volatile("s_waitcnt vmcnt(" #n ")" ::: "memory")
#define PG8_WAIT_L(n) asm volatile("s_waitcnt lgkmcnt(" #n ")" ::: "memory")
#define PG8_BAR __builtin_amdgcn_s_barrier()
#define PG8_SCHED __builtin_amdgcn_sched_barrier(0)
    Unit cur, nxt; int ui = 0;
    if (!S.next(0, cur)) return;
    f32x4 acc[2][2][4][2];
#pragma unroll
    for (int a = 0; a < 2; ++a)
#pragma unroll
        for (int b = 0; b < 2; ++b)
#pragma unroll
            for (int m = 0; m < 4; ++m)
#pragma unroll
                for (int n = 0; n < 2; ++n) acc[a][b][m][n] = (f32x4){0.f, 0.f, 0.f, 0.f};
    bf16x8 At[4][2], B0[2][2], B1[2][2];
    const char* cA = (const char*)g.A + (size_t)cur.pm * tstep + (size_t)cur.k0 * 2; const char* cB = (const char*)g.Bt + (size_t)cur.pn * tstep + (size_t)cur.k0 * 2;
    S.a_ready(cur);
    if constexpr (SP2) {
        PG8_STAGE(PG8_SB(0, 0), cB, voffB); PG8_STAGE(PG8_SB(0, 1), cB + hstep, voffB); PG8_STAGE(PG8_SA(0, 0), cA, voffA); PG8_STAGE(PG8_SA(0, 1), cA + hstep, voffA);
        if (wr == 1) PG8_BAR;
        PG8_WAIT_V(2); PG8_BAR;
        PG8_STAGE(PG8_SB(1, 0), cB + kstep, voffB); PG8_STAGE(PG8_SA(1, 0), cA + kstep, voffA); PG8_STAGE(PG8_SB(1, 1), cB + hstep + kstep, voffB);
        PG8_WAIT_V(6); PG8_BAR;
    } else {
        PG8_STAGE(PG8_SB(0, 0), cB, voffB); PG8_STAGE(PG8_SA(0, 0), cA, voffA); PG8_STAGE(PG8_SB(0, 1), cB + hstep, voffB); PG8_STAGE(PG8_SA(0, 1), cA + hstep, voffA);
        if (wr == 1) PG8_BAR;
        PG8_WAIT_V(4); PG8_BAR;
        PG8_STAGE(PG8_SB(1, 0), cB + kstep, voffB); PG8_STAGE(PG8_SA(1, 0), cA + kstep, voffA); PG8_STAGE(PG8_SB(1, 1), cB + hstep + kstep, voffB);
        PG8_WAIT_V(6); PG8_BAR;
    }
    for (;;) {
        const bool has_next = S.next(ui + 1, nxt);
        const char* nA = has_next ? (const char*)g.A + (size_t)nxt.pm * tstep + (size_t)nxt.k0 * 2 : cA; const char* nB = has_next ? (const char*)g.Bt + (size_t)nxt.pn * tstep + (size_t)nxt.k0 * 2 : cB;
        const int nt = cur.nt;
        for (int t = 0; t < nt; t += 2) {
            const bool last = (t == nt - 2);
            const char* a1 = cA + (size_t)(t + 1) * kstep;
            const char* a2 = last ? nA : cA + (size_t)(t + 2) * kstep; const char* b2 = last ? nB : cB + (size_t)(t + 2) * kstep;
            const char* a3 = a2 + kstep; const char* b3 = b2 + kstep;
            if (last && has_next) S.a_ready(nxt);
            if constexpr (SP2) {
            PG8_LDB(B0, 0, 0); PG8_LDB(B1, 0, 1); PG8_SCHED; PG8_LDA(At, 0, 0); PG8_STAGE(PG8_SA(1, 1), a1 + hstep, voffA);
            PG8_WAIT_V(8); PG8_WAIT_L(0); PG8_BAR; PG8_MMA(0, 0, At, B0); PG8_MMA(0, 1, At, B1); PG8_BAR; PG8_SCHED;
            PG8_LDA(At, 0, 1); PG8_STAGE(PG8_SB(0, 0), b2, voffB); PG8_STAGE(PG8_SB(0, 1), b2 + hstep, voffB); PG8_STAGE(PG8_SA(0, 0), a2, voffA);
            PG8_WAIT_V(8); PG8_WAIT_L(0); PG8_BAR; PG8_MMA(1, 0, At, B0); PG8_MMA(1, 1, At, B1); PG8_BAR; PG8_SCHED;
            PG8_LDB(B0, 1, 0); PG8_LDB(B1, 1, 1); PG8_SCHED; PG8_LDA(At, 1, 0); PG8_STAGE(PG8_SA(0, 1), a2 + hstep, voffA);
            PG8_WAIT_V(8); PG8_WAIT_L(0); PG8_BAR; PG8_MMA(0, 0, At, B0); PG8_MMA(0, 1, At, B1); PG8_BAR; PG8_SCHED;
            PG8_LDA(At, 1, 1); PG8_STAGE(PG8_SB(1, 0), b3, voffB); PG8_STAGE(PG8_SB(1, 1), b3 + hstep, voffB); PG8_STAGE(PG8_SA(1, 0), a3, voffA);
            PG8_WAIT_V(8); PG8_WAIT_L(0); PG8_BAR; PG8_MMA(1, 0, At, B0); PG8_MMA(1, 1, At, B1); PG8_BAR; PG8_SCHED;
            } else {
            PG8_LDB(B0, 0, 0); PG8_SCHED; PG8_LDA(At, 0, 0); PG8_STAGE(PG8_SA(1, 1), a1 + hstep, voffA);
            PG8_WAIT_L(8); PG8_BAR; PG8_WAIT_L(0); PG8_MMA(0, 0, At, B0); PG8_BAR; PG8_SCHED;
            PG8_LDB(B1, 0, 1); PG8_STAGE(PG8_SB(0, 0), b2, voffB);
            PG8_BAR; PG8_WAIT_L(0); PG8_MMA(0, 1, At, B1); PG8_BAR;
            PG8_LDA(At, 0, 1); PG8_STAGE(PG8_SA(0, 0), a2, voffA);
            PG8_BAR; PG8_WAIT_L(0); PG8_MMA(1, 0, At, B0); PG8_BAR; PG8_SCHED;
            PG8_STAGE(PG8_SB(0, 1), b2 + hstep, voffB);
            PG8_WAIT_V(6); PG8_BAR; PG8_MMA(1, 1, At, B1); PG8_BAR;
            PG8_LDB(B0, 1, 0); PG8_SCHED; PG8_LDA(At, 1, 0); PG8_STAGE(PG8_SA(0, 1), a2 + hstep, voffA);
            PG8_WAIT_L(8); PG8_BAR; PG8_WAIT_L(0); PG8_MMA(0, 0, At, B0); PG8_BAR; PG8_SCHED;
            PG8_LDB(B1, 1, 1); PG8_STAGE(PG8_SB(1, 0), b3, voffB);
            PG8_BAR; PG8_WAIT_L(0); PG8_MMA(0, 1, At, B1); PG8_BAR;
            PG8_LDA(At, 1, 1); PG8_STAGE(PG8_SA(1, 0), a3, voffA);
            PG8_BAR; PG8_WAIT_L(0); PG8_MMA(1, 0, At, B0); PG8_BAR; PG8_SCHED;
            PG8_STAGE(PG8_SB(1, 1), b3 + hstep, voffB);
            PG8_WAIT_V(6); PG8_BAR; PG8_MMA(1, 1, At, B1); PG8_BAR;
            }
        }
        if constexpr (ALIGN_EPI) { if (wr == 0) PG8_BAR; }
        if constexpr (!Epi::AFTER_DRAIN) { E(acc, cur, wr, wc, fr, fq); S.done(cur); }
        if (!has_next) break;
#pragma unroll
        for (int a = 0; a < 2; ++a)
#pragma unroll
            for (int b = 0; b < 2; ++b)
#pragma unroll
                for (int m = 0; m < 4; ++m)
#pragma unroll
                    for (int n = 0; n < 2; ++n) acc[a][b][m][n] = (f32x4){0.f, 0.f, 0.f, 0.f};
        cur = nxt; cA = nA; cB = nB; ++ui;
        if constexpr (ALIGN_EPI) { if (wr == 1) PG8_BAR; }
    }
    PG8_WAIT_V(0);
    if constexpr (!ALIGN_EPI) { if (wr == 0) PG8_BAR; }
    PG8_BAR;
    if constexpr (Epi::AFTER_DRAIN) { E.fused(acc, cur, wr, wc, fr, fq, lds, wid, lane); S.done(cur); }
#undef PG8_SA
#undef PG8_SB
#undef PG8_STAGE
#undef PG8_LDA
#undef PG8_LDB
#undef PG8_MMA
#undef PG8_WAIT_V
#undef PG8_WAIT_L
#undef PG8_BAR
#undef PG8_SCHED
}
}
#define GAS __attribute__((address_space(1)))
#define LAS __attribute__((address_space(3)))
typedef unsigned short bf16;
typedef unsigned v4u __attribute__((ext_vector_type(4)));
typedef float f32x4 __attribute__((ext_vector_type(4)));
typedef short bf16x8 __attribute__((ext_vector_type(8)));
typedef GAS unsigned gu32;
typedef GAS unsigned long long gu64;
#define RLX_AGENT __ATOMIC_RELAXED, __HIP_MEMORY_SCOPE_AGENT
#define LDS_WAIT() asm volatile("s_waitcnt lgkmcnt(0)" ::: "memory")
#define VM_WAIT() asm volatile("s_waitcnt vmcnt(0)" ::: "memory")
__device__ __forceinline__ unsigned long long rt() { return __builtin_amdgcn_s_memrealtime(); }
__device__ __forceinline__ unsigned f2bf(float f) { unsigned u = __builtin_bit_cast(unsigned, f); return (u + 0x7fffu + ((u >> 16) & 1u)) >> 16; }
__device__ __forceinline__ unsigned pk2(float lo, float hi) { return f2bf(lo) | (f2bf(hi) << 16); }

#define XB_TMO      128
#define XB_XCNT(j)  (256  + 64 * (j))
#define XB_XSUB(j)  (1280 + 64 * (j))
#define XB_XGEN(j)  (2304 + 64 * (j))
#define XB_TOP      3328
#define XB_TOPGEN   3392
#define XCD_BAR_WORDS 3456
#define XB_SPIN_CAP (1u << 18)

__device__ __forceinline__ unsigned xb_ld(unsigned* p)              { return __hip_atomic_load(p, __ATOMIC_RELAXED, __HIP_MEMORY_SCOPE_AGENT); }
__device__ __forceinline__ unsigned xb_add(unsigned* p, unsigned v) { return __hip_atomic_fetch_add(p, v, __ATOMIC_RELAXED, __HIP_MEMORY_SCOPE_AGENT); }
__device__ __forceinline__ unsigned xb_xcc_id() { return (unsigned)__builtin_amdgcn_s_getreg((3 << 11) | 20) & 0xFu; }
#define XB_SPIN(cond, bar) do { unsigned _sp = 0; while (cond) { __builtin_amdgcn_s_sleep(1); \
    if ((++_sp & 255u) == 0u) { if (xb_ld(&(bar)[XB_TMO])) break; if (_sp > XB_SPIN_CAP) { atomicAdd(&(bar)[XB_TMO], 1u); break; } } } } while (0)

struct XcdBarrier {
    unsigned* bar; unsigned x;
    volatile LAS unsigned* st;
};

__device__ __forceinline__ XcdBarrier xcd_barrier_post(unsigned* bar, volatile LAS unsigned* st) {
    XcdBarrier b; b.bar = bar; b.x = xb_xcc_id(); b.st = st;
    if (threadIdx.x == 0) (void)xb_add(&bar[XB_XCNT(b.x)], 1u);
    return b;
}
__device__ __forceinline__ void xcd_barrier_complete(unsigned* bar, unsigned x, unsigned& nloc, unsigned& nx) {
    const unsigned G = gridDim.x * gridDim.y * gridDim.z;
    unsigned sum, cnt, mine, sp = 0u;
    for (;;) {
        sum = 0u; cnt = 0u; mine = 0u;
#pragma unroll
        for (unsigned j = 0; j < 16; ++j) { const unsigned c = xb_ld(&bar[XB_XCNT(j)]); sum += c; cnt += (c > 0u) ? 1u : 0u; mine = (j == x) ? c : mine; }
        if (sum == G) break;
        __builtin_amdgcn_s_sleep(1);
        if ((++sp & 255u) == 0u) { if (xb_ld(&bar[XB_TMO])) break; if (sp > XB_SPIN_CAP) { atomicAdd(&bar[XB_TMO], 1u); break; } }
    }
    nloc = mine > 0u ? mine : 1u; nx = cnt > 0u ? cnt : 1u;
}

__device__ __forceinline__ void xcd_barrier(const XcdBarrier& b) {
    asm volatile("s_waitcnt vmcnt(0)" ::: "memory");
    __syncthreads();
    if (threadIdx.x == 0) {
        unsigned* bar = b.bar;
        __builtin_amdgcn_s_waitcnt(0);
        unsigned nloc = b.st[0], nx = b.st[1];
        if (nloc == 0u) { xcd_barrier_complete(bar, b.x, nloc, nx); b.st[0] = nloc; b.st[1] = nx; }
        const unsigned old = xb_add(&bar[XB_XSUB(b.x)], 1u);
        const unsigned gen = old / nloc;
        if (old + 1u == (gen + 1u) * nloc) {
            __builtin_amdgcn_fence(__ATOMIC_RELEASE, "agent");
            asm volatile("s_waitcnt vmcnt(0)" ::: "memory");
            const unsigned og = xb_add(&bar[XB_TOP], 1u);
            const unsigned tg = og / nx;
            if (og + 1u == (tg + 1u) * nx) xb_add(&bar[XB_TOPGEN], 1u);
            else XB_SPIN(xb_ld(&bar[XB_TOPGEN]) == tg, bar);
            __builtin_amdgcn_fence(__ATOMIC_ACQUIRE, "agent");
            xb_add(&bar[XB_XGEN(b.x)], 1u);
            asm volatile("s_waitcnt vmcnt(0)" ::: "memory");
        } else {
            XB_SPIN(xb_ld(&bar[XB_XGEN(b.x)]) == gen, bar);
            __builtin_amdgcn_fence(__ATOMIC_ACQUIRE, "agent");
            asm volatile("s_waitcnt vmcnt(0)" ::: "memory");
        }
    }
    __syncthreads();
}
constexpr int NWAVES = 8;
constexpr int DM = 1024, TP = 2048, NBP = 8, MP = NBP * TP, NBS = 128, TS = 8, MS = NBS * TS, M = MP + MS, FF = 2816, NG1 = 2 * FF;
constexpr int NIN = 3088, NINP = 3328, NPROJ = 3072, DK = 128, DV = 256, NH = 4;
constexpr float EPS = 1e-6f;
static_assert(M == 68 * 256, "row tiles");
constexpr size_t O_YP = 0, O_YS = (size_t)MP * DM, O_NPP = O_YS + (size_t)MS * DM, O_NGP = O_NPP + (size_t)2 * NBP * 15 * DM, O_NPS = O_NGP + (size_t)2 * NBP * NH * DK * DV,
                 O_NGS = O_NPS + (size_t)2 * NBS * 15 * DM, O_END = O_NGS + (size_t)2 * NBS * NH * DK * DV;
constexpr size_t MiB = 1u << 20;
constexpr size_t WS_CTL = 0, CTL_ZERO_BYTES = 1 * MiB;
constexpr size_t SZ_W13 = (size_t)NG1 * DM * 2, SZ_W2 = (size_t)DM * FF * 2, SZ_WIN = (size_t)NINP * DM * 2, SZ_WO = (size_t)DM * DM * 2, SZ_WP = (size_t)4 * 256 * 256 * 2;
constexpr size_t WS_W13 = 1 * MiB, WS_W2 = WS_W13 + 4 * SZ_W13, WS_WIN = WS_W2 + 4 * SZ_W2, WS_WO = WS_WIN + 2 * SZ_WIN, WS_WP = WS_WO + 2 * SZ_WO;
constexpr size_t WS_H = WS_WP + 2 * SZ_WP;
constexpr size_t WS_BIG = WS_H + (size_t)M * DM * 2;
constexpr size_t WS_ALOW = WS_BIG + (size_t)M * NPROJ * 2;
constexpr size_t WS_DS = WS_ALOW + (size_t)M * 16 * 4;
constexpr size_t WS_DSC = WS_DS + (size_t)32 * 7 * DK * DV * 4;
constexpr size_t WS_END = WS_DSC + (size_t)32 * 7 * DK * 4;
static_assert(WS_END <= 256 * MiB, "d_ws map");
static_assert(WS_H % 256 == 0 && WS_BIG % 256 == 0 && WS_ALOW % 256 == 0 && WS_DS % 256 == 0 && WS_DSC % 256 == 0, "alignment");
constexpr int CW_BAR = 4096;
constexpr int RING_BYTES = 131072, LDSCTL_OFF = RING_BYTES, MISC_OFF = LDSCTL_OFF + 320, LDS_BYTES = 147456;

__device__ __forceinline__ float wave_sum(float v) {
#pragma unroll
    for (int o = 1; o < 64; o <<= 1) v += __shfl_xor(v, o);
    return v;
}
__device__ __forceinline__ float bf2f(unsigned short b) { return __builtin_bit_cast(float, (unsigned)b << 16); }

__device__ __forceinline__ void tr_item(const float* W, int K, int N, bf16* WT, int mode, int row_off, LAS float* scr, int item, int lane) {
    const int nblk = (N + 31) >> 5, kb = item / nblk, nb = item - kb * nblk, k0 = 64 * kb, n0 = 32 * nb;
    const int nn = n0 + (lane & 31); const bool ok = nn < N;
    float wv[32];
#pragma unroll
    for (int i = 0; i < 32; ++i) { const int kk = 2 * i + (lane >> 5); wv[i] = ok ? W[(size_t)(k0 + kk) * N + nn] : 0.f; }
#pragma unroll
    for (int i = 0; i < 32; ++i) { const int kk = 2 * i + (lane >> 5); scr[kk * 33 + (lane & 31)] = wv[i]; }
    LDS_WAIT(); asm volatile("" ::: "memory");
    const int c = lane & 7;
#pragma unroll
    for (int j = 0; j < 4; ++j) { const int n = (lane >> 3) + 8 * j; const LAS float* s = scr + (8 * c) * 33 + n;
        v4u o; o.x = pk2(s[0 * 33], s[1 * 33]); o.y = pk2(s[2 * 33], s[3 * 33]); o.z = pk2(s[4 * 33], s[5 * 33]); o.w = pk2(s[6 * 33], s[7 * 33]);
        const int ng = n0 + n; const int row = mode ? (((ng >> 7) << 8) + (ng & 127) + row_off) : (row_off + ng);
        *(v4u*)(WT + (size_t)row * K + k0 + 8 * c) = o; }
    LDS_WAIT(); asm volatile("" ::: "memory");
}
__device__ __forceinline__ void p0_weights(LAS unsigned char* lds, int wave, int lane, int gw, int NGW, const float* const* in, unsigned char* ws) {
    LAS float* scr = (LAS float*)(lds + wave * 16384);
    constexpr int I_W1 = (DM / 64) * (FF / 32), I_W2 = (FF / 64) * (DM / 32), I_WIN = (DM / 64) * ((NIN + 31) / 32), I_WO = (DM / 64) * (DM / 32), I_WP = (256 / 64) * (256 / 32);
    constexpr int N_FFN = 4 * (2 * I_W1 + I_W2), N_GLA = 2 * (I_WIN + I_WO), N_POOL = 8 * I_WP, NITEMS = N_FFN + N_GLA + N_POOL;
    for (int it = gw; it < NITEMS; it += NGW) {
        int r = it;
        if (r < N_FFN) { const int L = r / (2 * I_W1 + I_W2); r -= L * (2 * I_W1 + I_W2);
            if (r < I_W1) { tr_item(in[14] + (size_t)L * DM * FF, DM, FF, (bf16*)(ws + WS_W13 + L * SZ_W13), 1, 0, scr, r, lane); continue; } r -= I_W1;
            if (r < I_W1) { tr_item(in[15] + (size_t)L * DM * FF, DM, FF, (bf16*)(ws + WS_W13 + L * SZ_W13), 1, 128, scr, r, lane); continue; } r -= I_W1;
            tr_item(in[16] + (size_t)L * FF * DM, FF, DM, (bf16*)(ws + WS_W2 + L * SZ_W2), 0, 0, scr, r, lane); continue; }
        r -= N_FFN;
        if (r < N_GLA) { const int L = r / (I_WIN + I_WO); r -= L * (I_WIN + I_WO);
            if (r < I_WIN) { tr_item(in[9] + (size_t)L * DM * NIN, DM, NIN, (bf16*)(ws + WS_WIN + L * SZ_WIN), 0, 0, scr, r, lane); continue; } r -= I_WIN;
            tr_item(in[13] + (size_t)L * DM * DM, DM, DM, (bf16*)(ws + WS_WO + L * SZ_WO), 0, 0, scr, r, lane); continue; }
        r -= N_GLA;
        { const int jg = r / I_WP; r -= jg * I_WP;
          tr_item(in[7] + (size_t)jg * 65536, 256, 256, (bf16*)(ws + WS_WP + (jg >> 2) * SZ_WP), 0, (jg & 3) * 256, scr, r, lane); }
    }
    constexpr int PADV = (NINP - 3104) * DM * 2 / 16;
    for (int i = gw * 64 + lane; i < 2 * PADV; i += NGW * 64) { const int L = i / PADV, e = i - L * PADV;
        ((v4u*)(ws + WS_WIN + L * SZ_WIN + (size_t)3104 * DM * 2))[e] = (v4u){0u, 0u, 0u, 0u}; }
}

__device__ __forceinline__ void rms_row_bf16(const float* xrow, const float* g, bf16* orow, int lane) {
    const f32x4* xr = (const f32x4*)xrow + lane; const f32x4* gr = (const f32x4*)g + lane;
    f32x4 v[4]; float s = 0.f;
#pragma unroll
    for (int j = 0; j < 4; ++j) { v[j] = xr[64 * j]; s += (v[j].x * v[j].x + v[j].y * v[j].y) + (v[j].z * v[j].z + v[j].w * v[j].w); }
    const float rstd = rsqrtf(wave_sum(s) * (1.f / DM) + EPS);
    unsigned long long* o8 = (unsigned long long*)orow + lane;
#pragma unroll
    for (int j = 0; j < 4; ++j) { const f32x4 gg = gr[64 * j]; const f32x4 y = v[j] * rstd * gg;
        o8[64 * j] = (unsigned long long)pk2(y.x, y.y) | ((unsigned long long)pk2(y.z, y.w) << 32); }
}
__device__ __forceinline__ void rms_phase(int gw, int NGW, int lane, const float* X, const float* g, bf16* H) {
    for (int m = gw; m < M; m += NGW) rms_row_bf16(X + (size_t)m * DM, g, H + (size_t)m * DM, lane);
}
__device__ __forceinline__ void final_norm_phase(int gw, int NGW, int lane, float* X, const float* g) {
    for (int m = gw; m < M; m += NGW) {
        f32x4* xr = (f32x4*)(X + (size_t)m * DM) + lane; const f32x4* gr = (const f32x4*)g + lane;
        f32x4 v[4]; float s = 0.f;
#pragma unroll
        for (int j = 0; j < 4; ++j) { v[j] = xr[64 * j]; s += (v[j].x * v[j].x + v[j].y * v[j].y) + (v[j].z * v[j].z + v[j].w * v[j].w); }
        const float rstd = rsqrtf(wave_sum(s) * (1.f / DM) + EPS);
#pragma unroll
        for (int j = 0; j < 4; ++j) xr[64 * j] = v[j] * rstd * gr[64 * j];
    }
}

__device__ __forceinline__ void small_gemm_res(LAS unsigned char* lds, const bf16* A, const bf16* Bt, int K, float* X, int tid, int wave, int G, int bid) {
    constexpr int RS = 272, BUF = 2 * 64 * RS;
    const int lane = tid & 63, fr = lane & 15, fq = lane >> 4, rt = wave & 3, ch = wave >> 2;
    const int lr = tid >> 3, lc = (tid & 7) * 16;
    const int nch = K >> 7;
    for (int L = bid; L < 256; L += G) {
        const int tm = L >> 4, tn = L & 15;
        const v4u* ag = (const v4u*)(A + (size_t)(tm * 64 + lr) * K + lc); const v4u* bg = (const v4u*)(Bt + (size_t)(tn * 64 + lr) * K + lc);
        LAS unsigned char* wa = lds + lr * RS + lc * 2; LAS unsigned char* wb = wa + 64 * RS;
        v4u pa[2], pb[2], qa[2], qb[2];
        { const v4u a0 = ag[0], a1 = ag[1], b0 = bg[0], b1 = bg[1];
          pa[0] = ag[16]; pa[1] = ag[17]; pb[0] = bg[16]; pb[1] = bg[17];
          qa[0] = ag[32]; qa[1] = ag[33]; qb[0] = bg[32]; qb[1] = bg[33];
          *(LAS v4u*)wa = a0; *(LAS v4u*)(wa + 16) = a1; *(LAS v4u*)wb = b0; *(LAS v4u*)(wb + 16) = b1; }
        __syncthreads();
        f32x4 acc0 = (f32x4){0.f, 0.f, 0.f, 0.f}, acc1 = (f32x4){0.f, 0.f, 0.f, 0.f};
#define SG_COMPUTE(bufoff) { _Pragma("unroll") for (int ks = 0; ks < 4; ++ks) { const bf16x8 a = *(const LAS bf16x8*)(lds + (bufoff) + (16 * rt + fr) * RS + (32 * ks + 8 * fq) * 2); \
            const bf16x8 b0 = *(const LAS bf16x8*)(lds + (bufoff) + 64 * RS + (32 * ch + fr) * RS + (32 * ks + 8 * fq) * 2), b1 = *(const LAS bf16x8*)(lds + (bufoff) + 64 * RS + (32 * ch + 16 + fr) * RS + (32 * ks + 8 * fq) * 2); \
            acc0 = __builtin_amdgcn_mfma_f32_16x16x32_bf16(b0, a, acc0, 0, 0, 0); acc1 = __builtin_amdgcn_mfma_f32_16x16x32_bf16(b1, a, acc1, 0, 0, 0); } }
        for (int kc = 0; kc < nch; kc += 2) {
            SG_COMPUTE(0)
            *(LAS v4u*)(wa + BUF) = pa[0]; *(LAS v4u*)(wa + BUF + 16) = pa[1]; *(LAS v4u*)(wb + BUF) = pb[0]; *(LAS v4u*)(wb + BUF + 16) = pb[1];
            if (kc + 3 < nch) { pa[0] = ag[16 * (kc + 3)]; pa[1] = ag[16 * (kc + 3) + 1]; pb[0] = bg[16 * (kc + 3)]; pb[1] = bg[16 * (kc + 3) + 1]; }
            __syncthreads();
            SG_COMPUTE(BUF)
            if (kc + 2 < nch) { *(LAS v4u*)wa = qa[0]; *(LAS v4u*)(wa + 16) = qa[1]; *(LAS v4u*)wb = qb[0]; *(LAS v4u*)(wb + 16) = qb[1]; }
            if (kc + 4 < nch) { qa[0] = ag[16 * (kc + 4)]; qa[1] = ag[16 * (kc + 4) + 1]; qb[0] = bg[16 * (kc + 4)]; qb[1] = bg[16 * (kc + 4) + 1]; }
            __syncthreads();
        }
#undef SG_COMPUTE
        float* o = X + (size_t)(tm * 64 + 16 * rt + fr) * DM + tn * 64 + 32 * ch + 4 * fq;
        *(f32x4*)o = *(const f32x4*)o + acc0; *(f32x4*)(o + 16) = *(const f32x4*)(o + 16) + acc1;
    }
    __syncthreads();
}

__device__ __forceinline__ void pool_prep(LAS unsigned char* lds, int tid, int wave, int lane, int G, int bid,
                                          const float* xp, const float* xs, const float* gmix, const float* spool, bf16* DIFF, float* onp, float* ons) {
    typedef float f32x2 __attribute__((ext_vector_type(2)));
    LAS float* hb = (LAS float*)lds;
    for (int u = bid; u < 1024 + NBS; u += G) {
        const bool pr = u < 1024; const int b = pr ? (u >> 7) : (u - 1024); const int t0 = pr ? (u & 127) * 16 : 0; const int ntok = pr ? 16 : 8;
        {
            f32x4 v[4][4]; bool has[4], donorm[4];
#pragma unroll
            for (int k = 0; k < 4; ++k) { const int r = wave + 8 * k; const float* src = nullptr; donorm[k] = true;
                if (r < 15 + ntok) {
                    if (pr) { const int t = t0 - 15 + r; if (t >= 0) src = xp + ((size_t)b * TP + t) * DM; }
                    else { if (r < 15) { src = spool + ((size_t)b * 15 + r) * DM; donorm[k] = false; } else src = xs + ((size_t)b * TS + (r - 15)) * DM; } }
                has[k] = src != nullptr;
#pragma unroll
                for (int j = 0; j < 4; ++j) v[k][j] = has[k] ? ((const f32x4*)src + lane)[64 * j] : (f32x4){0.f, 0.f, 0.f, 0.f}; }
            const f32x4* gr = (const f32x4*)gmix + lane;
#pragma unroll
            for (int k = 0; k < 4; ++k) { const int r = wave + 8 * k;
                if (r < 15 + ntok) { float s = 0.f;
#pragma unroll
                    for (int j = 0; j < 4; ++j) s += (v[k][j].x * v[k][j].x + v[k][j].y * v[k][j].y) + (v[k][j].z * v[k][j].z + v[k][j].w * v[k][j].w);
                    const float rstd = (has[k] && donorm[k]) ? rsqrtf(wave_sum(s) * (1.f / DM) + EPS) : 1.f;
                    LAS f32x4* hrow = (LAS f32x4*)(hb + r * DM) + lane;
#pragma unroll
                    for (int j = 0; j < 4; ++j) hrow[64 * j] = (has[k] && donorm[k]) ? v[k][j] * rstd * gr[64 * j] : v[k][j]; } }
        }
        __syncthreads();
        const int c = 2 * tid, gi = tid >> 7, w = 2 << gi;
        f32x2 sum = (f32x2){0.f, 0.f};
        for (int l = 1; l < w; ++l) sum += *(const LAS f32x2*)(hb + (15 - l) * DM + c);
        for (int i = 0; i < ntok; ++i) {
            const f32x2 cur = *(const LAS f32x2*)(hb + (15 + i) * DM + c); sum += cur;
            const int cnt = pr ? ((t0 + i + 1) < w ? (t0 + i + 1) : w) : w; const float inv = 1.0f / (float)cnt;
            const f32x2 d = sum * inv - cur;
            const size_t row = pr ? ((size_t)b * TP + t0 + i) : ((size_t)MP + b * TS + i);
            *(unsigned*)(DIFF + ((size_t)gi * M + row) * 256 + (c & 255)) = pk2(d.x, d.y);
            sum -= *(const LAS f32x2*)(hb + (15 + i - w + 1) * DM + c);
        }
        if (pr) { if (t0 == TP - 16) for (int i = 1; i < 16; ++i) *(f32x2*)(onp + ((size_t)b * 15 + (i - 1)) * DM + c) = *(const LAS f32x2*)(hb + (15 + i) * DM + c); }
        else for (int i = 0; i < 15; ++i) *(f32x2*)(ons + ((size_t)b * 15 + i) * DM + c) = *(const LAS f32x2*)(hb + (8 + i) * DM + c);
        __syncthreads();
    }
}

constexpr int L_QH = 0, L_KH = 17408, L_KT = 34816, L_VT = 53248, L_AL = 90112, L_ALOW = 99328, L_DL = 105472, L_SSQ = 105984, L_TOT = 108032, L_WA = 112128, L_BA = 120320, L_NW = 120832, L_GLA_END = 121856;
constexpr int QS = 272, TSB = 144;
static_assert(L_GLA_END <= RING_BYTES, "GLA LDS");
__device__ __forceinline__ bf16x8 pack8(const f32x4 a, const f32x4 b) {
    v4u w; w.x = pg8::cvt_pk_bf16(a[0], a[1]); w.y = pg8::cvt_pk_bf16(a[2], a[3]); w.z = pg8::cvt_pk_bf16(b[0], b[1]); w.w = pg8::cvt_pk_bf16(b[2], b[3]);
    return __builtin_bit_cast(bf16x8, w);
}
__device__ __forceinline__ void gla_phase(LAS unsigned char* lds, int tid, int wave, int lane, int G, int bid, int phase, int jl,
                                          const float* const* in, float* out, unsigned char* ws) {
    typedef unsigned u32x2 __attribute__((ext_vector_type(2)));
    const bf16* PROJ = (const bf16*)(ws + WS_BIG); const float* ALOW = (const float*)(ws + WS_ALOW); bf16* GOUT = (bf16*)(ws + WS_H);
    float* DS = (float*)(ws + WS_DS); float* DSC = (float*)(ws + WS_DSC);
    const int nitems = phase == 0 ? (224 + 4 * NBS) : 256;
    const int tid_in = tid;
    for (int item = bid; item < nitems; item += G) {
        int tid = tid_in; asm volatile("" : "+v"(tid));
        int lane = tid & 63, fr = lane & 15, fq = lane >> 4;
        int b, h, row0, ntok, sc = 0; bool want_out, samp = false;
        if (phase == 0) { if (item < 224) { const int bh = item / 7; sc = item - bh * 7; b = bh >> 2; h = bh & 3; row0 = b * TP + sc * 256; ntok = 256; want_out = false; }
                          else { const int q = item - 224; b = q >> 2; h = q & 3; row0 = MP + b * TS; ntok = TS; want_out = true; samp = true; } }
        else { const int bh = item >> 3; sc = item & 7; b = bh >> 2; h = bh & 3; row0 = b * TP + sc * 256; ntok = 256; want_out = true; }
        const int bh = b * 4 + h;
        f32x4 S[8][2];
#pragma unroll
        for (int dt = 0; dt < 8; ++dt)
#pragma unroll
            for (int vt = 0; vt < 2; ++vt) S[dt][vt] = (f32x4){0.f, 0.f, 0.f, 0.f};
        if (samp) {
            const float* s0 = in[3] + ((size_t)(jl * NBS + b) * NH + h) * DK * DV;
#pragma unroll
            for (int dt = 0; dt < 8; ++dt)
#pragma unroll
                for (int vt = 0; vt < 2; ++vt)
#pragma unroll
                    for (int e = 0; e < 4; ++e) S[dt][vt][e] = s0[(size_t)(16 * dt + 4 * fq + e) * DV + 32 * wave + 16 * vt + fr];
        } else if (phase == 1 && sc > 0) {
            const float* dsp = DS + (size_t)(bh * 7 + sc - 1) * DK * DV;
#pragma unroll
            for (int dt = 0; dt < 8; ++dt)
#pragma unroll
                for (int vt = 0; vt < 2; ++vt) S[dt][vt] = *(const f32x4*)(dsp + (size_t)(((wave * 8 + dt) * 2 + vt) * 64 + lane) * 4);
        }
        { const int r = tid >> 5, d4 = (tid & 31) * 4;
          *(LAS f32x4*)(lds + L_WA + (r * 128 + d4) * 4) = *(const f32x4*)(in[10] + (size_t)jl * 16 * 512 + r * 512 + h * DK + d4) * 1.4426950408889634f;
          if (tid < 32) *(LAS f32x4*)(lds + L_BA + tid * 16) = *(const f32x4*)(in[11] + jl * 512 + h * DK + tid * 4) * 1.4426950408889634f;
          if (tid < 64) *(LAS f32x4*)(lds + L_NW + tid * 16) = *(const f32x4*)(in[12] + jl * DM + h * DV + tid * 4); }
        float btot0 = 0.f, btot1 = 0.f;
        const int nsub = (ntok + 63) >> 6;
        unsigned qn[8], kn[8]; v4u vn[4]; f32x4 aln;
#define GLA_LOAD(sbx) { const int tokv_ = (ntok - 64 * (sbx)) < 64 ? (ntok - 64 * (sbx)) : 64; const int rb_ = row0 + 64 * (sbx); const int dp_ = tid & 63, jp_ = tid & 31, vg_ = tid >> 5; \
            _Pragma("unroll") for (int i = 0; i < 8; ++i) { const int tok = 8 * wave + i; qn[i] = 0u; kn[i] = 0u; \
                if (tok < tokv_) { const unsigned* pr = (const unsigned*)(PROJ + (size_t)(rb_ + tok) * NPROJ + h * DK) + dp_; qn[i] = pr[0]; kn[i] = pr[256]; } } \
            _Pragma("unroll") for (int i = 0; i < 2; ++i) { const int tok = 2 * jp_ + i; vn[2 * i] = (v4u){0u, 0u, 0u, 0u}; vn[2 * i + 1] = (v4u){0u, 0u, 0u, 0u}; \
                if (tok < tokv_) { const v4u* pv = (const v4u*)(PROJ + (size_t)(rb_ + tok) * NPROJ + 1024 + h * DV + 16 * vg_); vn[2 * i] = pv[0]; vn[2 * i + 1] = pv[1]; } } \
            aln = (f32x4){0.f, 0.f, 0.f, 0.f}; if (tid < 256) { const int tok = tid >> 2; if (tok < tokv_) aln = *(const f32x4*)(ALOW + (size_t)(rb_ + tok) * 16 + 4 * (tid & 3)); } }
        GLA_LOAD(0)
        for (int sb = 0; sb < nsub; ++sb) {
            typedef float f32x2 __attribute__((ext_vector_type(2)));
            const int tokv = (ntok - 64 * sb) < 64 ? (ntok - 64 * sb) : 64; const int rbase = row0 + 64 * sb;
            asm volatile("" : "+v"(tid)); lane = tid & 63; fr = lane & 15; fq = lane >> 4;
            const int dp = tid & 63, jp = tid & 31, vg = tid >> 5;
            if (tid < 256) *(LAS f32x4*)(lds + L_ALOW + (tid >> 2) * 64 + 16 * (tid & 3)) = aln;
            __syncthreads();
            f32x2 bj[8];
            { f32x2 x[8]; const f32x2 bav = *(const LAS f32x2*)(lds + L_BA + dp * 8);
#pragma unroll
              for (int i = 0; i < 8; ++i) x[i] = bav;
#pragma unroll
              for (int r4 = 0; r4 < 4; ++r4) { const f32x2 w0 = *(const LAS f32x2*)(lds + L_WA + ((4 * r4 + 0) * 128 + 2 * dp) * 4), w1 = *(const LAS f32x2*)(lds + L_WA + ((4 * r4 + 1) * 128 + 2 * dp) * 4),
                                                            w2 = *(const LAS f32x2*)(lds + L_WA + ((4 * r4 + 2) * 128 + 2 * dp) * 4), w3 = *(const LAS f32x2*)(lds + L_WA + ((4 * r4 + 3) * 128 + 2 * dp) * 4);
                  f32x4 al[8];
#pragma unroll
                  for (int i = 0; i < 8; ++i) al[i] = *(const LAS f32x4*)(lds + L_ALOW + (8 * wave + i) * 64 + 16 * r4);
#pragma unroll
                  for (int i = 0; i < 8; ++i) x[i] = w0 * al[i][0] + x[i];
#pragma unroll
                  for (int i = 0; i < 8; ++i) x[i] = w1 * al[i][1] + x[i];
#pragma unroll
                  for (int i = 0; i < 8; ++i) x[i] = w2 * al[i][2] + x[i];
#pragma unroll
                  for (int i = 0; i < 8; ++i) x[i] = w3 * al[i][3] + x[i]; }
              f32x2 run = (f32x2){0.f, 0.f};
#pragma unroll
              for (int i = 0; i < 8; ++i) { f32x2 g;
                  g.x = (fminf(x[i].x, 0.f) - __builtin_amdgcn_logf(1.0f + __builtin_amdgcn_exp2f(-fabsf(x[i].x)))) * (1.0f / 16.0f); g.y = (fminf(x[i].y, 0.f) - __builtin_amdgcn_logf(1.0f + __builtin_amdgcn_exp2f(-fabsf(x[i].y)))) * (1.0f / 16.0f);
                  if (tokv < 64 && 8 * wave + i >= tokv) g = (f32x2){0.f, 0.f};
                  run += g; bj[i] = run; }
              *(LAS f32x2*)(lds + L_TOT + (wave * 128 + 2 * dp) * 4) = run; }
            __syncthreads();
            f32x2 pre = (f32x2){0.f, 0.f}, blast = (f32x2){0.f, 0.f};
#pragma unroll
            for (int q = 0; q < 8; ++q) { const f32x2 t = *(const LAS f32x2*)(lds + L_TOT + (q * 128 + 2 * dp) * 4); blast += t; if (q < wave) pre += t; }
            btot0 += blast.x; btot1 += blast.y;
            if (wave == 0) *(LAS f32x2*)(lds + L_DL + dp * 8) = (f32x2){__builtin_amdgcn_exp2f(blast.x), __builtin_amdgcn_exp2f(blast.y)};
            { unsigned kb[8];
#pragma unroll
              for (int i = 0; i < 8; ++i) { const int tok = 8 * wave + i; const f32x2 bb = bj[i] + pre;
                  const float e1x = __builtin_amdgcn_exp2f(blast.x - bb.x), e1y = __builtin_amdgcn_exp2f(blast.y - bb.y), e2x = __builtin_amdgcn_exp2f(bb.x - blast.x), e2y = __builtin_amdgcn_exp2f(bb.y - blast.y);
                  const unsigned qh = pg8::cvt_pk_bf16(bf2f((unsigned short)(qn[i] & 0xffffu)) * e2x, bf2f((unsigned short)(qn[i] >> 16)) * e2y);
                  const unsigned kh = pg8::cvt_pk_bf16(bf2f((unsigned short)(kn[i] & 0xffffu)) * e1x, bf2f((unsigned short)(kn[i] >> 16)) * e1y);
                  *(LAS unsigned*)(lds + L_QH + tok * QS + dp * 4) = qh; *(LAS unsigned*)(lds + L_KH + tok * QS + dp * 4) = kh; kb[i] = kh; }
              v4u k0, k1;
              k0.x = (kb[0] & 0xffffu) | (kb[1] << 16); k0.y = (kb[2] & 0xffffu) | (kb[3] << 16); k0.z = (kb[4] & 0xffffu) | (kb[5] << 16); k0.w = (kb[6] & 0xffffu) | (kb[7] << 16);
              k1.x = (kb[0] >> 16) | (kb[1] & 0xffff0000u); k1.y = (kb[2] >> 16) | (kb[3] & 0xffff0000u); k1.z = (kb[4] >> 16) | (kb[5] & 0xffff0000u); k1.w = (kb[6] >> 16) | (kb[7] & 0xffff0000u);
              *(LAS v4u*)(lds + L_KT + (2 * dp) * TSB + wave * 16) = k0; *(LAS v4u*)(lds + L_KT + (2 * dp + 1) * TSB + wave * 16) = k1; }
            {
#pragma unroll
              for (int hv = 0; hv < 2; ++hv) { const unsigned a4[4] = {vn[hv].x, vn[hv].y, vn[hv].z, vn[hv].w}, b4[4] = {vn[2 + hv].x, vn[2 + hv].y, vn[2 + hv].z, vn[2 + hv].w};
#pragma unroll
                  for (int k = 0; k < 4; ++k) { LAS unsigned char* p = lds + L_VT + (16 * vg + 8 * hv + 2 * k) * TSB + jp * 4;
                      *(LAS unsigned*)p = (a4[k] & 0xffffu) | (b4[k] << 16); *(LAS unsigned*)(p + TSB) = (a4[k] >> 16) | (b4[k] & 0xffff0000u); } } }
            __syncthreads();
            u32x2 rcur[4][2];
            if (want_out) {
#pragma unroll
                for (int it = 0; it < 4; ++it)
#pragma unroll
                    for (int vt = 0; vt < 2; ++vt) { rcur[it][vt] = (u32x2){0u, 0u};
                        if (16 * it + fr < tokv) rcur[it][vt] = *(const u32x2*)(PROJ + (size_t)(rbase + 16 * it + fr) * NPROJ + 2048 + h * DV + 32 * wave + 16 * vt + 4 * fq); } }
            if (sb + 1 < nsub) GLA_LOAD(sb + 1)
#pragma unroll
            for (int dt = 0; dt < 8; ++dt) { const f32x4 dv = *(const LAS f32x4*)(lds + L_DL + (16 * dt + 4 * fq) * 4); S[dt][0] = S[dt][0] * dv; S[dt][1] = S[dt][1] * dv; }
            if (want_out) {
                f32x4 O[2][4];
#pragma unroll
                for (int tt = 0; tt < 2; ++tt) { const int idx = 2 * wave + tt, it = idx >> 2, jt = idx & 3; f32x4 a = (f32x4){0.f, 0.f, 0.f, 0.f};
                    if (jt <= it) {
#pragma unroll
                        for (int ks = 0; ks < 4; ++ks) { const bf16x8 X = *(const LAS bf16x8*)(lds + L_KH + (16 * jt + fr) * QS + (32 * ks + 8 * fq) * 2);
                            const bf16x8 Y = *(const LAS bf16x8*)(lds + L_QH + (16 * it + fr) * QS + (32 * ks + 8 * fq) * 2);
                            a = __builtin_amdgcn_mfma_f32_16x16x32_bf16(X, Y, a, 0, 0, 0); }
                        const int ii = 16 * it + fr, j0 = 16 * jt + 4 * fq;
#pragma unroll
                        for (int e = 0; e < 4; ++e) if (j0 + e > ii) a[e] = 0.f;
                    }
                    u32x2 w2; w2.x = pg8::cvt_pk_bf16(a[0], a[1]); w2.y = pg8::cvt_pk_bf16(a[2], a[3]);
                    *(LAS u32x2*)(lds + L_AL + (16 * it + fr) * TSB + (16 * jt + 4 * fq) * 2) = w2; }
                __syncthreads();
                {
                bf16x8 Xs[2][4];
#pragma unroll
                for (int vt = 0; vt < 2; ++vt)
#pragma unroll
                    for (int dp = 0; dp < 4; ++dp) Xs[vt][dp] = pack8(S[2 * dp][vt], S[2 * dp + 1][vt]);
                bf16x8 XV[2][2];
#pragma unroll
                for (int vt = 0; vt < 2; ++vt)
#pragma unroll
                    for (int js = 0; js < 2; ++js) XV[vt][js] = *(const LAS bf16x8*)(lds + L_VT + (32 * wave + 16 * vt + fr) * TSB + (32 * js + 8 * fq) * 2);
#pragma unroll
                for (int it = 0; it < 4; ++it) {
                    bf16x8 YQ[4], YA[2];
#pragma unroll
                    for (int dp = 0; dp < 4; ++dp) { const u32x2 lo = *(const LAS u32x2*)(lds + L_QH + (16 * it + fr) * QS + (32 * dp + 4 * fq) * 2);
                        const u32x2 hi = *(const LAS u32x2*)(lds + L_QH + (16 * it + fr) * QS + (32 * dp + 16 + 4 * fq) * 2);
                        YQ[dp] = __builtin_bit_cast(bf16x8, (v4u){lo.x, lo.y, hi.x, hi.y}); }
#pragma unroll
                    for (int js = 0; js < 2; ++js) YA[js] = *(const LAS bf16x8*)(lds + L_AL + (16 * it + fr) * TSB + (32 * js + 8 * fq) * 2);
#pragma unroll
                    for (int vt = 0; vt < 2; ++vt) { f32x4 o = (f32x4){0.f, 0.f, 0.f, 0.f};
#pragma unroll
                        for (int dp = 0; dp < 4; ++dp) o = __builtin_amdgcn_mfma_f32_16x16x32_bf16(Xs[vt][dp], YQ[dp], o, 0, 0, 0);
#pragma unroll
                        for (int js = 0; js < 2; ++js) o = __builtin_amdgcn_mfma_f32_16x16x32_bf16(XV[vt][js], YA[js], o, 0, 0, 0);
                        O[vt][it] = o; }
                    __builtin_amdgcn_sched_barrier(0);
                }
                }
#pragma unroll
                for (int it = 0; it < 4; ++it) { float ss = 0.f;
#pragma unroll
                    for (int vt = 0; vt < 2; ++vt) { const f32x4 o = O[vt][it]; ss += (o[0] * o[0] + o[1] * o[1]) + (o[2] * o[2] + o[3] * o[3]); }
                    ss += __shfl_xor(ss, 16); ss += __shfl_xor(ss, 32);
                    if (fq == 0) *(LAS float*)(lds + L_SSQ + (wave * 64 + 16 * it + fr) * 4) = ss; }
                __syncthreads();
#pragma unroll
                for (int it = 0; it < 4; ++it) { const int tok = 16 * it + fr; float tot = 0.f;
#pragma unroll
                    for (int w8 = 0; w8 < 8; ++w8) tot += *(const LAS float*)(lds + L_SSQ + (w8 * 64 + tok) * 4);
                    const float rstd = rsqrtf(tot * (1.0f / DV) + EPS);
                    if (tok < tokv) { const size_t row = (size_t)(rbase + tok);
#pragma unroll
                        for (int vt = 0; vt < 2; ++vt) { const int vcol = h * DV + 32 * wave + 16 * vt + 4 * fq;
                            const u32x2 r2 = rcur[it][vt]; const f32x4 nw = *(const LAS f32x4*)(lds + L_NW + (32 * wave + 16 * vt + 4 * fq) * 4);
                            const f32x4 o = O[vt][it];
                            const float r0 = bf2f((unsigned short)(r2.x & 0xffffu)), r1 = bf2f((unsigned short)(r2.x >> 16)), r2f = bf2f((unsigned short)(r2.y & 0xffffu)), r3 = bf2f((unsigned short)(r2.y >> 16));
                            u32x2 w2; w2.x = pg8::cvt_pk_bf16(o[0] * rstd * nw[0] * r0, o[1] * rstd * nw[1] * r1);
                            w2.y = pg8::cvt_pk_bf16(o[2] * rstd * nw[2] * r2f, o[3] * rstd * nw[3] * r3);
                            *(u32x2*)(GOUT + row * DM + vcol) = w2; } }
                    __builtin_amdgcn_sched_barrier(0); }
            }
            __builtin_amdgcn_sched_barrier(0);
#pragma unroll
            for (int js = 0; js < 2; ++js)
#pragma unroll
                for (int vt = 0; vt < 2; ++vt) { const bf16x8 Yv = *(const LAS bf16x8*)(lds + L_VT + (32 * wave + 16 * vt + fr) * TSB + (32 * js + 8 * fq) * 2);
#pragma unroll
                    for (int dt = 0; dt < 8; ++dt) { const bf16x8 Xk = *(const LAS bf16x8*)(lds + L_KT + (16 * dt + fr) * TSB + (32 * js + 8 * fq) * 2);
                        S[dt][vt] = __builtin_amdgcn_mfma_f32_16x16x32_bf16(Xk, Yv, S[dt][vt], 0, 0, 0); }
                    __builtin_amdgcn_sched_barrier(0); }
            __syncthreads();
        }
        asm volatile("" : "+v"(tid)); lane = tid & 63; fr = lane & 15; fq = lane >> 4;
        if (phase == 0 && !samp) {
            float* dsp = DS + (size_t)(bh * 7 + sc) * DK * DV;
#pragma unroll
            for (int dt = 0; dt < 8; ++dt)
#pragma unroll
                for (int vt = 0; vt < 2; ++vt) *(f32x4*)(dsp + (size_t)(((wave * 8 + dt) * 2 + vt) * 64 + lane) * 4) = S[dt][vt];
            if (wave == 0) { DSC[(size_t)(bh * 7 + sc) * DK + 2 * (tid & 63)] = __builtin_amdgcn_exp2f(btot0); DSC[(size_t)(bh * 7 + sc) * DK + 2 * (tid & 63) + 1] = __builtin_amdgcn_exp2f(btot1); }
        } else if (samp || sc == 7) {
            float* so = samp ? out + O_NGS + ((size_t)(jl * NBS + b) * NH + h) * DK * DV : out + O_NGP + ((size_t)(jl * NBP + b) * NH + h) * DK * DV;
#pragma unroll
            for (int dt = 0; dt < 8; ++dt)
#pragma unroll
                for (int vt = 0; vt < 2; ++vt)
#pragma unroll
                    for (int e = 0; e < 4; ++e) so[(size_t)(16 * dt + 4 * fq + e) * DV + 32 * wave + 16 * vt + fr] = S[dt][vt][e];
        }
    }
}


__device__ __forceinline__ void gla_scan_phase(int gt, int NT, unsigned char* ws) {
    float* DS = (float*)(ws + WS_DS); const float* DSC = (const float*)(ws + WS_DSC);
    for (int c = gt; c < 32 * 8192; c += NT) {
        const int bh = c >> 13, e4 = c & 8191, ln = e4 & 63, dt = (e4 >> 7) & 7, dcol = 16 * dt + 4 * (ln >> 4);
        f32x4 ds[7], dv[7];
#pragma unroll
        for (int k = 0; k < 7; ++k) { ds[k] = *(const f32x4*)(DS + (size_t)(bh * 7 + k) * DK * DV + (size_t)e4 * 4); dv[k] = *(const f32x4*)(DSC + (size_t)(bh * 7 + k) * DK + dcol); }
        f32x4 run = (f32x4){0.f, 0.f, 0.f, 0.f};
#pragma unroll
        for (int k = 0; k < 7; ++k) { run = run * dv[k] + ds[k]; *(f32x4*)(DS + (size_t)(bh * 7 + k) * DK * DV + (size_t)e4 * 4) = run; }
    }
}

struct Args { const float* in[17]; float* out; unsigned char* ws; int ph_lo, ph_hi; };
constexpr int N_PHASES = 29;
__global__ void __launch_bounds__(NWAVES * 64, 2) mk_fwd(Args args) {
    extern __shared__ __attribute__((aligned(16))) unsigned char lds_raw[];
    LAS unsigned char* lds = (LAS unsigned char*)lds_raw;
    volatile LAS unsigned* MISC = (volatile LAS unsigned*)(lds + MISC_OFF);
    for (int u = threadIdx.x; u < (LDS_BYTES - LDSCTL_OFF) / 4; u += NWAVES * 64) ((LAS unsigned*)(lds + LDSCTL_OFF))[u] = 0u;
    __syncthreads();
    XcdBarrier bar = xcd_barrier_post((unsigned*)(args.ws + WS_CTL) + CW_BAR, MISC + 8);
    const int lo = args.ph_lo, hi = args.ph_hi;
    const int wave0 = __builtin_amdgcn_readfirstlane(threadIdx.x >> 6);
#define PH_BEGIN(k) if ((k) >= lo && (k) < hi) { int tid = wave0 * 64 + (int)__builtin_amdgcn_mbcnt_hi(~0u, __builtin_amdgcn_mbcnt_lo(~0u, 0u)); asm volatile("" : "+v"(tid)); const int lane = tid & 63, wave = wave0; \
        const int G = gridDim.x, bid = blockIdx.x; const int vcu = (G % 8 == 0) ? (bid % 8) * (G / 8) + bid / 8 : bid; const int gw = vcu * NWAVES + wave, NGW = G * NWAVES; \
        unsigned char* ws = args.ws; float* out = args.out; const float* const* in = args.in; bf16* Hb = (bf16*)(ws + WS_H); bf16* BIG = (bf16*)(ws + WS_BIG); float* Xs_ = out + O_YS; \
        (void)lane; (void)gw; (void)NGW; (void)Hb; (void)BIG; (void)Xs_; (void)in;
#define PH_END(k)   if ((k) + 1 < hi) xcd_barrier(bar); }

#define POOL_GEMM(k, L) PH_BEGIN(k) { constexpr int jl = (L) >> 1; \
        pg8::Gemm g{BIG, (const bf16*)(ws + WS_WP + jl * SZ_WP), 4 * M, 1024, 256}; pg8::PoolOrder S{G, bid}; \
        pg8::EpiRes<true> E{(L) == 0 ? in[0] : out, (L) == 0 ? in[1] : Xs_, out, in[8] + jl * DM}; \
        pg8::gemm_phase<pg8::EpiRes<true>, pg8::PoolOrder, true, true>(lds, g, S, E, tid); } PH_END(k)
#define RMS_PH(k, gain) PH_BEGIN(k) rms_phase(gw, NGW, lane, out, (gain), Hb); PH_END(k)
#define FFN1(k, L) PH_BEGIN(k) { pg8::Gemm g{Hb, (const bf16*)(ws + WS_W13 + (L) * SZ_W13), M, NG1, DM}; pg8::StaticOrder S; S.init(M, NG1, G, bid, DM); \
        pg8::EpiSwiglu E{BIG}; pg8::gemm_phase<pg8::EpiSwiglu, pg8::StaticOrder, true, true>(lds, g, S, E, tid); } PH_END(k)
#define FFN2(k, L) PH_BEGIN(k) { pg8::Gemm g{BIG, (const bf16*)(ws + WS_W2 + (L) * SZ_W2), M, DM, FF}; pg8::PanelOrder S{G, bid, FF / 64}; \
        pg8::EpiRes<false> E{out, Xs_, out, nullptr}; pg8::gemm_phase<pg8::EpiRes<false>, pg8::PanelOrder, true, true>(lds, g, S, E, tid); \
        small_gemm_res(lds, BIG + (size_t)MP * FF, (const bf16*)(ws + WS_W2 + (L) * SZ_W2), FF, Xs_, tid, wave, G, bid); } PH_END(k)
#define PROJ_PH(k, jl) PH_BEGIN(k) { pg8::Gemm g{Hb, (const bf16*)(ws + WS_WIN + (jl) * SZ_WIN), M, NINP, DM}; pg8::StaticOrder S; S.init(M, NINP, G, bid, DM); \
        pg8::EpiProj E{BIG, (float*)(ws + WS_ALOW)}; pg8::gemm_phase<pg8::EpiProj, pg8::StaticOrder, true, true>(lds, g, S, E, tid); } PH_END(k)
#define WO_PH(k, jl) PH_BEGIN(k) { pg8::Gemm g{Hb, (const bf16*)(ws + WS_WO + (jl) * SZ_WO), M, DM, DM}; pg8::PanelOrder S{G, bid, DM / 64}; \
        pg8::EpiRes<false> E{out, Xs_, out, nullptr}; pg8::gemm_phase<pg8::EpiRes<false>, pg8::PanelOrder, true, true>(lds, g, S, E, tid); \
        small_gemm_res(lds, Hb + (size_t)MP * DM, (const bf16*)(ws + WS_WO + (jl) * SZ_WO), DM, Xs_, tid, wave, G, bid); } PH_END(k)
#define GLA_PH(k, sub, jl) PH_BEGIN(k) gla_phase(lds, tid, wave, lane, G, bid, (sub), (jl), in, out, ws); PH_END(k)

#ifdef NO_GLA
#undef GLA_PH
#define GLA_PH(k, sub, jl)
#endif
#ifdef NO_GEMM
#undef POOL_GEMM
#undef FFN1
#undef FFN2
#undef PROJ_PH
#undef WO_PH
#define POOL_GEMM(k, L)
#define FFN1(k, L)
#define FFN2(k, L)
#define PROJ_PH(k, jl)
#define WO_PH(k, jl)
#endif
#ifdef ONLY_FFN1
#undef POOL_GEMM
#undef FFN2
#undef PROJ_PH
#undef WO_PH
#define POOL_GEMM(k, L)
#define FFN2(k, L)
#define PROJ_PH(k, jl)
#define WO_PH(k, jl)
#endif
    PH_BEGIN(0)
        p0_weights(lds, wave, lane, gw, NGW, in, ws);
        __syncthreads();
        pool_prep(lds, tid, wave, lane, G, bid, in[0], in[1], in[4] + 0 * DM, in[2], BIG, out + O_NPP, out + O_NPS);
    PH_END(0)
    POOL_GEMM(1, 0)
    RMS_PH(2, in[5] + 0 * DM)
    FFN1(3, 0)
    FFN2(4, 0)
    RMS_PH(5, in[4] + 1 * DM)
    PROJ_PH(6, 0)
    GLA_PH(7, 0, 0)
    PH_BEGIN(8)
        gla_scan_phase(vcu * (NWAVES * 64) + tid, G * NWAVES * 64, ws);
    PH_END(8)
    GLA_PH(9, 1, 0)
    WO_PH(10, 0)
    RMS_PH(11, in[5] + 1 * DM)
    FFN1(12, 1)
    FFN2(13, 1)
    PH_BEGIN(14)
        pool_prep(lds, tid, wave, lane, G, bid, out, Xs_, in[4] + 2 * DM, in[2] + (size_t)NBS * 15 * DM, BIG, out + O_NPP + (size_t)NBP * 15 * DM, out + O_NPS + (size_t)NBS * 15 * DM);
    PH_END(14)
    POOL_GEMM(15, 2)
    RMS_PH(16, in[5] + 2 * DM)
    FFN1(17, 2)
    FFN2(18, 2)
    RMS_PH(19, in[4] + 3 * DM)
    PROJ_PH(20, 1)
    GLA_PH(21, 0, 1)
    PH_BEGIN(22)
        gla_scan_phase(vcu * (NWAVES * 64) + tid, G * NWAVES * 64, ws);
    PH_END(22)
    GLA_PH(23, 1, 1)
    WO_PH(24, 1)
    RMS_PH(25, in[5] + 3 * DM)
    FFN1(26, 3)
    FFN2(27, 3)
    PH_BEGIN(28)
        final_norm_phase(gw, NGW, lane, out, in[6]);
    PH_END(28)
}

#ifndef MK_SPLIT
#define MK_SPLIT 0
#endif
extern "C" void kernel_launch(void* const* d_in, const int* in_sizes, int n_in, void* d_out, int out_size, void* d_ws, size_t ws_size, hipStream_t stream) {
    static int grid = 0;
    if (grid == 0) {
        if (n_in != 17 || (size_t)out_size != O_END || ws_size < WS_END) { fprintf(stderr, "kernel_launch: unexpected shapes (n_in %d out %d ws %zu)\n", n_in, out_size, ws_size); grid = -1; return; }
        int dev = 0, cus = 0, per_cu = 0;
        if (hipGetDevice(&dev) != hipSuccess || hipDeviceGetAttribute(&cus, hipDeviceAttributeMultiprocessorCount, dev) != hipSuccess) { grid = -1; return; }
        if (hipFuncSetAttribute((const void*)mk_fwd, hipFuncAttributeMaxDynamicSharedMemorySize, LDS_BYTES) != hipSuccess) { fprintf(stderr, "kernel_launch: hipFuncSetAttribute failed\n"); grid = -1; return; }
        if (hipOccupancyMaxActiveBlocksPerMultiprocessor(&per_cu, (const void*)mk_fwd, NWAVES * 64, LDS_BYTES) != hipSuccess || per_cu < 1) { fprintf(stderr, "kernel_launch: occupancy query failed (%d)\n", per_cu); (void)hipGetLastError(); per_cu = 1; }
        grid = cus;
        if (grid > cus * per_cu) grid = cus * per_cu;
    }
    if (grid < 0) return;
    if (hipMemsetAsync((char*)d_ws + WS_CTL, 0, CTL_ZERO_BYTES, stream) != hipSuccess) { fprintf(stderr, "kernel_launch: memset failed\n"); return; }
    Args a{};
    for (int i = 0; i < 17; ++i) a.in[i] = (const float*)d_in[i];
    a.out = (float*)d_out; a.ws = (unsigned char*)d_ws;
#if MK_SPLIT
    for (int p = 0; p < N_PHASES; ++p) { a.ph_lo = p; a.ph_hi = p + 1; hipLaunchKernelGGL(mk_fwd, dim3(grid), dim3(NWAVES * 64), LDS_BYTES, stream, a); }
#else
    a.ph_lo = 0; a.ph_hi = N_PHASES;
    void* kargs[] = {&a};
    hipError_t e = hipLaunchCooperativeKernel((const void*)mk_fwd, dim3(grid), dim3(NWAVES * 64), kargs, LDS_BYTES, stream);
    if (e != hipSuccess) fprintf(stderr, "kernel_launch: cooperative launch failed: %s (grid %d)\n", hipGetErrorString(e), grid);
#endif
}
```

```cpp
#include <hip/hip_runtime.h>
#include <cstdio>
#include <cstdint>
namespace pg8 {
#define PG8_LAS __attribute__((address_space(3)))
typedef unsigned short bf16_t;
typedef short bf16x8 __attribute__((ext_vector_type(8)));
typedef float f32x4 __attribute__((ext_vector_type(4)));
typedef unsigned u32x4 __attribute__((ext_vector_type(4)));
constexpr int BM = 256, BK = 64, HALF = 128, HTB = HALF * BK * 2  , STAGE_BYTES = 8 * HTB, NXCD = 8, WGM = 4;

__host__ __device__ __forceinline__ int lds_byte(int r, int c) { const int st = (r >> 4) * 2 + (c >> 5), rr = r & 15, cc = c & 31, ob = rr * 64 + cc * 2; return st * 1024 + (ob ^ (((ob >> 9) & 1) << 5)); }
__host__ __device__ __forceinline__ void stage_rc(int b, int& R, int& C) { const int st = b / 1024, sb = b % 1024, swz = sb ^ (((sb >> 9) & 1) << 5); R = (st >> 1) * 16 + swz / 64; C = (st & 1) * 32 + (swz % 64) / 2; }
__host__ __device__ __forceinline__ int perm32(int rho) { const int n = rho >> 4, i = rho & 15; return 8 * (i >> 2) + 4 * n + (i & 3); }

struct Unit { int pm, pn, k0, nt, part; };
struct Gemm { const bf16_t* A; const bf16_t* Bt; int M, N, K; };

struct StaticOrder {
    int nM, nN, nwg, G, c, ntk;
    __host__ __device__ void init(int M, int N, int G_, int c_, int K_) { nM = M / BM; nN = N / BM; nwg = nM * nN; G = G_; c = c_; ntk = K_ / BK; }
    __host__ __device__ bool next(int i, Unit& u) const {
        const long L = (long)i * G + c; if (L >= nwg) return false;
        int wgid = (int)L; { const int q = nwg / NXCD, r = nwg % NXCD, xcd = wgid % NXCD, off = wgid / NXCD; wgid = (xcd < r ? xcd * (q + 1) : r * (q + 1) + (xcd - r) * q) + off; }
        const int nig = WGM * nN, gid = wgid / nig, fm = gid * WGM, gsz = (nM - fm) < WGM ? (nM - fm) : WGM;
        u.pm = fm + ((wgid % nig) % gsz); u.pn = (wgid % nig) / gsz; u.k0 = 0; u.nt = ntk; u.part = 0; return true;
    }
    __device__ __forceinline__ void a_ready(const Unit&) const {}
    __device__ __forceinline__ void done(const Unit&) const {}
};

__device__ __forceinline__ unsigned cvt_pk_bf16(float lo, float hi) { unsigned r; asm volatile("v_cvt_pk_bf16_f32 %0, %1, %2" : "=v"(r) : "v"(lo), "v"(hi)); return r; }
typedef float f32x2 __attribute__((ext_vector_type(2)));
typedef unsigned u32x2 __attribute__((ext_vector_type(2)));
__device__ __forceinline__ float silu_f(float x) { return x * __builtin_amdgcn_rcpf(1.0f + __builtin_amdgcn_exp2f(x * -1.4426950408889634f)); }
constexpr int P_DM = 1024, P_FF = 2816, P_NT = 68  , P_PROJ = 3072;

__device__ __forceinline__ unsigned swiglu_pk(f32x2 g, f32x2 u) {
    const f32x2 t = g * -1.4426950408889634f; f32x2 e; e.x = __builtin_amdgcn_exp2f(t.x); e.y = __builtin_amdgcn_exp2f(t.y);
    const f32x2 d = e + 1.0f; f32x2 r; r.x = __builtin_amdgcn_rcpf(d.x); r.y = __builtin_amdgcn_rcpf(d.y);
    const f32x2 o = (g * u) * r; return cvt_pk_bf16(o.x, o.y);
}
struct EpiSwiglu {
    static constexpr bool PERM = true, AFTER_DRAIN = false;
    bf16_t* U;
    __device__ __forceinline__ void operator()(const f32x4 (&acc)[2][2][4][2], const Unit& u, int wr, int wc, int fr, int fq) const {
        const int row0 = u.pm * BM + wr * 64 + fr, col0 = u.pn * 128 + wc * 32 + 8 * fq;
#pragma unroll
        for (int ai = 0; ai < 2; ++ai)
#pragma unroll
            for (int m = 0; m < 4; ++m) { bf16_t* rowp = U + (size_t)(row0 + ai * HALF + m * 16) * P_FF + col0;
                const f32x4 g0 = acc[ai][0][m][0], g1 = acc[ai][0][m][1], u0 = acc[ai][1][m][0], u1 = acc[ai][1][m][1];
                u32x4 w; w.x = swiglu_pk((f32x2){g0[0], g0[1]}, (f32x2){u0[0], u0[1]}); w.y = swiglu_pk((f32x2){g0[2], g0[3]}, (f32x2){u0[2], u0[3]});
                w.z = swiglu_pk((f32x2){g1[0], g1[1]}, (f32x2){u1[0], u1[1]}); w.w = swiglu_pk((f32x2){g1[2], g1[3]}, (f32x2){u1[2], u1[3]});
                *(u32x4*)rowp = w; }
    }
};
struct EpiProj {
    static constexpr bool PERM = true, AFTER_DRAIN = false;
    bf16_t* P; float* AL;
    __device__ __forceinline__ void operator()(const f32x4 (&acc)[2][2][4][2], const Unit& u, int wr, int wc, int fr, int fq) const {
        const int row0 = u.pm * BM + wr * 64 + fr;
        if (u.pn >= 8 && u.pn < 12) {
            const int col0 = u.pn * BM + wc * 32 + 8 * fq; const f32x2 one = (f32x2){1.f, 1.f};
#pragma unroll
            for (int ai = 0; ai < 2; ++ai)
#pragma unroll
                for (int m = 0; m < 4; ++m) { bf16_t* rowp = P + (size_t)(row0 + ai * HALF + m * 16) * P_PROJ + col0;
#pragma unroll
                    for (int bj = 0; bj < 2; ++bj) { const f32x4 v0 = acc[ai][bj][m][0], v1 = acc[ai][bj][m][1];
                        u32x4 w; w.x = swiglu_pk((f32x2){v0[0], v0[1]}, one); w.y = swiglu_pk((f32x2){v0[2], v0[3]}, one); w.z = swiglu_pk((f32x2){v1[0], v1[1]}, one); w.w = swiglu_pk((f32x2){v1[2], v1[3]}, one);
                        *(u32x4*)(rowp + bj * HALF) = w; } }
        } else if (u.pn < 12) {
            const float sc = u.pn < 2 ? 0.08838834764831845f : 1.0f;
            const int col0 = u.pn * BM + wc * 32 + 8 * fq;
#pragma unroll
            for (int ai = 0; ai < 2; ++ai)
#pragma unroll
                for (int m = 0; m < 4; ++m) { bf16_t* rowp = P + (size_t)(row0 + ai * HALF + m * 16) * P_PROJ + col0;
#pragma unroll
                    for (int bj = 0; bj < 2; ++bj) { const f32x4 v0 = acc[ai][bj][m][0] * sc, v1 = acc[ai][bj][m][1] * sc;
                        u32x4 w; w.x = cvt_pk_bf16(v0[0], v0[1]); w.y = cvt_pk_bf16(v0[2], v0[3]); w.z = cvt_pk_bf16(v1[0], v1[1]); w.w = cvt_pk_bf16(v1[2], v1[3]);
                        *(u32x4*)(rowp + bj * HALF) = w; } }
        } else if (wc == 0 && fq < 2) {
#pragma unroll
            for (int ai = 0; ai < 2; ++ai)
#pragma unroll
                for (int m = 0; m < 4; ++m) { float* rowp = AL + (size_t)(row0 + ai * HALF + m * 16) * 16 + 8 * fq;
                    *(f32x4*)rowp = acc[ai][0][m][0]; *(f32x4*)(rowp + 4) = acc[ai][0][m][1]; }
        }
    }
};
template <bool POOL> struct EpiRes {
    static constexpr bool PERM = false, AFTER_DRAIN = false;
    const float* bp; const float* bs; float* out; const float* scale;
    __device__ __forceinline__ void operator()(const f32x4 (&acc)[2][2][4][2], const Unit& u, int wr, int wc, int fr, int fq) const {
        const int pm = POOL ? (u.pm - P_NT * u.pn) : u.pm, pn = u.pn;
        const float* base = pm < 64 ? bp + (size_t)pm * BM * P_DM : bs + (size_t)(pm - 64) * BM * P_DM;
        float* o = out + (size_t)pm * BM * P_DM;
        int frq = fr + 16 * fq; asm volatile("" : "+v"(frq));
        const unsigned col0 = (unsigned)(pn * BM + wc * 32 + 4 * (frq >> 4));
        const unsigned roff = (unsigned)(wr * 64 + (frq & 15)) * P_DM + col0;
#pragma unroll
        for (int ai = 0; ai < 2; ++ai)
#pragma unroll
            for (int m = 0; m < 4; ++m) { const unsigned off = roff + (unsigned)(ai * HALF + m * 16) * P_DM;
#pragma unroll
                for (int bj = 0; bj < 2; ++bj)
#pragma unroll
                    for (int n = 0; n < 2; ++n) { f32x4 a = acc[ai][bj][m][n]; if (POOL) a = a * *(const f32x4*)(scale + col0 + bj * HALF + n * 16);
                        const f32x4 b = *(const f32x4*)(base + off + bj * HALF + n * 16); *(f32x4*)(o + off + bj * HALF + n * 16) = a + b; } }
    }
};
struct PoolOrder {
    int G, c;
    __device__ bool next(int i, Unit& u) const { const int L = i * G + c; if (L >= 256) return false; const int g = L & 3, pm = L >> 2;     u.pm = g * P_NT + pm; u.pn = g; u.k0 = 0; u.nt = 4; u.part = 0; return true; }
    __device__ __forceinline__ void a_ready(const Unit&) const {}
    __device__ __forceinline__ void done(const Unit&) const {}
};
struct PanelOrder {
    int G, c, ntk;
    __device__ bool next(int i, Unit& u) const {
        const int L = i * G + c; if (L >= 256) return false;
        const int x = L & 7, idx = L >> 3; u.pm = x * 8 + (idx >> 2); u.pn = idx & 3; u.k0 = 0; u.nt = ntk; u.part = 0; return true;
    }
    __device__ __forceinline__ void a_ready(const Unit&) const {}
    __device__ __forceinline__ void done(const Unit&) const {}
};
template <class Epi, class Sched, bool ALIGN_EPI = false, bool SP2 = false>
__device__ __forceinline__ void gemm_phase(PG8_LAS unsigned char* lds, const Gemm g, const Sched& S, const Epi& E, const int tid_in) {
    int tid_raw = tid_in; asm volatile("" : "+v"(tid_raw));
    const int tid = tid_raw, wid = __builtin_amdgcn_readfirstlane(tid >> 6), lane = tid & 63, wr = wid >> 2, wc = wid & 3, fr = lane & 15, fq = lane >> 4;
    const int K = g.K;
    unsigned voffA[2], voffB[2];
#pragma unroll
    for (int i = 0; i < 2; ++i) { int R, C; stage_rc(tid * 16 + i * 8192, R, C); const int Rb = Epi::PERM ? ((R & ~31) + perm32(R & 31)) : R;
        voffA[i] = (unsigned)(R * K + C) * 2u; voffB[i] = (unsigned)(Rb * K + C) * 2u; }
    const size_t kstep = (size_t)(BK * 2);
    const size_t hstep = (size_t)HALF * K * 2;
    const size_t tstep = 2 * hstep;
    const unsigned ldsw = (unsigned)wid * 1024u;
    const int aoff = lds_byte(wr * 64 + fr, fq * 8), boff = lds_byte(wc * 32 + fr, fq * 8);
#define PG8_SA(b, h) (((b) * 2 + (h)) * HTB)
#define PG8_SB(b, h) ((4 + (b) * 2 + (h)) * HTB)
#define PG8_STAGE(bufoff, gbase, voff) do { _Pragma("unroll") for (int _i = 0; _i < 2; ++_i) \
        __builtin_amdgcn_global_load_lds((const unsigned*)((const char*)(gbase) + (voff)[_i]), (PG8_LAS unsigned*)(lds + (bufoff) + ldsw + _i * 8192), 16, 0, 0); } while (0)
#define PG8_LDA(dst, b, h) do { _Pragma("unroll") for (int m = 0; m < 4; ++m) _Pragma("unroll") for (int k = 0; k < 2; ++k) dst[m][k] = *(const PG8_LAS bf16x8*)(lds + PG8_SA(b, h) + aoff + m * 2048 + k * 1024); } while (0)
#define PG8_LDB(dst, b, h) do { _Pragma("unroll") for (int n = 0; n < 2; ++n) _Pragma("unroll") for (int k = 0; k < 2; ++k) dst[n][k] = *(const PG8_LAS bf16x8*)(lds + PG8_SB(b, h) + boff + n * 2048 + k * 1024); } while (0)
#define PG8_MMA(ai, bj, At, Bt) do { __builtin_amdgcn_s_setprio(1); _Pragma("unroll") for (int m = 0; m < 4; ++m) _Pragma("unroll") for (int n = 0; n < 2; ++n) _Pragma("unroll") for (int k = 0; k < 2; ++k) \
        acc[ai][bj][m][n] = __builtin_amdgcn_mfma_f32_16x16x32_bf16(Bt[n][k], At[m][k], acc[ai][bj][m][n], 0, 0, 0); __builtin_amdgcn_s_setprio(0); } while (0)
#define PG8_WAIT_V(n) asm volatile("s_waitcnt vmcnt(" #n ")" ::: "memory")
#define PG8_WAIT_L(n) asm volatile("s_waitcnt lgkmcnt(" #n ")" ::: "memory")
#define PG8_BAR __builtin_amdgcn_s_barrier()
#define PG8_SCHED __builtin_amdgcn_sched_barrier(0)
    Unit cur, nxt; int ui = 0;
    if (!S.next(0, cur)) return;
    f32x4 acc[2][2][4][2];
#pragma unroll
    for (int a = 0; a < 2; ++a)
#pragma unroll
        for (int b = 0; b < 2; ++b)
#pragma unroll
            for (int m = 0; m < 4; ++m)
#pragma unroll
                for (int n = 0; n < 2; ++n) acc[a][b][m][n] = (f32x4){0.f, 0.f, 0.f, 0.f};
    bf16x8 At[4][2], B0[2][2], B1[2][2];
    const char* cA = (const char*)g.A + (size_t)cur.pm * tstep + (size_t)cur.k0 * 2; const char* cB = (const char*)g.Bt + (size_t)cur.pn * tstep + (size_t)cur.k0 * 2;
    S.a_ready(cur);
    if constexpr (SP2) {
        PG8_STAGE(PG8_SB(0, 0), cB, voffB); PG8_STAGE(PG8_SB(0, 1), cB + hstep, voffB); PG8_STAGE(PG8_SA(0, 0), cA, voffA); PG8_STAGE(PG8_SA(0, 1), cA + hstep, voffA);
        if (wr == 1) PG8_BAR;
        PG8_WAIT_V(2); PG8_BAR;
        PG8_STAGE(PG8_SB(1, 0), cB + kstep, voffB); PG8_STAGE(PG8_SA(1, 0), cA + kstep, voffA); PG8_STAGE(PG8_SB(1, 1), cB + hstep + kstep, voffB);
        PG8_WAIT_V(6); PG8_BAR;
    } else {
        PG8_STAGE(PG8_SB(0, 0), cB, voffB); PG8_STAGE(PG8_SA(0, 0), cA, voffA); PG8_STAGE(PG8_SB(0, 1), cB + hstep, voffB); PG8_STAGE(PG8_SA(0, 1), cA + hstep, voffA);
        if (wr == 1) PG8_BAR;
        PG8_WAIT_V(4); PG8_BAR;
        PG8_STAGE(PG8_SB(1, 0), cB + kstep, voffB); PG8_STAGE(PG8_SA(1, 0), cA + kstep, voffA); PG8_STAGE(PG8_SB(1, 1), cB + hstep + kstep, voffB);
        PG8_WAIT_V(6); PG8_BAR;
    }
    for (;;) {
        const bool has_next = S.next(ui + 1, nxt);
        const char* nA = has_next ? (const char*)g.A + (size_t)nxt.pm * tstep + (size_t)nxt.k0 * 2 : cA; const char* nB = has_next ? (const char*)g.Bt + (size_t)nxt.pn * tstep + (size_t)nxt.k0 * 2 : cB;
        const int nt = cur.nt;
        for (int t = 0; t < nt; t += 2) {
            const bool last = (t == nt - 2);
            const char* a1 = cA + (size_t)(t + 1) * kstep;
            const char* a2 = last ? nA : cA + (size_t)(t + 2) * kstep; const char* b2 = last ? nB : cB + (size_t)(t + 2) * kstep;
            const char* a3 = a2 + kstep; const char* b3 = b2 + kstep;
            if (last && has_next) S.a_ready(nxt);
            if constexpr (SP2) {
            PG8_LDB(B0, 0, 0); PG8_LDB(B1, 0, 1); PG8_SCHED; PG8_LDA(At, 0, 0); PG8_STAGE(PG8_SA(1, 1), a1 + hstep, voffA);
            PG8_WAIT_V(8); PG8_WAIT_L(0); PG8_BAR; PG8_MMA(0, 0, At, B0); PG8_MMA(0, 1, At, B1); PG8_BAR; PG8_SCHED;
            PG8_LDA(At, 0, 1); PG8_STAGE(PG8_SB(0, 0), b2, voffB); PG8_STAGE(PG8_SB(0, 1), b2 + hstep, voffB); PG8_STAGE(PG8_SA(0, 0), a2, voffA);
            PG8_WAIT_V(8); PG8_WAIT_L(0); PG8_BAR; PG8_MMA(1, 0, At, B0); PG8_MMA(1, 1, At, B1); PG8_BAR; PG8_SCHED;
            PG8_LDB(B0, 1, 0); PG8_LDB(B1, 1, 1); PG8_SCHED; PG8_LDA(At, 1, 0); PG8_STAGE(PG8_SA(0, 1), a2 + hstep, voffA);
            PG8_WAIT_V(8); PG8_WAIT_L(0); PG8_BAR; PG8_MMA(0, 0, At, B0); PG8_MMA(0, 1, At, B1); PG8_BAR; PG8_SCHED;
            PG8_LDA(At, 1, 1); PG8_STAGE(PG8_SB(1, 0), b3, voffB); PG8_STAGE(PG8_SB(1, 1), b3 + hstep, voffB); PG8_STAGE(PG8_SA(1, 0), a3, voffA);
            PG8_WAIT_V(8); PG8_WAIT_L(0); PG8_BAR; PG8_MMA(1, 0, At, B0); PG8_MMA(1, 1, At, B1); PG8_BAR; PG8_SCHED;
            } else {
            PG8_LDB(B0, 0, 0); PG8_SCHED; PG8_LDA(At, 0, 0); PG8_STAGE(PG8_SA(1, 1), a1 + hstep, voffA);
            PG8_WAIT_L(8); PG8_BAR; PG8_WAIT_L(0); PG8_MMA(0, 0, At, B0); PG8_BAR; PG8_SCHED;
            PG8_LDB(B1, 0, 1); PG8_STAGE(PG8_SB(0, 0), b2, voffB);
            PG8_BAR; PG8_WAIT_L(0); PG8_MMA(0, 1, At, B1); PG8_BAR;
            PG8_LDA(At, 0, 1); PG8_STAGE(PG8_SA(0, 0), a2, voffA);
            PG8_BAR; PG8_WAIT_L(0); PG8_MMA(1, 0, At, B0); PG8_BAR; PG8_SCHED;
            PG8_STAGE(PG8_SB(0, 1), b2 + hstep, voffB);
            PG8_WAIT_V(6); PG8_BAR; PG8_MMA(1, 1, At, B1); PG8_BAR;
            PG8_LDB(B0, 1, 0); PG8_SCHED; PG8_LDA(At, 1, 0); PG8_STAGE(PG8_SA(0, 1), a2 + hstep, voffA);
            PG8_WAIT_L(8); PG8_BAR; PG8_WAIT_L(0); PG8_MMA(0, 0, At, B0); PG8_BAR; PG8_SCHED;
            PG8_LDB(B1, 1, 1); PG8_STAGE(PG8_SB(1, 0), b3, voffB);
            PG8_BAR; PG8_WAIT_L(0); PG8_MMA(0, 1, At, B1); PG8_BAR;
            PG8_LDA(At, 1, 1); PG8_STAGE(PG8_SA(1, 0), a3, voffA);
            PG8_BAR; PG8_WAIT_L(0); PG8_MMA(1, 0, At, B0); PG8_BAR; PG8_SCHED;
            PG8_STAGE(PG8_SB(1, 1), b3 + hstep, voffB);
            PG8_WAIT_V(6); PG8_BAR; PG8_MMA(1, 1, At, B1); PG8_BAR;
            }
        }
        if constexpr (ALIGN_EPI) { if (wr == 0) PG8_BAR; }
        if constexpr (!Epi::AFTER_DRAIN) { E(acc, cur, wr, wc, fr, fq); S.done(cur); }
        if (!has_next) break;
#pragma unroll
        for (int a = 0; a < 2; ++a)
#pragma unroll
            for (int b = 0; b < 2; ++b)
#pragma unroll
                for (int m = 0; m < 4; ++m)
#pragma unroll
                    for (int n = 0; n < 2; ++n) acc[a][b][m][n] = (f32x4){0.f, 0.f, 0.f, 0.f};
        cur = nxt; cA = nA; cB = nB; ++ui;
        if constexpr (ALIGN_EPI) { if (wr == 1) PG8_BAR; }
    }
    PG8_WAIT_V(0);
    if constexpr (!ALIGN_EPI) { if (wr == 0) PG8_BAR; }
    PG8_BAR;
    if constexpr (Epi::AFTER_DRAIN) { E.fused(acc, cur, wr, wc, fr, fq, lds, wid, lane); S.done(cur); }
#undef PG8_SA
#undef PG8_SB
#undef PG8_STAGE
#undef PG8_LDA
#undef PG8_LDB
#undef PG8_MMA
#undef PG8_WAIT_V
#undef PG8_WAIT_L
#undef PG8_BAR
#undef PG8_SCHED
}
}
#define GAS __attribute__((address_space(1)))
#define LAS __attribute__((address_space(3)))
typedef unsigned short bf16;
typedef unsigned v4u __attribute__((ext_vector_type(4)));
typedef float f32x4 __attribute__((ext_vector_type(4)));
typedef short bf16x8 __attribute__((ext_vector_type(8)));
typedef GAS unsigned gu32;
typedef GAS unsigned long long gu64;
#define RLX_AGENT __ATOMIC_RELAXED, __HIP_MEMORY_SCOPE_AGENT
#define LDS_WAIT() asm volatile("s_waitcnt lgkmcnt(0)" ::: "memory")
#define VM_WAIT() asm volatile("s_waitcnt vmcnt(0)" ::: "memory")
__device__ __forceinline__ unsigned long long rt() { return __builtin_amdgcn_s_memrealtime(); }
__device__ __forceinline__ unsigned f2bf(float f) { unsigned u = __builtin_bit_cast(unsigned, f); return (u + 0x7fffu + ((u >> 16) & 1u)) >> 16; }
__device__ __forceinline__ unsigned pk2(float lo, float hi) { return f2bf(lo) | (f2bf(hi) << 16); }

#define XB_TMO      128
#define XB_XCNT(j)  (256  + 64 * (j))
#define XB_XSUB(j)  (1280 + 64 * (j))
#define XB_XGEN(j)  (2304 + 64 * (j))
#define XB_TOP      3328
#define XB_TOPGEN   3392
#define XCD_BAR_WORDS 3456
#define XB_SPIN_CAP (1u << 18)

__device__ __forceinline__ unsigned xb_ld(unsigned* p)              { return __hip_atomic_load(p, __ATOMIC_RELAXED, __HIP_MEMORY_SCOPE_AGENT); }
__device__ __forceinline__ unsigned xb_add(unsigned* p, unsigned v) { return __hip_atomic_fetch_add(p, v, __ATOMIC_RELAXED, __HIP_MEMORY_SCOPE_AGENT); }
__device__ __forceinline__ unsigned xb_xcc_id() { return (unsigned)__builtin_amdgcn_s_getreg((3 << 11) | 20) & 0xFu; }
#define XB_SPIN(cond, bar) do { unsigned _sp = 0; while (cond) { __builtin_amdgcn_s_sleep(1); \
    if ((++_sp & 255u) == 0u) { if (xb_ld(&(bar)[XB_TMO])) break; if (_sp > XB_SPIN_CAP) { atomicAdd(&(bar)[XB_TMO], 1u); break; } } } } while (0)

struct XcdBarrier {
    unsigned* bar; unsigned x;
    volatile LAS unsigned* st;
};

__device__ __forceinline__ XcdBarrier xcd_barrier_post(unsigned* bar, volatile LAS unsigned* st) {
    XcdBarrier b; b.bar = bar; b.x = xb_xcc_id(); b.st = st;
    if (threadIdx.x == 0) (void)xb_add(&bar[XB_XCNT(b.x)], 1u);
    return b;
}
__device__ __forceinline__ void xcd_barrier_complete(unsigned* bar, unsigned x, unsigned& nloc, unsigned& nx) {
    const unsigned G = gridDim.x * gridDim.y * gridDim.z;
    unsigned sum, cnt, mine, sp = 0u;
    for (;;) {
        sum = 0u; cnt = 0u; mine = 0u;
#pragma unroll
        for (unsigned j = 0; j < 16; ++j) { const unsigned c = xb_ld(&bar[XB_XCNT(j)]); sum += c; cnt += (c > 0u) ? 1u : 0u; mine = (j == x) ? c : mine; }
        if (sum == G) break;
        __builtin_amdgcn_s_sleep(1);
        if ((++sp & 255u) == 0u) { if (xb_ld(&bar[XB_TMO])) break; if (sp > XB_SPIN_CAP) { atomicAdd(&bar[XB_TMO], 1u); break; } }
    }
    nloc = mine > 0u ? mine : 1u; nx = cnt > 0u ? cnt : 1u;
}

__device__ __forceinline__ void xcd_barrier(const XcdBarrier& b) {
    asm volatile("s_waitcnt vmcnt(0)" ::: "memory");
    __syncthreads();
    if (threadIdx.x == 0) {
        unsigned* bar = b.bar;
        __builtin_amdgcn_s_waitcnt(0);
        unsigned nloc = b.st[0], nx = b.st[1];
        if (nloc == 0u) { xcd_barrier_complete(bar, b.x, nloc, nx); b.st[0] = nloc; b.st[1] = nx; }
        const unsigned old = xb_add(&bar[XB_XSUB(b.x)], 1u);
        const unsigned gen = old / nloc;
        if (old + 1u == (gen + 1u) * nloc) {
            __builtin_amdgcn_fence(__ATOMIC_RELEASE, "agent");
            asm volatile("s_waitcnt vmcnt(0)" ::: "memory");
            const unsigned og = xb_add(&bar[XB_TOP], 1u);
            const unsigned tg = og / nx;
            if (og + 1u == (tg + 1u) * nx) xb_add(&bar[XB_TOPGEN], 1u);
            else XB_SPIN(xb_ld(&bar[XB_TOPGEN]) == tg, bar);
            __builtin_amdgcn_fence(__ATOMIC_ACQUIRE, "agent");
            xb_add(&bar[XB_XGEN(b.x)], 1u);
            asm volatile("s_waitcnt vmcnt(0)" ::: "memory");
        } else {
            XB_SPIN(xb_ld(&bar[XB_XGEN(b.x)]) == gen, bar);
            __builtin_amdgcn_fence(__ATOMIC_ACQUIRE, "agent");
            asm volatile("s_waitcnt vmcnt(0)" ::: "memory");
        }
    }
    __syncthreads();
}
constexpr int NWAVES = 8;
constexpr int DM = 1024, TP = 2048, NBP = 8, MP = NBP * TP, NBS = 128, TS = 8, MS = NBS * TS, M = MP + MS, FF = 2816, NG1 = 2 * FF;
constexpr int NIN = 3088, NINP = 3328, NPROJ = 3072, DK = 128, DV = 256, NH = 4;
constexpr float EPS = 1e-6f;
static_assert(M == 68 * 256, "row tiles");
constexpr size_t O_YP = 0, O_YS = (size_t)MP * DM, O_NPP = O_YS + (size_t)MS * DM, O_NGP = O_NPP + (size_t)2 * NBP * 15 * DM, O_NPS = O_NGP + (size_t)2 * NBP * NH * DK * DV,
                 O_NGS = O_NPS + (size_t)2 * NBS * 15 * DM, O_END = O_NGS + (size_t)2 * NBS * NH * DK * DV;
constexpr size_t MiB = 1u << 20;
constexpr size_t WS_CTL = 0, CTL_ZERO_BYTES = 1 * MiB;
constexpr size_t SZ_W13 = (size_t)NG1 * DM * 2, SZ_W2 = (size_t)DM * FF * 2, SZ_WIN = (size_t)NINP * DM * 2, SZ_WO = (size_t)DM * DM * 2, SZ_WP = (size_t)4 * 256 * 256 * 2;
constexpr size_t WS_W13 = 1 * MiB, WS_W2 = WS_W13 + 4 * SZ_W13, WS_WIN = WS_W2 + 4 * SZ_W2, WS_WO = WS_WIN + 2 * SZ_WIN, WS_WP = WS_WO + 2 * SZ_WO;
constexpr size_t WS_H = WS_WP + 2 * SZ_WP;
constexpr size_t WS_BIG = WS_H + (size_t)M * DM * 2;
constexpr size_t WS_ALOW = WS_BIG + (size_t)M * NPROJ * 2;
constexpr size_t WS_DS = WS_ALOW + (size_t)M * 16 * 4;
constexpr size_t WS_DSC = WS_DS + (size_t)32 * 7 * DK * DV * 4;
constexpr size_t WS_END = WS_DSC + (size_t)32 * 7 * DK * 4;
static_assert(WS_END <= 256 * MiB, "d_ws map");
static_assert(WS_H % 256 == 0 && WS_BIG % 256 == 0 && WS_ALOW % 256 == 0 && WS_DS % 256 == 0 && WS_DSC % 256 == 0, "alignment");
constexpr int CW_BAR = 4096;
constexpr int RING_BYTES = 131072, LDSCTL_OFF = RING_BYTES, MISC_OFF = LDSCTL_OFF + 320, LDS_BYTES = 147456;

__device__ __forceinline__ float wave_sum(float v) {
#pragma unroll
    for (int o = 1; o < 64; o <<= 1) v += __shfl_xor(v, o);
    return v;
}
__device__ __forceinline__ float bf2f(unsigned short b) { return __builtin_bit_cast(float, (unsigned)b << 16); }

__device__ __forceinline__ void tr_item(const float* W, int K, int N, bf16* WT, int mode, int row_off, LAS float* scr, int item, int lane) {
    const int nblk = (N + 31) >> 5, kb = item / nblk, nb = item - kb * nblk, k0 = 64 * kb, n0 = 32 * nb;
    const int nn = n0 + (lane & 31); const bool ok = nn < N;
    float wv[32];
#pragma unroll
    for (int i = 0; i < 32; ++i) { const int kk = 2 * i + (lane >> 5); wv[i] = ok ? W[(size_t)(k0 + kk) * N + nn] : 0.f; }
#pragma unroll
    for (int i = 0; i < 32; ++i) { const int kk = 2 * i + (lane >> 5); scr[kk * 33 + (lane & 31)] = wv[i]; }
    LDS_WAIT(); asm volatile("" ::: "memory");
    const int c = lane & 7;
#pragma unroll
    for (int j = 0; j < 4; ++j) { const int n = (lane >> 3) + 8 * j; const LAS float* s = scr + (8 * c) * 33 + n;
        v4u o; o.x = pk2(s[0 * 33], s[1 * 33]); o.y = pk2(s[2 * 33], s[3 * 33]); o.z = pk2(s[4 * 33], s[5 * 33]); o.w = pk2(s[6 * 33], s[7 * 33]);
        const int ng = n0 + n; const int row = mode ? (((ng >> 7) << 8) + (ng & 127) + row_off) : (row_off + ng);
        *(v4u*)(WT + (size_t)row * K + k0 + 8 * c) = o; }
    LDS_WAIT(); asm volatile("" ::: "memory");
}
__device__ __forceinline__ void p0_weights(LAS unsigned char* lds, int wave, int lane, int gw, int NGW, const float* const* in, unsigned char* ws) {
    LAS float* scr = (LAS float*)(lds + wave * 16384);
    constexpr int I_W1 = (DM / 64) * (FF / 32), I_W2 = (FF / 64) * (DM / 32), I_WIN = (DM / 64) * ((NIN + 31) / 32), I_WO = (DM / 64) * (DM / 32), I_WP = (256 / 64) * (256 / 32);
    constexpr int N_FFN = 4 * (2 * I_W1 + I_W2), N_GLA = 2 * (I_WIN + I_WO), N_POOL = 8 * I_WP, NITEMS = N_FFN + N_GLA + N_POOL;
    for (int it = gw; it < NITEMS; it += NGW) {
        int r = it;
        if (r < N_FFN) { const int L = r / (2 * I_W1 + I_W2); r -= L * (2 * I_W1 + I_W2);
            if (r < I_W1) { tr_item(in[14] + (size_t)L * DM * FF, DM, FF, (bf16*)(ws + WS_W13 + L * SZ_W13), 1, 0, scr, r, lane); continue; } r -= I_W1;
            if (r < I_W1) { tr_item(in[15] + (size_t)L * DM * FF, DM, FF, (bf16*)(ws + WS_W13 + L * SZ_W13), 1, 128, scr, r, lane); continue; } r -= I_W1;
            tr_item(in[16] + (size_t)L * FF * DM, FF, DM, (bf16*)(ws + WS_W2 + L * SZ_W2), 0, 0, scr, r, lane); continue; }
        r -= N_FFN;
        if (r < N_GLA) { const int L = r / (I_WIN + I_WO); r -= L * (I_WIN + I_WO);
            if (r < I_WIN) { tr_item(in[9] + (size_t)L * DM * NIN, DM, NIN, (bf16*)(ws + WS_WIN + L * SZ_WIN), 0, 0, scr, r, lane); continue; } r -= I_WIN;
            tr_item(in[13] + (size_t)L * DM * DM, DM, DM, (bf16*)(ws + WS_WO + L * SZ_WO), 0, 0, scr, r, lane); continue; }
        r -= N_GLA;
        { const int jg = r / I_WP; r -= jg * I_WP;
          tr_item(in[7] + (size_t)jg * 65536, 256, 256, (bf16*)(ws + WS_WP + (jg >> 2) * SZ_WP), 0, (jg & 3) * 256, scr, r, lane); }
    }
    constexpr int PADV = (NINP - 3104) * DM * 2 / 16;
    for (int i = gw * 64 + lane; i < 2 * PADV; i += NGW * 64) { const int L = i / PADV, e = i - L * PADV;
        ((v4u*)(ws + WS_WIN + L * SZ_WIN + (size_t)3104 * DM * 2))[e] = (v4u){0u, 0u, 0u, 0u}; }
}

__device__ __forceinline__ void rms_row_bf16(const float* xrow, const float* g, bf16* orow, int lane) {
    const f32x4* xr = (const f32x4*)xrow + lane; const f32x4* gr = (const f32x4*)g + lane;
    f32x4 v[4]; float s = 0.f;
#pragma unroll
    for (int j = 0; j < 4; ++j) { v[j] = xr[64 * j]; s += (v[j].x * v[j].x + v[j].y * v[j].y) + (v[j].z * v[j].z + v[j].w * v[j].w); }
    const float rstd = rsqrtf(wave_sum(s) * (1.f / DM) + EPS);
    unsigned long long* o8 = (unsigned long long*)orow + lane;
#pragma unroll
    for (int j = 0; j < 4; ++j) { const f32x4 gg = gr[64 * j]; const f32x4 y = v[j] * rstd * gg;
        o8[64 * j] = (unsigned long long)pk2(y.x, y.y) | ((unsigned long long)pk2(y.z, y.w) << 32); }
}
__device__ __forceinline__ void rms_phase(int gw, int NGW, int lane, const float* X, const float* g, bf16* H) {
    for (int m = gw; m < M; m += NGW) rms_row_bf16(X + (size_t)m * DM, g, H + (size_t)m * DM, lane);
}
__device__ __forceinline__ void final_norm_phase(int gw, int NGW, int lane, float* X, const float* g) {
    for (int m = gw; m < M; m += NGW) {
        f32x4* xr = (f32x4*)(X + (size_t)m * DM) + lane; const f32x4* gr = (const f32x4*)g + lane;
        f32x4 v[4]; float s = 0.f;
#pragma unroll
        for (int j = 0; j < 4; ++j) { v[j] = xr[64 * j]; s += (v[j].x * v[j].x + v[j].y * v[j].y) + (v[j].z * v[j].z + v[j].w * v[j].w); }
        const float rstd = rsqrtf(wave_sum(s) * (1.f / DM) + EPS);
#pragma unroll
        for (int j = 0; j < 4; ++j) xr[64 * j] = v[j] * rstd * gr[64 * j];
    }
}

__device__ __forceinline__ void small_gemm_res(LAS unsigned char* lds, const bf16* A, const bf16* Bt, int K, float* X, int tid, int wave, int G, int bid) {
    constexpr int RS = 272, BUF = 2 * 64 * RS;
    const int lane = tid & 63, fr = lane & 15, fq = lane >> 4, rt = wave & 3, ch = wave >> 2;
    const int lr = tid >> 3, lc = (tid & 7) * 16;
    const int nch = K >> 7;
    for (int L = bid; L < 256; L += G) {
        const int tm = L >> 4, tn = L & 15;
        const v4u* ag = (const v4u*)(A + (size_t)(tm * 64 + lr) * K + lc); const v4u* bg = (const v4u*)(Bt + (size_t)(tn * 64 + lr) * K + lc);
        LAS unsigned char* wa = lds + lr * RS + lc * 2; LAS unsigned char* wb = wa + 64 * RS;
        v4u pa[2], pb[2], qa[2], qb[2];
        { const v4u a0 = ag[0], a1 = ag[1], b0 = bg[0], b1 = bg[1];
          pa[0] = ag[16]; pa[1] = ag[17]; pb[0] = bg[16]; pb[1] = bg[17];
          qa[0] = ag[32]; qa[1] = ag[33]; qb[0] = bg[32]; qb[1] = bg[33];
          *(LAS v4u*)wa = a0; *(LAS v4u*)(wa + 16) = a1; *(LAS v4u*)wb = b0; *(LAS v4u*)(wb + 16) = b1; }
        __syncthreads();
        f32x4 acc0 = (f32x4){0.f, 0.f, 0.f, 0.f}, acc1 = (f32x4){0.f, 0.f, 0.f, 0.f};
#define SG_COMPUTE(bufoff) { _Pragma("unroll") for (int ks = 0; ks < 4; ++ks) { const bf16x8 a = *(const LAS bf16x8*)(lds + (bufoff) + (16 * rt + fr) * RS + (32 * ks + 8 * fq) * 2); \
            const bf16x8 b0 = *(const LAS bf16x8*)(lds + (bufoff) + 64 * RS + (32 * ch + fr) * RS + (32 * ks + 8 * fq) * 2), b1 = *(const LAS bf16x8*)(lds + (bufoff) + 64 * RS + (32 * ch + 16 + fr) * RS + (32 * ks + 8 * fq) * 2); \
            acc0 = __builtin_amdgcn_mfma_f32_16x16x32_bf16(b0, a, acc0, 0, 0, 0); acc1 = __builtin_amdgcn_mfma_f32_16x16x32_bf16(b1, a, acc1, 0, 0, 0); } }
        for (int kc = 0; kc < nch; kc += 2) {
            SG_COMPUTE(0)
            *(LAS v4u*)(wa + BUF) = pa[0]; *(LAS v4u*)(wa + BUF + 16) = pa[1]; *(LAS v4u*)(wb + BUF) = pb[0]; *(LAS v4u*)(wb + BUF + 16) = pb[1];
            if (kc + 3 < nch) { pa[0] = ag[16 * (kc + 3)]; pa[1] = ag[16 * (kc + 3) + 1]; pb[0] = bg[16 * (kc + 3)]; pb[1] = bg[16 * (kc + 3) + 1]; }
            __syncthreads();
            SG_COMPUTE(BUF)
            if (kc + 2 < nch) { *(LAS v4u*)wa = qa[0]; *(LAS v4u*)(wa + 16) = qa[1]; *(LAS v4u*)wb = qb[0]; *(LAS v4u*)(wb + 16) = qb[1]; }
            if (kc + 4 < nch) { qa[0] = ag[16 * (kc + 4)]; qa[1] = ag[16 * (kc + 4) + 1]; qb[0] = bg[16 * (kc + 4)]; qb[1] = bg[16 * (kc + 4) + 1]; }
            __syncthreads();
        }
#undef SG_COMPUTE
        float* o = X + (size_t)(tm * 64 + 16 * rt + fr) * DM + tn * 64 + 32 * ch + 4 * fq;
        *(f32x4*)o = *(const f32x4*)o + acc0; *(f32x4*)(o + 16) = *(const f32x4*)(o + 16) + acc1;
    }
    __syncthreads();
}

__device__ __forceinline__ void small_gemm_pool(LAS unsigned char* lds, const bf16* DIFF, const bf16* Wp, const float* base_s, float* Xs, const float* scale, int tid, int wave, int G, int bid) {
    constexpr int RS = 272, BUF = 2 * 64 * RS;
    const int lane = tid & 63, fr = lane & 15, fq = lane >> 4, rt = wave & 3, ch = wave >> 2;
    const int lr = tid >> 3, lc = (tid & 7) * 16;
    for (int L = bid; L < 256; L += G) {
        const int tm = L >> 4, tn = L & 15, g = tn >> 2, cb = (tn & 3) * 64;
        const v4u* ag = (const v4u*)(DIFF + ((size_t)g * M + MP + tm * 64 + lr) * 256 + lc); const v4u* bg = (const v4u*)(Wp + ((size_t)g * 256 + cb + lr) * 256 + lc);
        const v4u a0 = ag[0], a1 = ag[1], a2 = ag[16], a3 = ag[17], b0 = bg[0], b1 = bg[1], b2 = bg[16], b3 = bg[17];
        LAS unsigned char* wa = lds + lr * RS + lc * 2; LAS unsigned char* wb = wa + 64 * RS;
        *(LAS v4u*)wa = a0; *(LAS v4u*)(wa + 16) = a1; *(LAS v4u*)wb = b0; *(LAS v4u*)(wb + 16) = b1;
        *(LAS v4u*)(wa + BUF) = a2; *(LAS v4u*)(wa + BUF + 16) = a3; *(LAS v4u*)(wb + BUF) = b2; *(LAS v4u*)(wb + BUF + 16) = b3;
        __syncthreads();
        f32x4 acc0 = (f32x4){0.f, 0.f, 0.f, 0.f}, acc1 = (f32x4){0.f, 0.f, 0.f, 0.f};
#pragma unroll
        for (int kk = 0; kk < 8; ++kk) { const int bufoff = (kk >> 2) * BUF, ks = kk & 3;
            const bf16x8 a = *(const LAS bf16x8*)(lds + bufoff + (16 * rt + fr) * RS + (32 * ks + 8 * fq) * 2);
            const bf16x8 w0 = *(const LAS bf16x8*)(lds + bufoff + 64 * RS + (32 * ch + fr) * RS + (32 * ks + 8 * fq) * 2), w1 = *(const LAS bf16x8*)(lds + bufoff + 64 * RS + (32 * ch + 16 + fr) * RS + (32 * ks + 8 * fq) * 2);
            acc0 = __builtin_amdgcn_mfma_f32_16x16x32_bf16(w0, a, acc0, 0, 0, 0); acc1 = __builtin_amdgcn_mfma_f32_16x16x32_bf16(w1, a, acc1, 0, 0, 0); }
        const int col = g * 256 + cb + 32 * ch + 4 * fq; const size_t ro = (size_t)(tm * 64 + 16 * rt + fr) * DM + col;
        const f32x4 x0 = *(const f32x4*)(base_s + ro) + acc0 * *(const f32x4*)(scale + col), x1 = *(const f32x4*)(base_s + ro + 16) + acc1 * *(const f32x4*)(scale + col + 16);
        *(f32x4*)(Xs + ro) = x0; *(f32x4*)(Xs + ro + 16) = x1;
        __syncthreads();
    }
}

__device__ __forceinline__ void pool_prep(LAS unsigned char* lds, int tid, int wave, int lane, int G, int bid,
                                          const float* xp, const float* xs, const float* gmix, const float* spool, bf16* DIFF, float* onp, float* ons) {
    typedef float f32x2 __attribute__((ext_vector_type(2)));
    LAS float* hb = (LAS float*)lds;
    for (int u = bid; u < 1024 + NBS; u += G) {
        const bool pr = u < 1024; const int b = pr ? (u >> 7) : (u - 1024); const int t0 = pr ? (u & 127) * 16 : 0; const int ntok = pr ? 16 : 8;
        {
            f32x4 v[4][4]; bool has[4], donorm[4];
#pragma unroll
            for (int k = 0; k < 4; ++k) { const int r = wave + 8 * k; const float* src = nullptr; donorm[k] = true;
                if (r < 15 + ntok) {
                    if (pr) { const int t = t0 - 15 + r; if (t >= 0) src = xp + ((size_t)b * TP + t) * DM; }
                    else { if (r < 15) { src = spool + ((size_t)b * 15 + r) * DM; donorm[k] = false; } else src = xs + ((size_t)b * TS + (r - 15)) * DM; } }
                has[k] = src != nullptr;
#pragma unroll
                for (int j = 0; j < 4; ++j) v[k][j] = has[k] ? ((const f32x4*)src + lane)[64 * j] : (f32x4){0.f, 0.f, 0.f, 0.f}; }
            const f32x4* gr = (const f32x4*)gmix + lane;
#pragma unroll
            for (int k = 0; k < 4; ++k) { const int r = wave + 8 * k;
                if (r < 15 + ntok) { float s = 0.f;
#pragma unroll
                    for (int j = 0; j < 4; ++j) s += (v[k][j].x * v[k][j].x + v[k][j].y * v[k][j].y) + (v[k][j].z * v[k][j].z + v[k][j].w * v[k][j].w);
                    const float rstd = (has[k] && donorm[k]) ? rsqrtf(wave_sum(s) * (1.f / DM) + EPS) : 1.f;
                    LAS f32x4* hrow = (LAS f32x4*)(hb + r * DM) + lane;
#pragma unroll
                    for (int j = 0; j < 4; ++j) hrow[64 * j] = (has[k] && donorm[k]) ? v[k][j] * rstd * gr[64 * j] : v[k][j]; } }
        }
        __syncthreads();
        const int c = 2 * tid, gi = tid >> 7, w = 2 << gi;
        f32x2 sum = (f32x2){0.f, 0.f};
        for (int l = 1; l < w; ++l) sum += *(const LAS f32x2*)(hb + (15 - l) * DM + c);
        for (int i = 0; i < ntok; ++i) {
            const f32x2 cur = *(const LAS f32x2*)(hb + (15 + i) * DM + c); sum += cur;
            const int cnt = pr ? ((t0 + i + 1) < w ? (t0 + i + 1) : w) : w; const float inv = 1.0f / (float)cnt;
            const f32x2 d = sum * inv - cur;
            const size_t row = pr ? ((size_t)b * TP + t0 + i) : ((size_t)MP + b * TS + i);
            *(unsigned*)(DIFF + ((size_t)gi * M + row) * 256 + (c & 255)) = pk2(d.x, d.y);
            sum -= *(const LAS f32x2*)(hb + (15 + i - w + 1) * DM + c);
        }
        if (pr) { if (t0 == TP - 16) for (int i = 1; i < 16; ++i) *(f32x2*)(onp + ((size_t)b * 15 + (i - 1)) * DM + c) = *(const LAS f32x2*)(hb + (15 + i) * DM + c); }
        else for (int i = 0; i < 15; ++i) *(f32x2*)(ons + ((size_t)b * 15 + i) * DM + c) = *(const LAS f32x2*)(hb + (8 + i) * DM + c);
        __syncthreads();
    }
}

constexpr int L_QH = 0, L_KH = 17408, L_KT = 34816, L_VT = 53248, L_AL = 90112, L_ALOW = 99328, L_DL = 105472, L_SSQ = 105984, L_TOT = 108032, L_WA = 112128, L_BA = 120320, L_NW = 120832, L_GLA_END = 121856;
constexpr int QS = 272, TSB = 144;
static_assert(L_GLA_END <= RING_BYTES, "GLA LDS");
__device__ __forceinline__ bf16x8 pack8(const f32x4 a, const f32x4 b) {
    v4u w; w.x = pg8::cvt_pk_bf16(a[0], a[1]); w.y = pg8::cvt_pk_bf16(a[2], a[3]); w.z = pg8::cvt_pk_bf16(b[0], b[1]); w.w = pg8::cvt_pk_bf16(b[2], b[3]);
    return __builtin_bit_cast(bf16x8, w);
}
__device__ __forceinline__ void gla_phase(LAS unsigned char* lds, int tid, int wave, int lane, int G, int bid, int phase, int jl,
                                          const float* const* in, float* out, unsigned char* ws) {
    typedef unsigned u32x2 __attribute__((ext_vector_type(2)));
    const bf16* PROJ = (const bf16*)(ws + WS_BIG); const float* ALOW = (const float*)(ws + WS_ALOW); bf16* GOUT = (bf16*)(ws + WS_H);
    float* DS = (float*)(ws + WS_DS); float* DSC = (float*)(ws + WS_DSC);
    const int nitems = phase == 0 ? (224 + 4 * NBS) : 256;
    const int tid_in = tid;
    for (int item = bid; item < nitems; item += G) {
        int tid = tid_in; asm volatile("" : "+v"(tid));
        int lane = tid & 63, fr = lane & 15, fq = lane >> 4;
        int b, h, row0, ntok, sc = 0; bool want_out, samp = false;
        if (phase == 0) { if (item < 224) { const int bh = item / 7; sc = item - bh * 7; b = bh >> 2; h = bh & 3; row0 = b * TP + sc * 256; ntok = 256; want_out = false; }
                          else { const int q = item - 224; b = q >> 2; h = q & 3; row0 = MP + b * TS; ntok = TS; want_out = true; samp = true; } }
        else { const int bh = item >> 3; sc = item & 7; b = bh >> 2; h = bh & 3; row0 = b * TP + sc * 256; ntok = 256; want_out = true; }
        const int bh = b * 4 + h;
        f32x4 S[8][2];
#pragma unroll
        for (int dt = 0; dt < 8; ++dt)
#pragma unroll
            for (int vt = 0; vt < 2; ++vt) S[dt][vt] = (f32x4){0.f, 0.f, 0.f, 0.f};
        if (samp) {
            const float* s0 = in[3] + ((size_t)(jl * NBS + b) * NH + h) * DK * DV;
#pragma unroll
            for (int dt = 0; dt < 8; ++dt)
#pragma unroll
                for (int vt = 0; vt < 2; ++vt)
#pragma unroll
                    for (int e = 0; e < 4; ++e) S[dt][vt][e] = s0[(size_t)(16 * dt + 4 * fq + e) * DV + 32 * wave + 16 * vt + fr];
        } else if (phase == 1 && sc > 0) {
            const float* dsp = DS + (size_t)(bh * 7 + sc - 1) * DK * DV;
#pragma unroll
            for (int dt = 0; dt < 8; ++dt)
#pragma unroll
                for (int vt = 0; vt < 2; ++vt) S[dt][vt] = *(const f32x4*)(dsp + (size_t)(((wave * 8 + dt) * 2 + vt) * 64 + lane) * 4);
        }
        { const int r = tid >> 5, d4 = (tid & 31) * 4;
          *(LAS f32x4*)(lds + L_WA + (r * 128 + d4) * 4) = *(const f32x4*)(in[10] + (size_t)jl * 16 * 512 + r * 512 + h * DK + d4) * 1.4426950408889634f;
          if (tid < 32) *(LAS f32x4*)(lds + L_BA + tid * 16) = *(const f32x4*)(in[11] + jl * 512 + h * DK + tid * 4) * 1.4426950408889634f;
          if (tid < 64) *(LAS f32x4*)(lds + L_NW + tid * 16) = *(const f32x4*)(in[12] + jl * DM + h * DV + tid * 4); }
        float btot0 = 0.f, btot1 = 0.f;
        const int nsub = (ntok + 63) >> 6;
        unsigned qn[8], kn[8]; v4u vn[4]; f32x4 aln;
#define GLA_LOAD(sbx) { const int tokv_ = (ntok - 64 * (sbx)) < 64 ? (ntok - 64 * (sbx)) : 64; const int rb_ = row0 + 64 * (sbx); const int dp_ = tid & 63, jp_ = tid & 31, vg_ = tid >> 5; \
            _Pragma("unroll") for (int i = 0; i < 8; ++i) { const int tok = 8 * wave + i; qn[i] = 0u; kn[i] = 0u; \
                if (tok < tokv_) { const unsigned* pr = (const unsigned*)(PROJ + (size_t)(rb_ + tok) * NPROJ + h * DK) + dp_; qn[i] = pr[0]; kn[i] = pr[256]; } } \
            _Pragma("unroll") for (int i = 0; i < 2; ++i) { const int tok = 2 * jp_ + i; vn[2 * i] = (v4u){0u, 0u, 0u, 0u}; vn[2 * i + 1] = (v4u){0u, 0u, 0u, 0u}; \
                if (tok < tokv_) { const v4u* pv = (const v4u*)(PROJ + (size_t)(rb_ + tok) * NPROJ + 1024 + h * DV + 16 * vg_); vn[2 * i] = pv[0]; vn[2 * i + 1] = pv[1]; } } \
            aln = (f32x4){0.f, 0.f, 0.f, 0.f}; if (tid < 256) { const int tok = tid >> 2; if (tok < tokv_) aln = *(const f32x4*)(ALOW + (size_t)(rb_ + tok) * 16 + 4 * (tid & 3)); } }
        GLA_LOAD(0)
        for (int sb = 0; sb < nsub; ++sb) {
            typedef float f32x2 __attribute__((ext_vector_type(2)));
            const int tokv = (ntok - 64 * sb) < 64 ? (ntok - 64 * sb) : 64; const int rbase = row0 + 64 * sb;
            asm volatile("" : "+v"(tid)); lane = tid & 63; fr = lane & 15; fq = lane >> 4;
            const int dp = tid & 63, jp = tid & 31, vg = tid >> 5;
            if (tid < 256) *(LAS f32x4*)(lds + L_ALOW + (tid >> 2) * 64 + 16 * (tid & 3)) = aln;
            __syncthreads();
            f32x2 bj[8];
            { f32x2 x[8]; const f32x2 bav = *(const LAS f32x2*)(lds + L_BA + dp * 8);
#pragma unroll
              for (int i = 0; i < 8; ++i) x[i] = bav;
#pragma unroll
              for (int r4 = 0; r4 < 4; ++r4) { const f32x2 w0 = *(const LAS f32x2*)(lds + L_WA + ((4 * r4 + 0) * 128 + 2 * dp) * 4), w1 = *(const LAS f32x2*)(lds + L_WA + ((4 * r4 + 1) * 128 + 2 * dp) * 4),
                                                            w2 = *(const LAS f32x2*)(lds + L_WA + ((4 * r4 + 2) * 128 + 2 * dp) * 4), w3 = *(const LAS f32x2*)(lds + L_WA + ((4 * r4 + 3) * 128 + 2 * dp) * 4);
                  f32x4 al[8];
#pragma unroll
                  for (int i = 0; i < 8; ++i) al[i] = *(const LAS f32x4*)(lds + L_ALOW + (8 * wave + i) * 64 + 16 * r4);
#pragma unroll
                  for (int i = 0; i < 8; ++i) x[i] = w0 * al[i][0] + x[i];
#pragma unroll
                  for (int i = 0; i < 8; ++i) x[i] = w1 * al[i][1] + x[i];
#pragma unroll
                  for (int i = 0; i < 8; ++i) x[i] = w2 * al[i][2] + x[i];
#pragma unroll
                  for (int i = 0; i < 8; ++i) x[i] = w3 * al[i][3] + x[i]; }
              f32x2 run = (f32x2){0.f, 0.f};
#pragma unroll
              for (int i = 0; i < 8; ++i) { f32x2 g;
                  g.x = (fminf(x[i].x, 0.f) - __builtin_amdgcn_logf(1.0f + __builtin_amdgcn_exp2f(-fabsf(x[i].x)))) * (1.0f / 16.0f); g.y = (fminf(x[i].y, 0.f) - __builtin_amdgcn_logf(1.0f + __builtin_amdgcn_exp2f(-fabsf(x[i].y)))) * (1.0f / 16.0f);
                  if (tokv < 64 && 8 * wave + i >= tokv) g = (f32x2){0.f, 0.f};
                  run += g; bj[i] = run; }
              *(LAS f32x2*)(lds + L_TOT + (wave * 128 + 2 * dp) * 4) = run; }
            __syncthreads();
            f32x2 pre = (f32x2){0.f, 0.f}, blast = (f32x2){0.f, 0.f};
#pragma unroll
            for (int q = 0; q < 8; ++q) { const f32x2 t = *(const LAS f32x2*)(lds + L_TOT + (q * 128 + 2 * dp) * 4); blast += t; if (q < wave) pre += t; }
            btot0 += blast.x; btot1 += blast.y;
            if (wave == 0) *(LAS f32x2*)(lds + L_DL + dp * 8) = (f32x2){__builtin_amdgcn_exp2f(blast.x), __builtin_amdgcn_exp2f(blast.y)};
            { unsigned kb[8];
#pragma unroll
              for (int i = 0; i < 8; ++i) { const int tok = 8 * wave + i; const f32x2 bb = bj[i] + pre;
                  const float e1x = __builtin_amdgcn_exp2f(blast.x - bb.x), e1y = __builtin_amdgcn_exp2f(blast.y - bb.y), e2x = __builtin_amdgcn_exp2f(bb.x - blast.x), e2y = __builtin_amdgcn_exp2f(bb.y - blast.y);
                  const unsigned qh = pg8::cvt_pk_bf16(bf2f((unsigned short)(qn[i] & 0xffffu)) * e2x, bf2f((unsigned short)(qn[i] >> 16)) * e2y);
                  const unsigned kh = pg8::cvt_pk_bf16(bf2f((unsigned short)(kn[i] & 0xffffu)) * e1x, bf2f((unsigned short)(kn[i] >> 16)) * e1y);
                  *(LAS unsigned*)(lds + L_QH + tok * QS + dp * 4) = qh; *(LAS unsigned*)(lds + L_KH + tok * QS + dp * 4) = kh; kb[i] = kh; }
              v4u k0, k1;
              k0.x = (kb[0] & 0xffffu) | (kb[1] << 16); k0.y = (kb[2] & 0xffffu) | (kb[3] << 16); k0.z = (kb[4] & 0xffffu) | (kb[5] << 16); k0.w = (kb[6] & 0xffffu) | (kb[7] << 16);
              k1.x = (kb[0] >> 16) | (kb[1] & 0xffff0000u); k1.y = (kb[2] >> 16) | (kb[3] & 0xffff0000u); k1.z = (kb[4] >> 16) | (kb[5] & 0xffff0000u); k1.w = (kb[6] >> 16) | (kb[7] & 0xffff0000u);
              *(LAS v4u*)(lds + L_KT + (2 * dp) * TSB + wave * 16) = k0; *(LAS v4u*)(lds + L_KT + (2 * dp + 1) * TSB + wave * 16) = k1; }
            {
#pragma unroll
              for (int hv = 0; hv < 2; ++hv) { const unsigned a4[4] = {vn[hv].x, vn[hv].y, vn[hv].z, vn[hv].w}, b4[4] = {vn[2 + hv].x, vn[2 + hv].y, vn[2 + hv].z, vn[2 + hv].w};
#pragma unroll
                  for (int k = 0; k < 4; ++k) { LAS unsigned char* p = lds + L_VT + (16 * vg + 8 * hv + 2 * k) * TSB + jp * 4;
                      *(LAS unsigned*)p = (a4[k] & 0xffffu) | (b4[k] << 16); *(LAS unsigned*)(p + TSB) = (a4[k] >> 16) | (b4[k] & 0xffff0000u); } } }
            __syncthreads();
            u32x2 rcur[4][2];
            if (want_out) {
#pragma unroll
                for (int it = 0; it < 4; ++it)
#pragma unroll
                    for (int vt = 0; vt < 2; ++vt) { rcur[it][vt] = (u32x2){0u, 0u};
                        if (16 * it + fr < tokv) rcur[it][vt] = *(const u32x2*)(PROJ + (size_t)(rbase + 16 * it + fr) * NPROJ + 2048 + h * DV + 32 * wave + 16 * vt + 4 * fq); } }
            if (sb + 1 < nsub) GLA_LOAD(sb + 1)
#pragma unroll
            for (int dt = 0; dt < 8; ++dt) { const f32x4 dv = *(const LAS f32x4*)(lds + L_DL + (16 * dt + 4 * fq) * 4); S[dt][0] = S[dt][0] * dv; S[dt][1] = S[dt][1] * dv; }
            if (want_out) {
                f32x4 O[2][4];
#pragma unroll
                for (int tt = 0; tt < 2; ++tt) { const int idx = 2 * wave + tt, it = idx >> 2, jt = idx & 3; f32x4 a = (f32x4){0.f, 0.f, 0.f, 0.f};
                    if (jt <= it) {
#pragma unroll
                        for (int ks = 0; ks < 4; ++ks) { const bf16x8 X = *(const LAS bf16x8*)(lds + L_KH + (16 * jt + fr) * QS + (32 * ks + 8 * fq) * 2);
                            const bf16x8 Y = *(const LAS bf16x8*)(lds + L_QH + (16 * it + fr) * QS + (32 * ks + 8 * fq) * 2);
                            a = __builtin_amdgcn_mfma_f32_16x16x32_bf16(X, Y, a, 0, 0, 0); }
                        const int ii = 16 * it + fr, j0 = 16 * jt + 4 * fq;
#pragma unroll
                        for (int e = 0; e < 4; ++e) if (j0 + e > ii) a[e] = 0.f;
                    }
                    u32x2 w2; w2.x = pg8::cvt_pk_bf16(a[0], a[1]); w2.y = pg8::cvt_pk_bf16(a[2], a[3]);
                    *(LAS u32x2*)(lds + L_AL + (16 * it + fr) * TSB + (16 * jt + 4 * fq) * 2) = w2; }
                __syncthreads();
                {
                bf16x8 Xs[2][4];
#pragma unroll
                for (int vt = 0; vt < 2; ++vt)
#pragma unroll
                    for (int dp = 0; dp < 4; ++dp) Xs[vt][dp] = pack8(S[2 * dp][vt], S[2 * dp + 1][vt]);
                bf16x8 XV[2][2];
#pragma unroll
                for (int vt = 0; vt < 2; ++vt)
#pragma unroll
                    for (int js = 0; js < 2; ++js) XV[vt][js] = *(const LAS bf16x8*)(lds + L_VT + (32 * wave + 16 * vt + fr) * TSB + (32 * js + 8 * fq) * 2);
#pragma unroll
                for (int it = 0; it < 4; ++it) {
                    bf16x8 YQ[4], YA[2];
#pragma unroll
                    for (int dp = 0; dp < 4; ++dp) { const u32x2 lo = *(const LAS u32x2*)(lds + L_QH + (16 * it + fr) * QS + (32 * dp + 4 * fq) * 2);
                        const u32x2 hi = *(const LAS u32x2*)(lds + L_QH + (16 * it + fr) * QS + (32 * dp + 16 + 4 * fq) * 2);
                        YQ[dp] = __builtin_bit_cast(bf16x8, (v4u){lo.x, lo.y, hi.x, hi.y}); }
#pragma unroll
                    for (int js = 0; js < 2; ++js) YA[js] = *(const LAS bf16x8*)(lds + L_AL + (16 * it + fr) * TSB + (32 * js + 8 * fq) * 2);
#pragma unroll
                    for (int vt = 0; vt < 2; ++vt) { f32x4 o = (f32x4){0.f, 0.f, 0.f, 0.f};
#pragma unroll
                        for (int dp = 0; dp < 4; ++dp) o = __builtin_amdgcn_mfma_f32_16x16x32_bf16(Xs[vt][dp], YQ[dp], o, 0, 0, 0);
#pragma unroll
                        for (int js = 0; js < 2; ++js) o = __builtin_amdgcn_mfma_f32_16x16x32_bf16(XV[vt][js], YA[js], o, 0, 0, 0);
                        O[vt][it] = o; }
                    __builtin_amdgcn_sched_barrier(0);
                }
                }
#pragma unroll
                for (int it = 0; it < 4; ++it) { float ss = 0.f;
#pragma unroll
                    for (int vt = 0; vt < 2; ++vt) { const f32x4 o = O[vt][it]; ss += (o[0] * o[0] + o[1] * o[1]) + (o[2] * o[2] + o[3] * o[3]); }
                    ss += __shfl_xor(ss, 16); ss += __shfl_xor(ss, 32);
                    if (fq == 0) *(LAS float*)(lds + L_SSQ + (wave * 64 + 16 * it + fr) * 4) = ss; }
                __syncthreads();
#pragma unroll
                for (int it = 0; it < 4; ++it) { const int tok = 16 * it + fr; float tot = 0.f;
#pragma unroll
                    for (int w8 = 0; w8 < 8; ++w8) tot += *(const LAS float*)(lds + L_SSQ + (w8 * 64 + tok) * 4);
                    const float rstd = rsqrtf(tot * (1.0f / DV) + EPS);
                    if (tok < tokv) { const size_t row = (size_t)(rbase + tok);
#pragma unroll
                        for (int vt = 0; vt < 2; ++vt) { const int vcol = h * DV + 32 * wave + 16 * vt + 4 * fq;
                            const u32x2 r2 = rcur[it][vt]; const f32x4 nw = *(const LAS f32x4*)(lds + L_NW + (32 * wave + 16 * vt + 4 * fq) * 4);
                            const f32x4 o = O[vt][it];
                            const float r0 = bf2f((unsigned short)(r2.x & 0xffffu)), r1 = bf2f((unsigned short)(r2.x >> 16)), r2f = bf2f((unsigned short)(r2.y & 0xffffu)), r3 = bf2f((unsigned short)(r2.y >> 16));
                            u32x2 w2; w2.x = pg8::cvt_pk_bf16(o[0] * rstd * nw[0] * r0, o[1] * rstd * nw[1] * r1);
                            w2.y = pg8::cvt_pk_bf16(o[2] * rstd * nw[2] * r2f, o[3] * rstd * nw[3] * r3);
                            *(u32x2*)(GOUT + row * DM + vcol) = w2; } }
                    __builtin_amdgcn_sched_barrier(0); }
            }
            __builtin_amdgcn_sched_barrier(0);
#pragma unroll
            for (int js = 0; js < 2; ++js)
#pragma unroll
                for (int vt = 0; vt < 2; ++vt) { const bf16x8 Yv = *(const LAS bf16x8*)(lds + L_VT + (32 * wave + 16 * vt + fr) * TSB + (32 * js + 8 * fq) * 2);
#pragma unroll
                    for (int dt = 0; dt < 8; ++dt) { const bf16x8 Xk = *(const LAS bf16x8*)(lds + L_KT + (16 * dt + fr) * TSB + (32 * js + 8 * fq) * 2);
                        S[dt][vt] = __builtin_amdgcn_mfma_f32_16x16x32_bf16(Xk, Yv, S[dt][vt], 0, 0, 0); }
                    __builtin_amdgcn_sched_barrier(0); }
            __syncthreads();
        }
        asm volatile("" : "+v"(tid)); lane = tid & 63; fr = lane & 15; fq = lane >> 4;
        if (phase == 0 && !samp) {
            float* dsp = DS + (size_t)(bh * 7 + sc) * DK * DV;
#pragma unroll
            for (int dt = 0; dt < 8; ++dt)
#pragma unroll
                for (int vt = 0; vt < 2; ++vt) *(f32x4*)(dsp + (size_t)(((wave * 8 + dt) * 2 + vt) * 64 + lane) * 4) = S[dt][vt];
            if (wave == 0) { DSC[(size_t)(bh * 7 + sc) * DK + 2 * (tid & 63)] = __builtin_amdgcn_exp2f(btot0); DSC[(size_t)(bh * 7 + sc) * DK + 2 * (tid & 63) + 1] = __builtin_amdgcn_exp2f(btot1); }
        } else if (samp || sc == 7) {
            float* so = samp ? out + O_NGS + ((size_t)(jl * NBS + b) * NH + h) * DK * DV : out + O_NGP + ((size_t)(jl * NBP + b) * NH + h) * DK * DV;
#pragma unroll
            for (int dt = 0; dt < 8; ++dt)
#pragma unroll
                for (int vt = 0; vt < 2; ++vt)
#pragma unroll
                    for (int e = 0; e < 4; ++e) so[(size_t)(16 * dt + 4 * fq + e) * DV + 32 * wave + 16 * vt + fr] = S[dt][vt][e];
        }
    }
}


__device__ __forceinline__ void gla_scan_phase(int gt, int NT, unsigned char* ws) {
    float* DS = (float*)(ws + WS_DS); const float* DSC = (const float*)(ws + WS_DSC);
    for (int c = gt; c < 32 * 8192; c += NT) {
        const int bh = c >> 13, e4 = c & 8191, ln = e4 & 63, dt = (e4 >> 7) & 7, dcol = 16 * dt + 4 * (ln >> 4);
        f32x4 ds[7], dv[7];
#pragma unroll
        for (int k = 0; k < 7; ++k) { ds[k] = *(const f32x4*)(DS + (size_t)(bh * 7 + k) * DK * DV + (size_t)e4 * 4); dv[k] = *(const f32x4*)(DSC + (size_t)(bh * 7 + k) * DK + dcol); }
        f32x4 run = (f32x4){0.f, 0.f, 0.f, 0.f};
#pragma unroll
        for (int k = 0; k < 7; ++k) { run = run * dv[k] + ds[k]; *(f32x4*)(DS + (size_t)(bh * 7 + k) * DK * DV + (size_t)e4 * 4) = run; }
    }
}

struct Args { const float* in[17]; float* out; unsigned char* ws; int ph_lo, ph_hi; };
constexpr int N_PHASES = 29;
__global__ void __launch_bounds__(NWAVES * 64, 2) mk_fwd(Args args) {
    extern __shared__ __attribute__((aligned(16))) unsigned char lds_raw[];
    LAS unsigned char* lds = (LAS unsigned char*)lds_raw;
    volatile LAS unsigned* MISC = (volatile LAS unsigned*)(lds + MISC_OFF);
    for (int u = threadIdx.x; u < (LDS_BYTES - LDSCTL_OFF) / 4; u += NWAVES * 64) ((LAS unsigned*)(lds + LDSCTL_OFF))[u] = 0u;
    __syncthreads();
    XcdBarrier bar = xcd_barrier_post((unsigned*)(args.ws + WS_CTL) + CW_BAR, MISC + 8);
    const int lo = args.ph_lo, hi = args.ph_hi;
    const int wave0 = __builtin_amdgcn_readfirstlane(threadIdx.x >> 6);
#define PH_BEGIN(k) if ((k) >= lo && (k) < hi) { int tid = wave0 * 64 + (int)__builtin_amdgcn_mbcnt_hi(~0u, __builtin_amdgcn_mbcnt_lo(~0u, 0u)); asm volatile("" : "+v"(tid)); const int lane = tid & 63, wave = wave0; \
        const int G = gridDim.x, bid = blockIdx.x; const int vcu = (G % 8 == 0) ? (bid % 8) * (G / 8) + bid / 8 : bid; const int gw = vcu * NWAVES + wave, NGW = G * NWAVES; \
        unsigned char* ws = args.ws; float* out = args.out; const float* const* in = args.in; bf16* Hb = (bf16*)(ws + WS_H); bf16* BIG = (bf16*)(ws + WS_BIG); float* Xs_ = out + O_YS; \
        (void)lane; (void)gw; (void)NGW; (void)Hb; (void)BIG; (void)Xs_; (void)in;
#define PH_END(k)   if ((k) + 1 < hi) xcd_barrier(bar); }

#define POOL_GEMM(k, L) PH_BEGIN(k) { constexpr int jl = (L) >> 1; \
        pg8::Gemm g{BIG, (const bf16*)(ws + WS_WP + jl * SZ_WP), 4 * M, 1024, 256}; pg8::PoolOrder S{G, bid}; \
        pg8::EpiRes<true> E{(L) == 0 ? in[0] : out, (L) == 0 ? in[1] : Xs_, out, in[8] + jl * DM}; \
        pg8::gemm_phase<pg8::EpiRes<true>, pg8::PoolOrder, true, true>(lds, g, S, E, tid); \
        small_gemm_pool(lds, BIG, (const bf16*)(ws + WS_WP + jl * SZ_WP), (L) == 0 ? in[1] : Xs_, Xs_, in[8] + jl * DM, tid, wave, G, bid); } PH_END(k)
#define RMS_PH(k, gain) PH_BEGIN(k) rms_phase(gw, NGW, lane, out, (gain), Hb); PH_END(k)
#define FFN1(k, L) PH_BEGIN(k) { pg8::Gemm g{Hb, (const bf16*)(ws + WS_W13 + (L) * SZ_W13), M, NG1, DM}; pg8::StaticOrder S; S.init(M, NG1, G, bid, DM); \
        pg8::EpiSwiglu E{BIG}; pg8::gemm_phase<pg8::EpiSwiglu, pg8::StaticOrder, true, true>(lds, g, S, E, tid); } PH_END(k)
#define FFN2(k, L) PH_BEGIN(k) { pg8::Gemm g{BIG, (const bf16*)(ws + WS_W2 + (L) * SZ_W2), M, DM, FF}; pg8::PanelOrder S{G, bid, FF / 64}; \
        pg8::EpiRes<false> E{out, Xs_, out, nullptr}; pg8::gemm_phase<pg8::EpiRes<false>, pg8::PanelOrder, true, true>(lds, g, S, E, tid); \
        small_gemm_res(lds, BIG + (size_t)MP * FF, (const bf16*)(ws + WS_W2 + (L) * SZ_W2), FF, Xs_, tid, wave, G, bid); } PH_END(k)
#define PROJ_PH(k, jl) PH_BEGIN(k) { pg8::Gemm g{Hb, (const bf16*)(ws + WS_WIN + (jl) * SZ_WIN), M, NINP, DM}; pg8::StaticOrder S; S.init(M, NINP, G, bid, DM); \
        pg8::EpiProj E{BIG, (float*)(ws + WS_ALOW)}; pg8::gemm_phase<pg8::EpiProj, pg8::StaticOrder, true, true>(lds, g, S, E, tid); } PH_END(k)
#define WO_PH(k, jl) PH_BEGIN(k) { pg8::Gemm g{Hb, (const bf16*)(ws + WS_WO + (jl) * SZ_WO), M, DM, DM}; pg8::PanelOrder S{G, bid, DM / 64}; \
        pg8::EpiRes<false> E{out, Xs_, out, nullptr}; pg8::gemm_phase<pg8::EpiRes<false>, pg8::PanelOrder, true, true>(lds, g, S, E, tid); \
        small_gemm_res(lds, Hb + (size_t)MP * DM, (const bf16*)(ws + WS_WO + (jl) * SZ_WO), DM, Xs_, tid, wave, G, bid); } PH_END(k)
#define GLA_PH(k, sub, jl) PH_BEGIN(k) gla_phase(lds, tid, wave, lane, G, bid, (sub), (jl), in, out, ws); PH_END(k)

#ifdef NO_GLA
#undef GLA_PH
#define GLA_PH(k, sub, jl)
#endif
#ifdef NO_GEMM
#undef POOL_GEMM
#undef FFN1
#undef FFN2
#undef PROJ_PH
#undef WO_PH
#define POOL_GEMM(k, L)
#define FFN1(k, L)
#define FFN2(k, L)
#define PROJ_PH(k, jl)
#define WO_PH(k, jl)
#endif
#ifdef ONLY_FFN1
#undef POOL_GEMM
#undef FFN2
#undef PROJ_PH
#undef WO_PH
#define POOL_GEMM(k, L)
#define FFN2(k, L)
#define PROJ_PH(k, jl)
#define WO_PH(k, jl)
#endif
    PH_BEGIN(0)
        p0_weights(lds, wave, lane, gw, NGW, in, ws);
        __syncthreads();
        pool_prep(lds, tid, wave, lane, G, bid, in[0], in[1], in[4] + 0 * DM, in[2], BIG, out + O_NPP, out + O_NPS);
    PH_END(0)
    POOL_GEMM(1, 0)
    RMS_PH(2, in[5] + 0 * DM)
    FFN1(3, 0)
    FFN2(4, 0)
    RMS_PH(5, in[4] + 1 * DM)
    PROJ_PH(6, 0)
    GLA_PH(7, 0, 0)
    PH_BEGIN(8)
        gla_scan_phase(vcu * (NWAVES * 64) + tid, G * NWAVES * 64, ws);
    PH_END(8)
    GLA_PH(9, 1, 0)
    WO_PH(10, 0)
    RMS_PH(11, in[5] + 1 * DM)
    FFN1(12, 1)
    FFN2(13, 1)
    PH_BEGIN(14)
        pool_prep(lds, tid, wave, lane, G, bid, out, Xs_, in[4] + 2 * DM, in[2] + (size_t)NBS * 15 * DM, BIG, out + O_NPP + (size_t)NBP * 15 * DM, out + O_NPS + (size_t)NBS * 15 * DM);
    PH_END(14)
    POOL_GEMM(15, 2)
    RMS_PH(16, in[5] + 2 * DM)
    FFN1(17, 2)
    FFN2(18, 2)
    RMS_PH(19, in[4] + 3 * DM)
    PROJ_PH(20, 1)
    GLA_PH(21, 0, 1)
    PH_BEGIN(22)
        gla_scan_phase(vcu * (NWAVES * 64) + tid, G * NWAVES * 64, ws);
    PH_END(22)
    GLA_PH(23, 1, 1)
    WO_PH(24, 1)
    RMS_PH(25, in[5] + 3 * DM)
    FFN1(26, 3)
    FFN2(27, 3)
    PH_BEGIN(28)
        final_norm_phase(gw, NGW, lane, out, in[6]);
    PH_END(28)
}

#ifndef MK_SPLIT
#define MK_SPLIT 0
#endif
extern "C" void kernel_launch(void* const* d_in, const int* in_sizes, int n_in, void* d_out, int out_size, void* d_ws, size_t ws_size, hipStream_t stream) {
    static int grid = 0;
    if (grid == 0) {
        if (n_in != 17 || (size_t)out_size != O_END || ws_size < WS_END) { fprintf(stderr, "kernel_launch: unexpected shapes (n_in %d out %d ws %zu)\n", n_in, out_size, ws_size); grid = -1; return; }
        int dev = 0, cus = 0, per_cu = 0;
        if (hipGetDevice(&dev) != hipSuccess || hipDeviceGetAttribute(&cus, hipDeviceAttributeMultiprocessorCount, dev) != hipSuccess) { grid = -1; return; }
        if (hipFuncSetAttribute((const void*)mk_fwd, hipFuncAttributeMaxDynamicSharedMemorySize, LDS_BYTES) != hipSuccess) { fprintf(stderr, "kernel_launch: hipFuncSetAttribute failed\n"); grid = -1; return; }
        if (hipOccupancyMaxActiveBlocksPerMultiprocessor(&per_cu, (const void*)mk_fwd, NWAVES * 64, LDS_BYTES) != hipSuccess || per_cu < 1) { fprintf(stderr, "kernel_launch: occupancy query failed (%d)\n", per_cu); (void)hipGetLastError(); per_cu = 1; }
        grid = cus;
        if (grid > cus * per_cu) grid = cus * per_cu;
    }
    if (grid < 0) return;
    if (hipMemsetAsync((char*)d_ws + WS_CTL, 0, CTL_ZERO_BYTES, stream) != hipSuccess) { fprintf(stderr, "kernel_launch: memset failed\n"); return; }
    Args a{};
    for (int i = 0; i < 17; ++i) a.in[i] = (const float*)d_in[i];
    a.out = (float*)d_out; a.ws = (unsigned char*)d_ws;
#if MK_SPLIT
    for (int p = 0; p < N_PHASES; ++p) { a.ph_lo = p; a.ph_hi = p + 1; hipLaunchKernelGGL(mk_fwd, dim3(grid), dim3(NWAVES * 64), LDS_BYTES, stream, a); }
#else
    a.ph_lo = 0; a.ph_hi = N_PHASES;
    void* kargs[] = {&a};
    hipError_t e = hipLaunchCooperativeKernel((const void*)mk_fwd, dim3(grid), dim3(NWAVES * 64), kargs, LDS_BYTES, stream);
    if (e != hipSuccess) fprintf(stderr, "kernel_launch: cooperative launch failed: %s (grid %d)\n", hipGetErrorString(e), grid);
#endif
}
```

```cpp
#include <hip/hip_runtime.h>
#include <cstdio>
#include <cstdint>
namespace pg8 {
#define PG8_LAS __attribute__((address_space(3)))
typedef unsigned short bf16_t;
typedef short bf16x8 __attribute__((ext_vector_type(8)));
typedef float f32x4 __attribute__((ext_vector_type(4)));
typedef unsigned u32x4 __attribute__((ext_vector_type(4)));
constexpr int BM = 256, BK = 64, HALF = 128, HTB = HALF * BK * 2  , STAGE_BYTES = 8 * HTB, NXCD = 8, WGM = 4;

__host__ __device__ __forceinline__ int lds_byte(int r, int c) { const int st = (r >> 4) * 2 + (c >> 5), rr = r & 15, cc = c & 31, ob = rr * 64 + cc * 2; return st * 1024 + (ob ^ (((ob >> 9) & 1) << 5)); }
__host__ __device__ __forceinline__ void stage_rc(int b, int& R, int& C) { const int st = b / 1024, sb = b % 1024, swz = sb ^ (((sb >> 9) & 1) << 5); R = (st >> 1) * 16 + swz / 64; C = (st & 1) * 32 + (swz % 64) / 2; }
__host__ __device__ __forceinline__ int perm32(int rho) { const int n = rho >> 4, i = rho & 15; return 8 * (i >> 2) + 4 * n + (i & 3); }

struct Unit { int pm, pn, k0, nt, part; };
struct Gemm { const bf16_t* A; const bf16_t* Bt; int M, N, K; };

struct StaticOrder {
    int nM, nN, nwg, G, c, ntk;
    __host__ __device__ void init(int M, int N, int G_, int c_, int K_) { nM = M / BM; nN = N / BM; nwg = nM * nN; G = G_; c = c_; ntk = K_ / BK; }
    __host__ __device__ bool next(int i, Unit& u) const {
        const long L = (long)i * G + c; if (L >= nwg) return false;
        int wgid = (int)L; { const int q = nwg / NXCD, r = nwg % NXCD, xcd = wgid % NXCD, off = wgid / NXCD; wgid = (xcd < r ? xcd * (q + 1) : r * (q + 1) + (xcd - r) * q) + off; }
        const int nig = WGM * nN, gid = wgid / nig, fm = gid * WGM, gsz = (nM - fm) < WGM ? (nM - fm) : WGM;
        u.pm = fm + ((wgid % nig) % gsz); u.pn = (wgid % nig) / gsz; u.k0 = 0; u.nt = ntk; u.part = 0; return true;
    }
    __device__ __forceinline__ void a_ready(const Unit&) const {}
    __device__ __forceinline__ void done(const Unit&) const {}
};

__device__ __forceinline__ unsigned cvt_pk_bf16(float lo, float hi) { unsigned r; asm volatile("v_cvt_pk_bf16_f32 %0, %1, %2" : "=v"(r) : "v"(lo), "v"(hi)); return r; }
typedef float f32x2 __attribute__((ext_vector_type(2)));
typedef unsigned u32x2 __attribute__((ext_vector_type(2)));
__device__ __forceinline__ float silu_f(float x) { return x * __builtin_amdgcn_rcpf(1.0f + __builtin_amdgcn_exp2f(x * -1.4426950408889634f)); }
constexpr int P_DM = 1024, P_FF = 2816, P_NT = 68  , P_PROJ = 3072;

__device__ __forceinline__ unsigned swiglu_pk(f32x2 g, f32x2 u) {
    const f32x2 t = g * -1.4426950408889634f; f32x2 e; e.x = __builtin_amdgcn_exp2f(t.x); e.y = __builtin_amdgcn_exp2f(t.y);
    const f32x2 d = e + 1.0f; f32x2 r; r.x = __builtin_amdgcn_rcpf(d.x); r.y = __builtin_amdgcn_rcpf(d.y);
    const f32x2 o = (g * u) * r; return cvt_pk_bf16(o.x, o.y);
}
struct EpiSwiglu {
    static constexpr bool PERM = true, AFTER_DRAIN = false;
    bf16_t* U;
    __device__ __forceinline__ void operator()(const f32x4 (&acc)[2][2][4][2], const Unit& u, int wr, int wc, int fr, int fq) const {
        const int row0 = u.pm * BM + wr * 64 + fr, col0 = u.pn * 128 + wc * 32 + 8 * fq;
#pragma unroll
        for (int ai = 0; ai < 2; ++ai)
#pragma unroll
            for (int m = 0; m < 4; ++m) { bf16_t* rowp = U + (size_t)(row0 + ai * HALF + m * 16) * P_FF + col0;
                const f32x4 g0 = acc[ai][0][m][0], g1 = acc[ai][0][m][1], u0 = acc[ai][1][m][0], u1 = acc[ai][1][m][1];
                u32x4 w; w.x = swiglu_pk((f32x2){g0[0], g0[1]}, (f32x2){u0[0], u0[1]}); w.y = swiglu_pk((f32x2){g0[2], g0[3]}, (f32x2){u0[2], u0[3]});
                w.z = swiglu_pk((f32x2){g1[0], g1[1]}, (f32x2){u1[0], u1[1]}); w.w = swiglu_pk((f32x2){g1[2], g1[3]}, (f32x2){u1[2], u1[3]});
                *(u32x4*)rowp = w; }
    }
};
struct EpiProj {
    static constexpr bool PERM = true, AFTER_DRAIN = false;
    bf16_t* P; float* AL;
    __device__ __forceinline__ void operator()(const f32x4 (&acc)[2][2][4][2], const Unit& u, int wr, int wc, int fr, int fq) const {
        const int row0 = u.pm * BM + wr * 64 + fr;
        if (u.pn >= 8 && u.pn < 12) {
            const int col0 = u.pn * BM + wc * 32 + 8 * fq; const f32x2 one = (f32x2){1.f, 1.f};
#pragma unroll
            for (int ai = 0; ai < 2; ++ai)
#pragma unroll
                for (int m = 0; m < 4; ++m) { bf16_t* rowp = P + (size_t)(row0 + ai * HALF + m * 16) * P_PROJ + col0;
#pragma unroll
                    for (int bj = 0; bj < 2; ++bj) { const f32x4 v0 = acc[ai][bj][m][0], v1 = acc[ai][bj][m][1];
                        u32x4 w; w.x = swiglu_pk((f32x2){v0[0], v0[1]}, one); w.y = swiglu_pk((f32x2){v0[2], v0[3]}, one); w.z = swiglu_pk((f32x2){v1[0], v1[1]}, one); w.w = swiglu_pk((f32x2){v1[2], v1[3]}, one);
                        *(u32x4*)(rowp + bj * HALF) = w; } }
        } else if (u.pn < 12) {
            const float sc = u.pn < 2 ? 0.08838834764831845f : 1.0f;
            const int col0 = u.pn * BM + wc * 32 + 8 * fq;
#pragma unroll
            for (int ai = 0; ai < 2; ++ai)
#pragma unroll
                for (int m = 0; m < 4; ++m) { bf16_t* rowp = P + (size_t)(row0 + ai * HALF + m * 16) * P_PROJ + col0;
#pragma unroll
                    for (int bj = 0; bj < 2; ++bj) { const f32x4 v0 = acc[ai][bj][m][0] * sc, v1 = acc[ai][bj][m][1] * sc;
                        u32x4 w; w.x = cvt_pk_bf16(v0[0], v0[1]); w.y = cvt_pk_bf16(v0[2], v0[3]); w.z = cvt_pk_bf16(v1[0], v1[1]); w.w = cvt_pk_bf16(v1[2], v1[3]);
                        *(u32x4*)(rowp + bj * HALF) = w; } }
        } else if (wc == 0 && fq < 2) {
#pragma unroll
            for (int ai = 0; ai < 2; ++ai)
#pragma unroll
                for (int m = 0; m < 4; ++m) { float* rowp = AL + (size_t)(row0 + ai * HALF + m * 16) * 16 + 8 * fq;
                    *(f32x4*)rowp = acc[ai][0][m][0]; *(f32x4*)(rowp + 4) = acc[ai][0][m][1]; }
        }
    }
};
template <bool POOL> struct EpiRes {
    static constexpr bool PERM = false, AFTER_DRAIN = false;
    const float* bp; const float* bs; float* out; const float* scale;
    __device__ __forceinline__ void operator()(const f32x4 (&acc)[2][2][4][2], const Unit& u, int wr, int wc, int fr, int fq) const {
        const int pm = POOL ? (u.pm - P_NT * u.pn) : u.pm, pn = u.pn;
        const float* base = pm < 64 ? bp + (size_t)pm * BM * P_DM : bs + (size_t)(pm - 64) * BM * P_DM;
        float* o = out + (size_t)pm * BM * P_DM;
        int frq = fr + 16 * fq; asm volatile("" : "+v"(frq));
        const unsigned col0 = (unsigned)(pn * BM + wc * 32 + 4 * (frq >> 4));
        const unsigned roff = (unsigned)(wr * 64 + (frq & 15)) * P_DM + col0;
#pragma unroll
        for (int ai = 0; ai < 2; ++ai)
#pragma unroll
            for (int m = 0; m < 4; ++m) { const unsigned off = roff + (unsigned)(ai * HALF + m * 16) * P_DM;
#pragma unroll
                for (int bj = 0; bj < 2; ++bj)
#pragma unroll
                    for (int n = 0; n < 2; ++n) { f32x4 a = acc[ai][bj][m][n]; if (POOL) a = a * *(const f32x4*)(scale + col0 + bj * HALF + n * 16);
                        const f32x4 b = *(const f32x4*)(base + off + bj * HALF + n * 16); *(f32x4*)(o + off + bj * HALF + n * 16) = a + b; } }
    }
};
struct PoolOrder {
    int G, c;
    __device__ bool next(int i, Unit& u) const { const int L = i * G + c; if (L >= 256) return false; const int g = L & 3, pm = L >> 2;     u.pm = g * P_NT + pm; u.pn = g; u.k0 = 0; u.nt = 4; u.part = 0; return true; }
    __device__ __forceinline__ void a_ready(const Unit&) const {}
    __device__ __forceinline__ void done(const Unit&) const {}
};
struct PanelOrder {
    int G, c, ntk;
    __device__ bool next(int i, Unit& u) const {
        const int L = i * G + c; if (L >= 256) return false;
        const int x = L & 7, idx = L >> 3; u.pm = x * 8 + (idx >> 2); u.pn = idx & 3; u.k0 = 0; u.nt = ntk; u.part = 0; return true;
    }
    __device__ __forceinline__ void a_ready(const Unit&) const {}
    __device__ __forceinline__ void done(const Unit&) const {}
};
template <class Epi, class Sched, bool ALIGN_EPI = false, bool SP2 = false>
__device__ __forceinline__ void gemm_phase(PG8_LAS unsigned char* lds, const Gemm g, const Sched& S, const Epi& E, const int tid_in) {
    int tid_raw = tid_in; asm volatile("" : "+v"(tid_raw));
    const int tid = tid_raw, wid = __builtin_amdgcn_readfirstlane(tid >> 6), lane = tid & 63, wr = wid >> 2, wc = wid & 3, fr = lane & 15, fq = lane >> 4;
    const int K = g.K;
    unsigned voffA[2], voffB[2];
#pragma unroll
    for (int i = 0; i < 2; ++i) { int R, C; stage_rc(tid * 16 + i * 8192, R, C); const int Rb = Epi::PERM ? ((R & ~31) + perm32(R & 31)) : R;
        voffA[i] = (unsigned)(R * K + C) * 2u; voffB[i] = (unsigned)(Rb * K + C) * 2u; }
    const size_t kstep = (size_t)(BK * 2);
    const size_t hstep = (size_t)HALF * K * 2;
    const size_t tstep = 2 * hstep;
    const unsigned ldsw = (unsigned)wid * 1024u;
    const int aoff = lds_byte(wr * 64 + fr, fq * 8), boff = lds_byte(wc * 32 + fr, fq * 8);
#define PG8_SA(b, h) (((b) * 2 + (h)) * HTB)
#define PG8_SB(b, h) ((4 + (b) * 2 + (h)) * HTB)
#define PG8_STAGE(bufoff, gbase, voff) do { _Pragma("unroll") for (int _i = 0; _i < 2; ++_i) \
        __builtin_amdgcn_global_load_lds((const unsigned*)((const char*)(gbase) + (voff)[_i]), (PG8_LAS unsigned*)(lds + (bufoff) + ldsw + _i * 8192), 16, 0, 0); } while (0)
#define PG8_LDA(dst, b, h) do { _Pragma("unroll") for (int m = 0; m < 4; ++m) _Pragma("unroll") for (int k = 0; k < 2; ++k) dst[m][k] = *(const PG8_LAS bf16x8*)(lds + PG8_SA(b, h) + aoff + m * 2048 + k * 1024); } while (0)
#define PG8_LDB(dst, b, h) do { _Pragma("unroll") for (int n = 0; n < 2; ++n) _Pragma("unroll") for (int k = 0; k < 2; ++k) dst[n][k] = *(const PG8_LAS bf16x8*)(lds + PG8_SB(b, h) + boff + n * 2048 + k * 1024); } while (0)
#define PG8_MMA(ai, bj, At, Bt) do { __builtin_amdgcn_s_setprio(1); _Pragma("unroll") for (int m = 0; m < 4; ++m) _Pragma("unroll") for (int n = 0; n < 2; ++n) _Pragma("unroll") for (int k = 0; k < 2; ++k) \
        acc[ai][bj][m][n] = __builtin_amdgcn_mfma_f32_16x16x32_bf16(Bt[n][k], At[m][k], acc[ai][bj][m][n], 0, 0, 0); __builtin_amdgcn_s_setprio(0); } while (0)
#define PG8_WAIT_V(n) asm volatile("s_waitcnt vmcnt(" #n ")" ::: "memory")
#define PG8_WAIT_L(n) asm volatile("s_waitcnt lgkmcnt(" #n ")" ::: "memory")
#define PG8_BAR __builtin_amdgcn_s_barrier()
#define PG8_SCHED __builtin_amdgcn_sched_barrier(0)
    Unit cur, nxt; int ui = 0;
    if (!S.next(0, cur)) return;
    f32x4 acc[2][2][4][2];
#pragma unroll
    for (int a = 0; a < 2; ++a)
#pragma unroll
        for (int b = 0; b < 2; ++b)
#pragma unroll
            for (int m = 0; m < 4; ++m)
#pragma unroll
                for (int n = 0; n < 2; ++n) acc[a][b][m][n] = (f32x4){0.f, 0.f, 0.f, 0.f};
    bf16x8 At[4][2], B0[2][2], B1[2][2];
    const char* cA = (const char*)g.A + (size_t)cur.pm * tstep + (size_t)cur.k0 * 2; const char* cB = (const char*)g.Bt + (size_t)cur.pn * tstep + (size_t)cur.k0 * 2;
    S.a_ready(cur);
    if constexpr (SP2) {
        PG8_STAGE(PG8_SB(0, 0), cB, voffB); PG8_STAGE(PG8_SB(0, 1), cB + hstep, voffB); PG8_STAGE(PG8_SA(0, 0), cA, voffA); PG8_STAGE(PG8_SA(0, 1), cA + hstep, voffA);
        if (wr == 1) PG8_BAR;
        PG8_WAIT_V(2); PG8_BAR;
        PG8_STAGE(PG8_SB(1, 0), cB + kstep, voffB); PG8_STAGE(PG8_SA(1, 0), cA + kstep, voffA); PG8_STAGE(PG8_SB(1, 1), cB + hstep + kstep, voffB);
        PG8_WAIT_V(6); PG8_BAR;
    } else {
        PG8_STAGE(PG8_SB(0, 0), cB, voffB); PG8_STAGE(PG8_SA(0, 0), cA, voffA); PG8_STAGE(PG8_SB(0, 1), cB + hstep, voffB); PG8_STAGE(PG8_SA(0, 1), cA + hstep, voffA);
        if (wr == 1) PG8_BAR;
        PG8_WAIT_V(4); PG8_BAR;
        PG8_STAGE(PG8_SB(1, 0), cB + kstep, voffB); PG8_STAGE(PG8_SA(1, 0), cA + kstep, voffA); PG8_STAGE(PG8_SB(1, 1), cB + hstep + kstep, voffB);
        PG8_WAIT_V(6); PG8_BAR;
    }
    for (;;) {
        const bool has_next = S.next(ui + 1, nxt);
        const char* nA = has_next ? (const char*)g.A + (size_t)nxt.pm * tstep + (size_t)nxt.k0 * 2 : cA; const char* nB = has_next ? (const char*)g.Bt + (size_t)nxt.pn * tstep + (size_t)nxt.k0 * 2 : cB;
        const int nt = cur.nt;
        for (int t = 0; t < nt; t += 2) {
            const bool last = (t == nt - 2);
            const char* a1 = cA + (size_t)(t + 1) * kstep;
            const char* a2 = last ? nA : cA + (size_t)(t + 2) * kstep; const char* b2 = last ? nB : cB + (size_t)(t + 2) * kstep;
            const char* a3 = a2 + kstep; const char* b3 = b2 + kstep;
            if (last && has_next) S.a_ready(nxt);
            if constexpr (SP2) {
            PG8_LDB(B0, 0, 0); PG8_LDB(B1, 0, 1); PG8_SCHED; PG8_LDA(At, 0, 0); PG8_STAGE(PG8_SA(1, 1), a1 + hstep, voffA);
            PG8_WAIT_V(8); PG8_WAIT_L(0); PG8_BAR; PG8_MMA(0, 0, At, B0); PG8_MMA(0, 1, At, B1); PG8_BAR; PG8_SCHED;
            PG8_LDA(At, 0, 1); PG8_STAGE(PG8_SB(0, 0), b2, voffB); PG8_STAGE(PG8_SB(0, 1), b2 + hstep, voffB); PG8_STAGE(PG8_SA(0, 0), a2, voffA);
            PG8_WAIT_V(8); PG8_WAIT_L(0); PG8_BAR; PG8_MMA(1, 0, At, B0); PG8_MMA(1, 1, At, B1); PG8_BAR; PG8_SCHED;
            PG8_LDB(B0, 1, 0); PG8_LDB(B1, 1, 1); PG8_SCHED; PG8_LDA(At, 1, 0); PG8_STAGE(PG8_SA(0, 1), a2 + hstep, voffA);
            PG8_WAIT_V(8); PG8_WAIT_L(0); PG8_BAR; PG8_MMA(0, 0, At, B0); PG8_MMA(0, 1, At, B1); PG8_BAR; PG8_SCHED;
            PG8_LDA(At, 1, 1); PG8_STAGE(PG8_SB(1, 0), b3, voffB); PG8_STAGE(PG8_SB(1, 1), b3 + hstep, voffB); PG8_STAGE(PG8_SA(1, 0), a3, voffA);
            PG8_WAIT_V(8); PG8_WAIT_L(0); PG8_BAR; PG8_MMA(1, 0, At, B0); PG8_MMA(1, 1, At, B1); PG8_BAR; PG8_SCHED;
            } else {
            PG8_LDB(B0, 0, 0); PG8_SCHED; PG8_LDA(At, 0, 0); PG8_STAGE(PG8_SA(1, 1), a1 + hstep, voffA);
            PG8_WAIT_L(8); PG8_BAR; PG8_WAIT_L(0); PG8_MMA(0, 0, At, B0); PG8_BAR; PG8_SCHED;
            PG8_LDB(B1, 0, 1); PG8_STAGE(PG8_SB(0, 0), b2, voffB);
            PG8_BAR; PG8_WAIT_L(0); PG8_MMA(0, 1, At, B1); PG8_BAR;
            PG8_LDA(At, 0, 1); PG8_STAGE(PG8_SA(0, 0), a2, voffA);
            PG8_BAR; PG8_WAIT_L(0); PG8_MMA(1, 0, At, B0); PG8_BAR; PG8_SCHED;
            PG8_STAGE(PG8_SB(0, 1), b2 + hstep, voffB);
            PG8_WAIT_V(6); PG8_BAR; PG8_MMA(1, 1, At, B1); PG8_BAR;
            PG8_LDB(B0, 1, 0); PG8_SCHED; PG8_LDA(At, 1, 0); PG8_STAGE(PG8_SA(0, 1), a2 + hstep, voffA);
            PG8_WAIT_L(8); PG8_BAR; PG8_WAIT_L(0); PG8_MMA(0, 0, At, B0); PG8_BAR; PG8_SCHED;
            PG8_LDB(B1, 1, 1); PG8_STAGE(PG8_SB(1, 0), b3, voffB);
            PG8_BAR; PG8_WAIT_L(0); PG8_MMA(0, 1, At, B1); PG8_BAR;
            PG8_LDA(At, 1, 1); PG8_STAGE(PG8_SA(1, 0), a3, voffA);
            PG8_BAR; PG8_WAIT_L(0); PG8_MMA(1, 0, At, B0); PG8_BAR; PG8_SCHED;
            PG8_STAGE(PG8_SB(1, 1), b3 + hstep, voffB);
            PG8_WAIT_V(6); PG8_BAR; PG8_MMA(1, 1, At, B1); PG8_BAR;
            }
        }
        if constexpr (ALIGN_EPI) { if (wr == 0) PG8_BAR; }
        if constexpr (!Epi::AFTER_DRAIN) { E(acc, cur, wr, wc, fr, fq); S.done(cur); }
        if (!has_next) break;
#pragma unroll
        for (int a = 0; a < 2; ++a)
#pragma unroll
            for (int b = 0; b < 2; ++b)
#pragma unroll
                for (int m = 0; m < 4; ++m)
#pragma unroll
                    for (int n = 0; n < 2; ++n) acc[a][b][m][n] = (f32x4){0.f, 0.f, 0.f, 0.f};
        cur = nxt; cA = nA; cB = nB; ++ui;
        if constexpr (ALIGN_EPI) { if (wr == 1) PG8_BAR; }
    }
    PG8_WAIT_V(0);
    if constexpr (!ALIGN_EPI) { if (wr == 0) PG8_BAR; }
    PG8_BAR;
    if constexpr (Epi::AFTER_DRAIN) { E.fused(acc, cur, wr, wc, fr, fq, lds, wid, lane); S.done(cur); }
#undef PG8_SA
#undef PG8_SB
#undef PG8_STAGE
#undef PG8_LDA
#undef PG8_LDB
#undef PG8_MMA
#undef PG8_WAIT_V
#undef PG8_WAIT_L
#undef PG8_BAR
#undef PG8_SCHED
}
}
#define GAS __attribute__((address_space(1)))
#define LAS __attribute__((address_space(3)))
typedef unsigned short bf16;
typedef unsigned v4u __attribute__((ext_vector_type(4)));
typedef float f32x4 __attribute__((ext_vector_type(4)));
typedef short bf16x8 __attribute__((ext_vector_type(8)));
typedef GAS unsigned gu32;
typedef GAS unsigned long long gu64;
#define RLX_AGENT __ATOMIC_RELAXED, __HIP_MEMORY_SCOPE_AGENT
#define LDS_WAIT() asm volatile("s_waitcnt lgkmcnt(0)" ::: "memory")
#define VM_WAIT() asm volatile("s_waitcnt vmcnt(0)" ::: "memory")
__device__ __forceinline__ unsigned long long rt() { return __builtin_amdgcn_s_memrealtime(); }
__device__ __forceinline__ unsigned f2bf(float f) { unsigned u = __builtin_bit_cast(unsigned, f); return (u + 0x7fffu + ((u >> 16) & 1u)) >> 16; }
__device__ __forceinline__ unsigned pk2(float lo, float hi) { return f2bf(lo) | (f2bf(hi) << 16); }

#define XB_TMO      128
#define XB_XCNT(j)  (256  + 64 * (j))
#define XB_XSUB(j)  (1280 + 64 * (j))
#define XB_XGEN(j)  (2304 + 64 * (j))
#define XB_TOP      3328
#define XB_TOPGEN   3392
#define XCD_BAR_WORDS 3456
#define XB_SPIN_CAP (1u << 18)

__device__ __forceinline__ unsigned xb_ld(unsigned* p)              { return __hip_atomic_load(p, __ATOMIC_RELAXED, __HIP_MEMORY_SCOPE_AGENT); }
__device__ __forceinline__ unsigned xb_add(unsigned* p, unsigned v) { return __hip_atomic_fetch_add(p, v, __ATOMIC_RELAXED, __HIP_MEMORY_SCOPE_AGENT); }
__device__ __forceinline__ unsigned xb_xcc_id() { return (unsigned)__builtin_amdgcn_s_getreg((3 << 11) | 20) & 0xFu; }
#define XB_SPIN(cond, bar) do { unsigned _sp = 0; while (cond) { __builtin_amdgcn_s_sleep(1); \
    if ((++_sp & 255u) == 0u) { if (xb_ld(&(bar)[XB_TMO])) break; if (_sp > XB_SPIN_CAP) { atomicAdd(&(bar)[XB_TMO], 1u); break; } } } } while (0)

struct XcdBarrier {
    unsigned* bar; unsigned x;
    volatile LAS unsigned* st;
};

__device__ __forceinline__ XcdBarrier xcd_barrier_post(unsigned* bar, volatile LAS unsigned* st) {
    XcdBarrier b; b.bar = bar; b.x = xb_xcc_id(); b.st = st;
    if (threadIdx.x == 0) (void)xb_add(&bar[XB_XCNT(b.x)], 1u);
    return b;
}
__device__ __forceinline__ void xcd_barrier_complete(unsigned* bar, unsigned x, unsigned& nloc, unsigned& nx) {
    const unsigned G = gridDim.x * gridDim.y * gridDim.z;
    unsigned sum, cnt, mine, sp = 0u;
    for (;;) {
        sum = 0u; cnt = 0u; mine = 0u;
#pragma unroll
        for (unsigned j = 0; j < 16; ++j) { const unsigned c = xb_ld(&bar[XB_XCNT(j)]); sum += c; cnt += (c > 0u) ? 1u : 0u; mine = (j == x) ? c : mine; }
        if (sum == G) break;
        __builtin_amdgcn_s_sleep(1);
        if ((++sp & 255u) == 0u) { if (xb_ld(&bar[XB_TMO])) break; if (sp > XB_SPIN_CAP) { atomicAdd(&bar[XB_TMO], 1u); break; } }
    }
    nloc = mine > 0u ? mine : 1u; nx = cnt > 0u ? cnt : 1u;
}

__device__ __forceinline__ void xcd_barrier(const XcdBarrier& b) {
    asm volatile("s_waitcnt vmcnt(0)" ::: "memory");
    __syncthreads();
    if (threadIdx.x == 0) {
        unsigned* bar = b.bar;
        __builtin_amdgcn_s_waitcnt(0);
        unsigned nloc = b.st[0], nx = b.st[1];
        if (nloc == 0u) { xcd_barrier_complete(bar, b.x, nloc, nx); b.st[0] = nloc; b.st[1] = nx; }
        const unsigned old = xb_add(&bar[XB_XSUB(b.x)], 1u);
        const unsigned gen = old / nloc;
        if (old + 1u == (gen + 1u) * nloc) {
            __builtin_amdgcn_fence(__ATOMIC_RELEASE, "agent");
            asm volatile("s_waitcnt vmcnt(0)" ::: "memory");
            const unsigned og = xb_add(&bar[XB_TOP], 1u);
            const unsigned tg = og / nx;
            if (og + 1u == (tg + 1u) * nx) xb_add(&bar[XB_TOPGEN], 1u);
            else XB_SPIN(xb_ld(&bar[XB_TOPGEN]) == tg, bar);
            __builtin_amdgcn_fence(__ATOMIC_ACQUIRE, "agent");
            xb_add(&bar[XB_XGEN(b.x)], 1u);
            asm volatile("s_waitcnt vmcnt(0)" ::: "memory");
        } else {
            XB_SPIN(xb_ld(&bar[XB_XGEN(b.x)]) == gen, bar);
            __builtin_amdgcn_fence(__ATOMIC_ACQUIRE, "agent");
            asm volatile("s_waitcnt vmcnt(0)" ::: "memory");
        }
    }
    __syncthreads();
}
constexpr int NWAVES = 8;
constexpr int DM = 1024, TP = 2048, NBP = 8, MP = NBP * TP, NBS = 128, TS = 8, MS = NBS * TS, M = MP + MS, FF = 2816, NG1 = 2 * FF;
constexpr int NIN = 3088, NINP = 3328, NPROJ = 3072, DK = 128, DV = 256, NH = 4;
constexpr float EPS = 1e-6f;
static_assert(M == 68 * 256, "row tiles");
constexpr size_t O_YP = 0, O_YS = (size_t)MP * DM, O_NPP = O_YS + (size_t)MS * DM, O_NGP = O_NPP + (size_t)2 * NBP * 15 * DM, O_NPS = O_NGP + (size_t)2 * NBP * NH * DK * DV,
                 O_NGS = O_NPS + (size_t)2 * NBS * 15 * DM, O_END = O_NGS + (size_t)2 * NBS * NH * DK * DV;
constexpr size_t MiB = 1u << 20;
constexpr size_t WS_CTL = 0, CTL_ZERO_BYTES = 1 * MiB;
constexpr size_t SZ_W13 = (size_t)NG1 * DM * 2, SZ_W2 = (size_t)DM * FF * 2, SZ_WIN = (size_t)NINP * DM * 2, SZ_WO = (size_t)DM * DM * 2, SZ_WP = (size_t)4 * 256 * 256 * 2;
constexpr size_t WS_W13 = 1 * MiB, WS_W2 = WS_W13 + 4 * SZ_W13, WS_WIN = WS_W2 + 4 * SZ_W2, WS_WO = WS_WIN + 2 * SZ_WIN, WS_WP = WS_WO + 2 * SZ_WO;
constexpr size_t WS_H = WS_WP + 2 * SZ_WP;
constexpr size_t WS_BIG = WS_H + (size_t)M * DM * 2;
constexpr size_t WS_ALOW = WS_BIG + (size_t)M * NPROJ * 2;
constexpr size_t WS_DS = WS_ALOW + (size_t)M * 16 * 4;
constexpr size_t WS_DSC = WS_DS + (size_t)32 * 7 * DK * DV * 4;
constexpr size_t WS_END = WS_DSC + (size_t)32 * 7 * DK * 4;
static_assert(WS_END <= 256 * MiB, "d_ws map");
static_assert(WS_H % 256 == 0 && WS_BIG % 256 == 0 && WS_ALOW % 256 == 0 && WS_DS % 256 == 0 && WS_DSC % 256 == 0, "alignment");
constexpr int CW_BAR = 4096;
constexpr int RING_BYTES = 131072, LDSCTL_OFF = RING_BYTES, MISC_OFF = LDSCTL_OFF + 320, LDS_BYTES = 147456;

__device__ __forceinline__ float wave_sum(float v) {
#pragma unroll
    for (int o = 1; o < 64; o <<= 1) v += __shfl_xor(v, o);
    return v;
}
__device__ __forceinline__ float bf2f(unsigned short b) { return __builtin_bit_cast(float, (unsigned)b << 16); }

__device__ __forceinline__ void tr_item(const float* W, int K, int N, bf16* WT, int mode, int row_off, LAS float* scr, int item, int lane) {
    const int nblk = (N + 31) >> 5, kb = item / nblk, nb = item - kb * nblk, k0 = 64 * kb, n0 = 32 * nb;
    const int nn = n0 + (lane & 31); const bool ok = nn < N;
    float wv[32];
#pragma unroll
    for (int i = 0; i < 32; ++i) { const int kk = 2 * i + (lane >> 5); wv[i] = ok ? W[(size_t)(k0 + kk) * N + nn] : 0.f; }
#pragma unroll
    for (int i = 0; i < 32; ++i) { const int kk = 2 * i + (lane >> 5); scr[kk * 33 + (lane & 31)] = wv[i]; }
    LDS_WAIT(); asm volatile("" ::: "memory");
    const int c = lane & 7;
#pragma unroll
    for (int j = 0; j < 4; ++j) { const int n = (lane >> 3) + 8 * j; const LAS float* s = scr + (8 * c) * 33 + n;
        v4u o; o.x = pk2(s[0 * 33], s[1 * 33]); o.y = pk2(s[2 * 33], s[3 * 33]); o.z = pk2(s[4 * 33], s[5 * 33]); o.w = pk2(s[6 * 33], s[7 * 33]);
        const int ng = n0 + n; const int row = mode ? (((ng >> 7) << 8) + (ng & 127) + row_off) : (row_off + ng);
        *(v4u*)(WT + (size_t)row * K + k0 + 8 * c) = o; }
    LDS_WAIT(); asm volatile("" ::: "memory");
}
__device__ __forceinline__ void p0_weights(LAS unsigned char* lds, int wave, int lane, int gw, int NGW, const float* const* in, unsigned char* ws) {
    LAS float* scr = (LAS float*)(lds + wave * 16384);
    constexpr int I_W1 = (DM / 64) * (FF / 32), I_W2 = (FF / 64) * (DM / 32), I_WIN = (DM / 64) * ((NIN + 31) / 32), I_WO = (DM / 64) * (DM / 32), I_WP = (256 / 64) * (256 / 32);
    constexpr int N_FFN = 4 * (2 * I_W1 + I_W2), N_GLA = 2 * (I_WIN + I_WO), N_POOL = 8 * I_WP, NITEMS = N_FFN + N_GLA + N_POOL;
    for (int it = gw; it < NITEMS; it += NGW) {
        int r = it;
        if (r < N_FFN) { const int L = r / (2 * I_W1 + I_W2); r -= L * (2 * I_W1 + I_W2);
            if (r < I_W1) { tr_item(in[14] + (size_t)L * DM * FF, DM, FF, (bf16*)(ws + WS_W13 + L * SZ_W13), 1, 0, scr, r, lane); continue; } r -= I_W1;
            if (r < I_W1) { tr_item(in[15] + (size_t)L * DM * FF, DM, FF, (bf16*)(ws + WS_W13 + L * SZ_W13), 1, 128, scr, r, lane); continue; } r -= I_W1;
            tr_item(in[16] + (size_t)L * FF * DM, FF, DM, (bf16*)(ws + WS_W2 + L * SZ_W2), 0, 0, scr, r, lane); continue; }
        r -= N_FFN;
        if (r < N_GLA) { const int L = r / (I_WIN + I_WO); r -= L * (I_WIN + I_WO);
            if (r < I_WIN) { tr_item(in[9] + (size_t)L * DM * NIN, DM, NIN, (bf16*)(ws + WS_WIN + L * SZ_WIN), 0, 0, scr, r, lane); continue; } r -= I_WIN;
            tr_item(in[13] + (size_t)L * DM * DM, DM, DM, (bf16*)(ws + WS_WO + L * SZ_WO), 0, 0, scr, r, lane); continue; }
        r -= N_GLA;
        { const int jg = r / I_WP; r -= jg * I_WP;
          tr_item(in[7] + (size_t)jg * 65536, 256, 256, (bf16*)(ws + WS_WP + (jg >> 2) * SZ_WP), 0, (jg & 3) * 256, scr, r, lane); }
    }
    constexpr int PADV = (NINP - 3104) * DM * 2 / 16;
    for (int i = gw * 64 + lane; i < 2 * PADV; i += NGW * 64) { const int L = i / PADV, e = i - L * PADV;
        ((v4u*)(ws + WS_WIN + L * SZ_WIN + (size_t)3104 * DM * 2))[e] = (v4u){0u, 0u, 0u, 0u}; }
}

__device__ __forceinline__ void rms_row_bf16(const float* xrow, const float* g, bf16* orow, int lane) {
    const f32x4* xr = (const f32x4*)xrow + lane; const f32x4* gr = (const f32x4*)g + lane;
    f32x4 v[4]; float s = 0.f;
#pragma unroll
    for (int j = 0; j < 4; ++j) { v[j] = xr[64 * j]; s += (v[j].x * v[j].x + v[j].y * v[j].y) + (v[j].z * v[j].z + v[j].w * v[j].w); }
    const float rstd = rsqrtf(wave_sum(s) * (1.f / DM) + EPS);
    unsigned long long* o8 = (unsigned long long*)orow + lane;
#pragma unroll
    for (int j = 0; j < 4; ++j) { const f32x4 gg = gr[64 * j]; const f32x4 y = v[j] * rstd * gg;
        o8[64 * j] = (unsigned long long)pk2(y.x, y.y) | ((unsigned long long)pk2(y.z, y.w) << 32); }
}
__device__ __forceinline__ void rms_phase(int gw, int NGW, int lane, const float* X, const float* g, bf16* H) {
    for (int m = gw; m < M; m += NGW) rms_row_bf16(X + (size_t)m * DM, g, H + (size_t)m * DM, lane);
}
__device__ __forceinline__ void final_norm_phase(int gw, int NGW, int lane, float* X, const float* g) {
    for (int m = gw; m < M; m += NGW) {
        f32x4* xr = (f32x4*)(X + (size_t)m * DM) + lane; const f32x4* gr = (const f32x4*)g + lane;
        f32x4 v[4]; float s = 0.f;
#pragma unroll
        for (int j = 0; j < 4; ++j) { v[j] = xr[64 * j]; s += (v[j].x * v[j].x + v[j].y * v[j].y) + (v[j].z * v[j].z + v[j].w * v[j].w); }
        const float rstd = rsqrtf(wave_sum(s) * (1.f / DM) + EPS);
#pragma unroll
        for (int j = 0; j < 4; ++j) xr[64 * j] = v[j] * rstd * gr[64 * j];
    }
}

__device__ __forceinline__ void small_gemm_res(LAS unsigned char* lds, const bf16* A, const bf16* Bt, int K, float* X, int tid, int wave, int G, int bid) {
    constexpr int RS = 272, BUF = 2 * 64 * RS;
    const int lane = tid & 63, fr = lane & 15, fq = lane >> 4, rt = wave & 3, ch = wave >> 2;
    const int lr = tid >> 3, lc = (tid & 7) * 16;
    const int nch = K >> 7;
    for (int L = bid; L < 256; L += G) {
        const int tm = L >> 4, tn = L & 15;
        const v4u* ag = (const v4u*)(A + (size_t)(tm * 64 + lr) * K + lc); const v4u* bg = (const v4u*)(Bt + (size_t)(tn * 64 + lr) * K + lc);
        LAS unsigned char* wa = lds + lr * RS + lc * 2; LAS unsigned char* wb = wa + 64 * RS;
        v4u pa[2], pb[2], qa[2], qb[2];
        { const v4u a0 = ag[0], a1 = ag[1], b0 = bg[0], b1 = bg[1];
          pa[0] = ag[16]; pa[1] = ag[17]; pb[0] = bg[16]; pb[1] = bg[17];
          qa[0] = ag[32]; qa[1] = ag[33]; qb[0] = bg[32]; qb[1] = bg[33];
          *(LAS v4u*)wa = a0; *(LAS v4u*)(wa + 16) = a1; *(LAS v4u*)wb = b0; *(LAS v4u*)(wb + 16) = b1; }
        __syncthreads();
        f32x4 acc0 = (f32x4){0.f, 0.f, 0.f, 0.f}, acc1 = (f32x4){0.f, 0.f, 0.f, 0.f};
#define SG_COMPUTE(bufoff) { _Pragma("unroll") for (int ks = 0; ks < 4; ++ks) { const bf16x8 a = *(const LAS bf16x8*)(lds + (bufoff) + (16 * rt + fr) * RS + (32 * ks + 8 * fq) * 2); \
            const bf16x8 b0 = *(const LAS bf16x8*)(lds + (bufoff) + 64 * RS + (32 * ch + fr) * RS + (32 * ks + 8 * fq) * 2), b1 = *(const LAS bf16x8*)(lds + (bufoff) + 64 * RS + (32 * ch + 16 + fr) * RS + (32 * ks + 8 * fq) * 2); \
            acc0 = __builtin_amdgcn_mfma_f32_16x16x32_bf16(b0, a, acc0, 0, 0, 0); acc1 = __builtin_amdgcn_mfma_f32_16x16x32_bf16(b1, a, acc1, 0, 0, 0); } }
        for (int kc = 0; kc < nch; kc += 2) {
            SG_COMPUTE(0)
            *(LAS v4u*)(wa + BUF) = pa[0]; *(LAS v4u*)(wa + BUF + 16) = pa[1]; *(LAS v4u*)(wb + BUF) = pb[0]; *(LAS v4u*)(wb + BUF + 16) = pb[1];
            if (kc + 3 < nch) { pa[0] = ag[16 * (kc + 3)]; pa[1] = ag[16 * (kc + 3) + 1]; pb[0] = bg[16 * (kc + 3)]; pb[1] = bg[16 * (kc + 3) + 1]; }
            __syncthreads();
            SG_COMPUTE(BUF)
            if (kc + 2 < nch) { *(LAS v4u*)wa = qa[0]; *(LAS v4u*)(wa + 16) = qa[1]; *(LAS v4u*)wb = qb[0]; *(LAS v4u*)(wb + 16) = qb[1]; }
            if (kc + 4 < nch) { qa[0] = ag[16 * (kc + 4)]; qa[1] = ag[16 * (kc + 4) + 1]; qb[0] = bg[16 * (kc + 4)]; qb[1] = bg[16 * (kc + 4) + 1]; }
            __syncthreads();
        }
#undef SG_COMPUTE
        float* o = X + (size_t)(tm * 64 + 16 * rt + fr) * DM + tn * 64 + 32 * ch + 4 * fq;
        *(f32x4*)o = *(const f32x4*)o + acc0; *(f32x4*)(o + 16) = *(const f32x4*)(o + 16) + acc1;
    }
    __syncthreads();
}

__device__ __forceinline__ void small_gemm_pool(LAS unsigned char* lds, const bf16* DIFF, const bf16* Wp, const float* base_s, float* Xs, const float* scale, int tid, int wave, int G, int bid) {
    constexpr int RS = 272, BUF = 2 * 64 * RS;
    const int lane = tid & 63, fr = lane & 15, fq = lane >> 4, rt = wave & 3, ch = wave >> 2;
    const int lr = tid >> 3, lc = (tid & 7) * 16;
    for (int L = bid; L < 256; L += G) {
        const int tm = L >> 4, tn = L & 15, g = tn >> 2, cb = (tn & 3) * 64;
        const v4u* ag = (const v4u*)(DIFF + ((size_t)g * M + MP + tm * 64 + lr) * 256 + lc); const v4u* bg = (const v4u*)(Wp + ((size_t)g * 256 + cb + lr) * 256 + lc);
        const v4u a0 = ag[0], a1 = ag[1], a2 = ag[16], a3 = ag[17], b0 = bg[0], b1 = bg[1], b2 = bg[16], b3 = bg[17];
        LAS unsigned char* wa = lds + lr * RS + lc * 2; LAS unsigned char* wb = wa + 64 * RS;
        *(LAS v4u*)wa = a0; *(LAS v4u*)(wa + 16) = a1; *(LAS v4u*)wb = b0; *(LAS v4u*)(wb + 16) = b1;
        *(LAS v4u*)(wa + BUF) = a2; *(LAS v4u*)(wa + BUF + 16) = a3; *(LAS v4u*)(wb + BUF) = b2; *(LAS v4u*)(wb + BUF + 16) = b3;
        __syncthreads();
        f32x4 acc0 = (f32x4){0.f, 0.f, 0.f, 0.f}, acc1 = (f32x4){0.f, 0.f, 0.f, 0.f};
#pragma unroll
        for (int kk = 0; kk < 8; ++kk) { const int bufoff = (kk >> 2) * BUF, ks = kk & 3;
            const bf16x8 a = *(const LAS bf16x8*)(lds + bufoff + (16 * rt + fr) * RS + (32 * ks + 8 * fq) * 2);
            const bf16x8 w0 = *(const LAS bf16x8*)(lds + bufoff + 64 * RS + (32 * ch + fr) * RS + (32 * ks + 8 * fq) * 2), w1 = *(const LAS bf16x8*)(lds + bufoff + 64 * RS + (32 * ch + 16 + fr) * RS + (32 * ks + 8 * fq) * 2);
            acc0 = __builtin_amdgcn_mfma_f32_16x16x32_bf16(w0, a, acc0, 0, 0, 0); acc1 = __builtin_amdgcn_mfma_f32_16x16x32_bf16(w1, a, acc1, 0, 0, 0); }
        const int col = g * 256 + cb + 32 * ch + 4 * fq; const size_t ro = (size_t)(tm * 64 + 16 * rt + fr) * DM + col;
        const f32x4 x0 = *(const f32x4*)(base_s + ro) + acc0 * *(const f32x4*)(scale + col), x1 = *(const f32x4*)(base_s + ro + 16) + acc1 * *(const f32x4*)(scale + col + 16);
        *(f32x4*)(Xs + ro) = x0; *(f32x4*)(Xs + ro + 16) = x1;
        __syncthreads();
    }
}

__device__ __forceinline__ void pool_prep(LAS unsigned char* lds, int tid, int wave, int lane, int G, int bid,
                                          const float* xp, const float* xs, const float* gmix, const float* spool, bf16* DIFF, float* onp, float* ons) {
    typedef float f32x2 __attribute__((ext_vector_type(2)));
    LAS float* hb = (LAS float*)lds;
    for (int u = bid; u < 1024 + NBS; u += G) {
        const bool pr = u < 1024; const int b = pr ? (u >> 7) : (u - 1024); const int t0 = pr ? (u & 127) * 16 : 0; const int ntok = pr ? 16 : 8;
        {
            f32x4 v[4][4]; bool has[4], donorm[4];
#pragma unroll
            for (int k = 0; k < 4; ++k) { const int r = wave + 8 * k; const float* src = nullptr; donorm[k] = true;
                if (r < 15 + ntok) {
                    if (pr) { const int t = t0 - 15 + r; if (t >= 0) src = xp + ((size_t)b * TP + t) * DM; }
                    else { if (r < 15) { src = spool + ((size_t)b * 15 + r) * DM; donorm[k] = false; } else src = xs + ((size_t)b * TS + (r - 15)) * DM; } }
                has[k] = src != nullptr;
#pragma unroll
                for (int j = 0; j < 4; ++j) v[k][j] = has[k] ? ((const f32x4*)src + lane)[64 * j] : (f32x4){0.f, 0.f, 0.f, 0.f}; }
            const f32x4* gr = (const f32x4*)gmix + lane;
#pragma unroll
            for (int k = 0; k < 4; ++k) { const int r = wave + 8 * k;
                if (r < 15 + ntok) { float s = 0.f;
#pragma unroll
                    for (int j = 0; j < 4; ++j) s += (v[k][j].x * v[k][j].x + v[k][j].y * v[k][j].y) + (v[k][j].z * v[k][j].z + v[k][j].w * v[k][j].w);
                    const float rstd = (has[k] && donorm[k]) ? rsqrtf(wave_sum(s) * (1.f / DM) + EPS) : 1.f;
                    LAS f32x4* hrow = (LAS f32x4*)(hb + r * DM) + lane;
#pragma unroll
                    for (int j = 0; j < 4; ++j) hrow[64 * j] = (has[k] && donorm[k]) ? v[k][j] * rstd * gr[64 * j] : v[k][j]; } }
        }
        __syncthreads();
        const int c = 2 * tid, gi = tid >> 7, w = 2 << gi;
        f32x2 sum = (f32x2){0.f, 0.f};
        for (int l = 1; l < w; ++l) sum += *(const LAS f32x2*)(hb + (15 - l) * DM + c);
        for (int i = 0; i < ntok; ++i) {
            const f32x2 cur = *(const LAS f32x2*)(hb + (15 + i) * DM + c); sum += cur;
            const int cnt = pr ? ((t0 + i + 1) < w ? (t0 + i + 1) : w) : w; const float inv = 1.0f / (float)cnt;
            const f32x2 d = sum * inv - cur;
            const size_t row = pr ? ((size_t)b * TP + t0 + i) : ((size_t)MP + b * TS + i);
            *(unsigned*)(DIFF + ((size_t)gi * M + row) * 256 + (c & 255)) = pk2(d.x, d.y);
            sum -= *(const LAS f32x2*)(hb + (15 + i - w + 1) * DM + c);
        }
        if (pr) { if (t0 == TP - 16) for (int i = 1; i < 16; ++i) *(f32x2*)(onp + ((size_t)b * 15 + (i - 1)) * DM + c) = *(const LAS f32x2*)(hb + (15 + i) * DM + c); }
        else for (int i = 0; i < 15; ++i) *(f32x2*)(ons + ((size_t)b * 15 + i) * DM + c) = *(const LAS f32x2*)(hb + (8 + i) * DM + c);
        __syncthreads();
    }
}

constexpr int L_QH = 0, L_KH = 17408, L_KT = 34816, L_VT = 53248, L_AL = 90112, L_ALOW = 99328, L_DL = 105472, L_SSQ = 105984, L_TOT = 108032, L_WA = 112128, L_BA = 120320, L_NW = 120832, L_GLA_END = 121856;
constexpr int QS = 272, TSB = 144;
static_assert(L_GLA_END <= RING_BYTES, "GLA LDS");
__device__ __forceinline__ bf16x8 pack8(const f32x4 a, const f32x4 b) {
    v4u w; w.x = pg8::cvt_pk_bf16(a[0], a[1]); w.y = pg8::cvt_pk_bf16(a[2], a[3]); w.z = pg8::cvt_pk_bf16(b[0], b[1]); w.w = pg8::cvt_pk_bf16(b[2], b[3]);
    return __builtin_bit_cast(bf16x8, w);
}
__device__ __forceinline__ void gla_phase(LAS unsigned char* lds, int tid, int wave, int lane, int G, int bid, int phase, int jl,
                                          const float* const* in, float* out, unsigned char* ws) {
    typedef unsigned u32x2 __attribute__((ext_vector_type(2)));
    const bf16* PROJ = (const bf16*)(ws + WS_BIG); const float* ALOW = (const float*)(ws + WS_ALOW); bf16* GOUT = (bf16*)(ws + WS_H);
    float* DS = (float*)(ws + WS_DS); float* DSC = (float*)(ws + WS_DSC);
    const int nitems = phase == 0 ? (224 + 4 * NBS) : 256;
    const int tid_in = tid;
    for (int item = bid; item < nitems; item += G) {
        int tid = tid_in; asm volatile("" : "+v"(tid));
        int lane = tid & 63, fr = lane & 15, fq = lane >> 4;
        int b, h, row0, ntok, sc = 0; bool want_out, samp = false;
        if (phase == 0) { if (item < 224) { const int bh = item / 7; sc = item - bh * 7; b = bh >> 2; h = bh & 3; row0 = b * TP + sc * 256; ntok = 256; want_out = false; }
                          else { const int q = item - 224; b = q >> 2; h = q & 3; row0 = MP + b * TS; ntok = TS; want_out = true; samp = true; } }
        else { const int bh = item >> 3; sc = item & 7; b = bh >> 2; h = bh & 3; row0 = b * TP + sc * 256; ntok = 256; want_out = true; }
        const int bh = b * 4 + h;
        f32x4 S[8][2];
#pragma unroll
        for (int dt = 0; dt < 8; ++dt)
#pragma unroll
            for (int vt = 0; vt < 2; ++vt) S[dt][vt] = (f32x4){0.f, 0.f, 0.f, 0.f};
        if (samp) {
            const float* s0 = in[3] + ((size_t)(jl * NBS + b) * NH + h) * DK * DV;
#pragma unroll
            for (int dt = 0; dt < 8; ++dt)
#pragma unroll
                for (int vt = 0; vt < 2; ++vt)
#pragma unroll
                    for (int e = 0; e < 4; ++e) S[dt][vt][e] = s0[(size_t)(16 * dt + 4 * fq + e) * DV + 32 * wave + 16 * vt + fr];
        } else if (phase == 1 && sc > 0) {
            const float* dsp = DS + (size_t)(bh * 7 + sc - 1) * DK * DV;
#pragma unroll
            for (int dt = 0; dt < 8; ++dt)
#pragma unroll
                for (int vt = 0; vt < 2; ++vt) S[dt][vt] = *(const f32x4*)(dsp + (size_t)(((wave * 8 + dt) * 2 + vt) * 64 + lane) * 4);
        }
        { const int r = tid >> 5, d4 = (tid & 31) * 4;
          *(LAS f32x4*)(lds + L_WA + (r * 128 + d4) * 4) = *(const f32x4*)(in[10] + (size_t)jl * 16 * 512 + r * 512 + h * DK + d4) * 1.4426950408889634f;
          if (tid < 32) *(LAS f32x4*)(lds + L_BA + tid * 16) = *(const f32x4*)(in[11] + jl * 512 + h * DK + tid * 4) * 1.4426950408889634f;
          if (tid < 64) *(LAS f32x4*)(lds + L_NW + tid * 16) = *(const f32x4*)(in[12] + jl * DM + h * DV + tid * 4); }
        float btot0 = 0.f, btot1 = 0.f;
        const int nsub = (ntok + 63) >> 6;
        unsigned qn[8], kn[8]; v4u vn[4]; f32x4 aln;
#define GLA_LOAD(sbx) { const int tokv_ = (ntok - 64 * (sbx)) < 64 ? (ntok - 64 * (sbx)) : 64; const int rb_ = row0 + 64 * (sbx); const int dp_ = tid & 63, jp_ = tid & 31, vg_ = tid >> 5; \
            _Pragma("unroll") for (int i = 0; i < 8; ++i) { const int tok = 8 * wave + i; qn[i] = 0u; kn[i] = 0u; \
                if (tok < tokv_) { const unsigned* pr = (const unsigned*)(PROJ + (size_t)(rb_ + tok) * NPROJ + h * DK) + dp_; qn[i] = pr[0]; kn[i] = pr[256]; } } \
            _Pragma("unroll") for (int i = 0; i < 2; ++i) { const int tok = 2 * jp_ + i; vn[2 * i] = (v4u){0u, 0u, 0u, 0u}; vn[2 * i + 1] = (v4u){0u, 0u, 0u, 0u}; \
                if (tok < tokv_) { const v4u* pv = (const v4u*)(PROJ + (size_t)(rb_ + tok) * NPROJ + 1024 + h * DV + 16 * vg_); vn[2 * i] = pv[0]; vn[2 * i + 1] = pv[1]; } } \
            aln = (f32x4){0.f, 0.f, 0.f, 0.f}; if (tid < 256) { const int tok = tid >> 2; if (tok < tokv_) aln = *(const f32x4*)(ALOW + (size_t)(rb_ + tok) * 16 + 4 * (tid & 3)); } }
        GLA_LOAD(0)
        for (int sb = 0; sb < nsub; ++sb) {
            typedef float f32x2 __attribute__((ext_vector_type(2)));
            const int tokv = (ntok - 64 * sb) < 64 ? (ntok - 64 * sb) : 64; const int rbase = row0 + 64 * sb;
            asm volatile("" : "+v"(tid)); lane = tid & 63; fr = lane & 15; fq = lane >> 4;
            const int dp = tid & 63, jp = tid & 31, vg = tid >> 5;
            if (tid < 256) *(LAS f32x4*)(lds + L_ALOW + (tid >> 2) * 64 + 16 * (tid & 3)) = aln;
            __syncthreads();
            f32x2 bj[8];
            { f32x2 x[8]; const f32x2 bav = *(const LAS f32x2*)(lds + L_BA + dp * 8);
#pragma unroll
              for (int i = 0; i < 8; ++i) x[i] = bav;
#pragma unroll
              for (int r4 = 0; r4 < 4; ++r4) { const f32x2 w0 = *(const LAS f32x2*)(lds + L_WA + ((4 * r4 + 0) * 128 + 2 * dp) * 4), w1 = *(const LAS f32x2*)(lds + L_WA + ((4 * r4 + 1) * 128 + 2 * dp) * 4),
                                                            w2 = *(const LAS f32x2*)(lds + L_WA + ((4 * r4 + 2) * 128 + 2 * dp) * 4), w3 = *(const LAS f32x2*)(lds + L_WA + ((4 * r4 + 3) * 128 + 2 * dp) * 4);
                  f32x4 al[8];
#pragma unroll
                  for (int i = 0; i < 8; ++i) al[i] = *(const LAS f32x4*)(lds + L_ALOW + (8 * wave + i) * 64 + 16 * r4);
#pragma unroll
                  for (int i = 0; i < 8; ++i) x[i] = w0 * al[i][0] + x[i];
#pragma unroll
                  for (int i = 0; i < 8; ++i) x[i] = w1 * al[i][1] + x[i];
#pragma unroll
                  for (int i = 0; i < 8; ++i) x[i] = w2 * al[i][2] + x[i];
#pragma unroll
                  for (int i = 0; i < 8; ++i) x[i] = w3 * al[i][3] + x[i]; }
              f32x2 run = (f32x2){0.f, 0.f};
#pragma unroll
              for (int i = 0; i < 8; ++i) { f32x2 g;
                  g.x = (fminf(x[i].x, 0.f) - __builtin_amdgcn_logf(1.0f + __builtin_amdgcn_exp2f(-fabsf(x[i].x)))) * (1.0f / 16.0f); g.y = (fminf(x[i].y, 0.f) - __builtin_amdgcn_logf(1.0f + __builtin_amdgcn_exp2f(-fabsf(x[i].y)))) * (1.0f / 16.0f);
                  if (tokv < 64 && 8 * wave + i >= tokv) g = (f32x2){0.f, 0.f};
                  run += g; bj[i] = run; }
              *(LAS f32x2*)(lds + L_TOT + (wave * 128 + 2 * dp) * 4) = run; }
            __syncthreads();
            f32x2 pre = (f32x2){0.f, 0.f}, blast = (f32x2){0.f, 0.f};
#pragma unroll
            for (int q = 0; q < 8; ++q) { const f32x2 t = *(const LAS f32x2*)(lds + L_TOT + (q * 128 + 2 * dp) * 4); blast += t; if (q < wave) pre += t; }
            btot0 += blast.x; btot1 += blast.y;
            if (wave == 0) *(LAS f32x2*)(lds + L_DL + dp * 8) = (f32x2){__builtin_amdgcn_exp2f(blast.x), __builtin_amdgcn_exp2f(blast.y)};
            { unsigned kb[8];
#pragma unroll
              for (int i = 0; i < 8; ++i) { const int tok = 8 * wave + i; const f32x2 bb = bj[i] + pre;
                  const float e1x = __builtin_amdgcn_exp2f(blast.x - bb.x), e1y = __builtin_amdgcn_exp2f(blast.y - bb.y), e2x = __builtin_amdgcn_exp2f(bb.x - blast.x), e2y = __builtin_amdgcn_exp2f(bb.y - blast.y);
                  const unsigned qh = pg8::cvt_pk_bf16(bf2f((unsigned short)(qn[i] & 0xffffu)) * e2x, bf2f((unsigned short)(qn[i] >> 16)) * e2y);
                  const unsigned kh = pg8::cvt_pk_bf16(bf2f((unsigned short)(kn[i] & 0xffffu)) * e1x, bf2f((unsigned short)(kn[i] >> 16)) * e1y);
                  *(LAS unsigned*)(lds + L_QH + tok * QS + dp * 4) = qh; *(LAS unsigned*)(lds + L_KH + tok * QS + dp * 4) = kh; kb[i] = kh; }
              v4u k0, k1;
              k0.x = (kb[0] & 0xffffu) | (kb[1] << 16); k0.y = (kb[2] & 0xffffu) | (kb[3] << 16); k0.z = (kb[4] & 0xffffu) | (kb[5] << 16); k0.w = (kb[6] & 0xffffu) | (kb[7] << 16);
              k1.x = (kb[0] >> 16) | (kb[1] & 0xffff0000u); k1.y = (kb[2] >> 16) | (kb[3] & 0xffff0000u); k1.z = (kb[4] >> 16) | (kb[5] & 0xffff0000u); k1.w = (kb[6] >> 16) | (kb[7] & 0xffff0000u);
              *(LAS v4u*)(lds + L_KT + (2 * dp) * TSB + wave * 16) = k0; *(LAS v4u*)(lds + L_KT + (2 * dp + 1) * TSB + wave * 16) = k1; }
            {
#pragma unroll
              for (int hv = 0; hv < 2; ++hv) { const unsigned a4[4] = {vn[hv].x, vn[hv].y, vn[hv].z, vn[hv].w}, b4[4] = {vn[2 + hv].x, vn[2 + hv].y, vn[2 + hv].z, vn[2 + hv].w};
#pragma unroll
                  for (int k = 0; k < 4; ++k) { LAS unsigned char* p = lds + L_VT + (16 * vg + 8 * hv + 2 * k) * TSB + jp * 4;
                      *(LAS unsigned*)p = (a4[k] & 0xffffu) | (b4[k] << 16); *(LAS unsigned*)(p + TSB) = (a4[k] >> 16) | (b4[k] & 0xffff0000u); } } }
            __syncthreads();
            u32x2 rcur[4][2];
            if (want_out) {
#pragma unroll
                for (int it = 0; it < 4; ++it)
#pragma unroll
                    for (int vt = 0; vt < 2; ++vt) { rcur[it][vt] = (u32x2){0u, 0u};
                        if (16 * it + fr < tokv) rcur[it][vt] = *(const u32x2*)(PROJ + (size_t)(rbase + 16 * it + fr) * NPROJ + 2048 + h * DV + 32 * wave + 16 * vt + 4 * fq); } }
            if (sb + 1 < nsub) GLA_LOAD(sb + 1)
#pragma unroll
            for (int dt = 0; dt < 8; ++dt) { const f32x4 dv = *(const LAS f32x4*)(lds + L_DL + (16 * dt + 4 * fq) * 4); S[dt][0] = S[dt][0] * dv; S[dt][1] = S[dt][1] * dv; }
            if (want_out) {
                f32x4 O[2][4];
#pragma unroll
                for (int tt = 0; tt < 2; ++tt) { const int idx = 2 * wave + tt, it = idx >> 2, jt = idx & 3; f32x4 a = (f32x4){0.f, 0.f, 0.f, 0.f};
                    if (jt <= it) {
#pragma unroll
                        for (int ks = 0; ks < 4; ++ks) { const bf16x8 X = *(const LAS bf16x8*)(lds + L_KH + (16 * jt + fr) * QS + (32 * ks + 8 * fq) * 2);
                            const bf16x8 Y = *(const LAS bf16x8*)(lds + L_QH + (16 * it + fr) * QS + (32 * ks + 8 * fq) * 2);
                            a = __builtin_amdgcn_mfma_f32_16x16x32_bf16(X, Y, a, 0, 0, 0); }
                        const int ii = 16 * it + fr, j0 = 16 * jt + 4 * fq;
#pragma unroll
                        for (int e = 0; e < 4; ++e) if (j0 + e > ii) a[e] = 0.f;
                    }
                    u32x2 w2; w2.x = pg8::cvt_pk_bf16(a[0], a[1]); w2.y = pg8::cvt_pk_bf16(a[2], a[3]);
                    *(LAS u32x2*)(lds + L_AL + (16 * it + fr) * TSB + (16 * jt + 4 * fq) * 2) = w2; }
                __syncthreads();
                {
                bf16x8 Xs[2][4];
#pragma unroll
                for (int vt = 0; vt < 2; ++vt)
#pragma unroll
                    for (int dp = 0; dp < 4; ++dp) Xs[vt][dp] = pack8(S[2 * dp][vt], S[2 * dp + 1][vt]);
                bf16x8 XV[2][2];
#pragma unroll
                for (int vt = 0; vt < 2; ++vt)
#pragma unroll
                    for (int js = 0; js < 2; ++js) XV[vt][js] = *(const LAS bf16x8*)(lds + L_VT + (32 * wave + 16 * vt + fr) * TSB + (32 * js + 8 * fq) * 2);
#pragma unroll
                for (int it = 0; it < 4; ++it) {
                    bf16x8 YQ[4], YA[2];
#pragma unroll
                    for (int dp = 0; dp < 4; ++dp) { const u32x2 lo = *(const LAS u32x2*)(lds + L_QH + (16 * it + fr) * QS + (32 * dp + 4 * fq) * 2);
                        const u32x2 hi = *(const LAS u32x2*)(lds + L_QH + (16 * it + fr) * QS + (32 * dp + 16 + 4 * fq) * 2);
                        YQ[dp] = __builtin_bit_cast(bf16x8, (v4u){lo.x, lo.y, hi.x, hi.y}); }
#pragma unroll
                    for (int js = 0; js < 2; ++js) YA[js] = *(const LAS bf16x8*)(lds + L_AL + (16 * it + fr) * TSB + (32 * js + 8 * fq) * 2);
                    { f32x4 o0 = (f32x4){0.f, 0.f, 0.f, 0.f}, o1 = (f32x4){0.f, 0.f, 0.f, 0.f};
#pragma unroll
                      for (int dp = 0; dp < 4; ++dp) { o0 = __builtin_amdgcn_mfma_f32_16x16x32_bf16(Xs[0][dp], YQ[dp], o0, 0, 0, 0); o1 = __builtin_amdgcn_mfma_f32_16x16x32_bf16(Xs[1][dp], YQ[dp], o1, 0, 0, 0); }
#pragma unroll
                      for (int js = 0; js < 2; ++js) { o0 = __builtin_amdgcn_mfma_f32_16x16x32_bf16(XV[0][js], YA[js], o0, 0, 0, 0); o1 = __builtin_amdgcn_mfma_f32_16x16x32_bf16(XV[1][js], YA[js], o1, 0, 0, 0); }
                      O[0][it] = o0; O[1][it] = o1; }
                    __builtin_amdgcn_sched_barrier(0);
                }
                }
#pragma unroll
                for (int it = 0; it < 4; ++it) { float ss = 0.f;
#pragma unroll
                    for (int vt = 0; vt < 2; ++vt) { const f32x4 o = O[vt][it]; ss += (o[0] * o[0] + o[1] * o[1]) + (o[2] * o[2] + o[3] * o[3]); }
                    ss += __shfl_xor(ss, 16); ss += __shfl_xor(ss, 32);
                    if (fq == 0) *(LAS float*)(lds + L_SSQ + (wave * 64 + 16 * it + fr) * 4) = ss; }
                __syncthreads();
#pragma unroll
                for (int it = 0; it < 4; ++it) { const int tok = 16 * it + fr; float tot = 0.f;
#pragma unroll
                    for (int w8 = 0; w8 < 8; ++w8) tot += *(const LAS float*)(lds + L_SSQ + (w8 * 64 + tok) * 4);
                    const float rstd = rsqrtf(tot * (1.0f / DV) + EPS);
                    if (tok < tokv) { const size_t row = (size_t)(rbase + tok);
#pragma unroll
                        for (int vt = 0; vt < 2; ++vt) { const int vcol = h * DV + 32 * wave + 16 * vt + 4 * fq;
                            const u32x2 r2 = rcur[it][vt]; const f32x4 nw = *(const LAS f32x4*)(lds + L_NW + (32 * wave + 16 * vt + 4 * fq) * 4);
                            const f32x4 o = O[vt][it];
                            const float r0 = bf2f((unsigned short)(r2.x & 0xffffu)), r1 = bf2f((unsigned short)(r2.x >> 16)), r2f = bf2f((unsigned short)(r2.y & 0xffffu)), r3 = bf2f((unsigned short)(r2.y >> 16));
                            u32x2 w2; w2.x = pg8::cvt_pk_bf16(o[0] * rstd * nw[0] * r0, o[1] * rstd * nw[1] * r1);
                            w2.y = pg8::cvt_pk_bf16(o[2] * rstd * nw[2] * r2f, o[3] * rstd * nw[3] * r3);
                            *(u32x2*)(GOUT + row * DM + vcol) = w2; } }
                    __builtin_amdgcn_sched_barrier(0); }
            }
            __builtin_amdgcn_sched_barrier(0);
#pragma unroll
            for (int js = 0; js < 2; ++js)
#pragma unroll
                for (int vt = 0; vt < 2; ++vt) { const bf16x8 Yv = *(const LAS bf16x8*)(lds + L_VT + (32 * wave + 16 * vt + fr) * TSB + (32 * js + 8 * fq) * 2);
#pragma unroll
                    for (int dt = 0; dt < 8; ++dt) { const bf16x8 Xk = *(const LAS bf16x8*)(lds + L_KT + (16 * dt + fr) * TSB + (32 * js + 8 * fq) * 2);
                        S[dt][vt] = __builtin_amdgcn_mfma_f32_16x16x32_bf16(Xk, Yv, S[dt][vt], 0, 0, 0); }
                    __builtin_amdgcn_sched_barrier(0); }
            __syncthreads();
        }
        asm volatile("" : "+v"(tid)); lane = tid & 63; fr = lane & 15; fq = lane >> 4;
        if (phase == 0 && !samp) {
            float* dsp = DS + (size_t)(bh * 7 + sc) * DK * DV;
#pragma unroll
            for (int dt = 0; dt < 8; ++dt)
#pragma unroll
                for (int vt = 0; vt < 2; ++vt) *(f32x4*)(dsp + (size_t)(((wave * 8 + dt) * 2 + vt) * 64 + lane) * 4) = S[dt][vt];
            if (wave == 0) { DSC[(size_t)(bh * 7 + sc) * DK + 2 * (tid & 63)] = __builtin_amdgcn_exp2f(btot0); DSC[(size_t)(bh * 7 + sc) * DK + 2 * (tid & 63) + 1] = __builtin_amdgcn_exp2f(btot1); }
        } else if (samp || sc == 7) {
            float* so = samp ? out + O_NGS + ((size_t)(jl * NBS + b) * NH + h) * DK * DV : out + O_NGP + ((size_t)(jl * NBP + b) * NH + h) * DK * DV;
#pragma unroll
            for (int dt = 0; dt < 8; ++dt)
#pragma unroll
                for (int vt = 0; vt < 2; ++vt)
#pragma unroll
                    for (int e = 0; e < 4; ++e) so[(size_t)(16 * dt + 4 * fq + e) * DV + 32 * wave + 16 * vt + fr] = S[dt][vt][e];
        }
    }
}


__device__ __forceinline__ void gla_scan_phase(int gt, int NT, unsigned char* ws) {
    float* DS = (float*)(ws + WS_DS); const float* DSC = (const float*)(ws + WS_DSC);
    for (int c = gt; c < 32 * 8192; c += NT) {
        const int bh = c >> 13, e4 = c & 8191, ln = e4 & 63, dt = (e4 >> 7) & 7, dcol = 16 * dt + 4 * (ln >> 4);
        f32x4 ds[7], dv[7];
#pragma unroll
        for (int k = 0; k < 7; ++k) { ds[k] = *(const f32x4*)(DS + (size_t)(bh * 7 + k) * DK * DV + (size_t)e4 * 4); dv[k] = *(const f32x4*)(DSC + (size_t)(bh * 7 + k) * DK + dcol); }
        f32x4 run = (f32x4){0.f, 0.f, 0.f, 0.f};
#pragma unroll
        for (int k = 0; k < 7; ++k) { run = run * dv[k] + ds[k]; *(f32x4*)(DS + (size_t)(bh * 7 + k) * DK * DV + (size_t)e4 * 4) = run; }
    }
}

struct Args { const float* in[17]; float* out; unsigned char* ws; int ph_lo, ph_hi; };
constexpr int N_PHASES = 29;
__global__ void __launch_bounds__(NWAVES * 64, 2) mk_fwd(Args args) {
    extern __shared__ __attribute__((aligned(16))) unsigned char lds_raw[];
    LAS unsigned char* lds = (LAS unsigned char*)lds_raw;
    volatile LAS unsigned* MISC = (volatile LAS unsigned*)(lds + MISC_OFF);
    for (int u = threadIdx.x; u < (LDS_BYTES - LDSCTL_OFF) / 4; u += NWAVES * 64) ((LAS unsigned*)(lds + LDSCTL_OFF))[u] = 0u;
    __syncthreads();
    XcdBarrier bar = xcd_barrier_post((unsigned*)(args.ws + WS_CTL) + CW_BAR, MISC + 8);
    const int lo = args.ph_lo, hi = args.ph_hi;
    const int wave0 = __builtin_amdgcn_readfirstlane(threadIdx.x >> 6);
#define PH_BEGIN(k) if ((k) >= lo && (k) < hi) { int tid = wave0 * 64 + (int)__builtin_amdgcn_mbcnt_hi(~0u, __builtin_amdgcn_mbcnt_lo(~0u, 0u)); asm volatile("" : "+v"(tid)); const int lane = tid & 63, wave = wave0; \
        const int G = gridDim.x, bid = blockIdx.x; const int vcu = (G % 8 == 0) ? (bid % 8) * (G / 8) + bid / 8 : bid; const int gw = vcu * NWAVES + wave, NGW = G * NWAVES; \
        unsigned char* ws = args.ws; float* out = args.out; const float* const* in = args.in; bf16* Hb = (bf16*)(ws + WS_H); bf16* BIG = (bf16*)(ws + WS_BIG); float* Xs_ = out + O_YS; \
        (void)lane; (void)gw; (void)NGW; (void)Hb; (void)BIG; (void)Xs_; (void)in;
#define PH_END(k)   if ((k) + 1 < hi) xcd_barrier(bar); }

#define POOL_GEMM(k, L) PH_BEGIN(k) { constexpr int jl = (L) >> 1; \
        pg8::Gemm g{BIG, (const bf16*)(ws + WS_WP + jl * SZ_WP), 4 * M, 1024, 256}; pg8::PoolOrder S{G, bid}; \
        pg8::EpiRes<true> E{(L) == 0 ? in[0] : out, (L) == 0 ? in[1] : Xs_, out, in[8] + jl * DM}; \
        pg8::gemm_phase<pg8::EpiRes<true>, pg8::PoolOrder, true, true>(lds, g, S, E, tid); \
        small_gemm_pool(lds, BIG, (const bf16*)(ws + WS_WP + jl * SZ_WP), (L) == 0 ? in[1] : Xs_, Xs_, in[8] + jl * DM, tid, wave, G, bid); } PH_END(k)
#define RMS_PH(k, gain) PH_BEGIN(k) rms_phase(gw, NGW, lane, out, (gain), Hb); PH_END(k)
#define FFN1(k, L) PH_BEGIN(k) { pg8::Gemm g{Hb, (const bf16*)(ws + WS_W13 + (L) * SZ_W13), M, NG1, DM}; pg8::StaticOrder S; S.init(M, NG1, G, bid, DM); \
        pg8::EpiSwiglu E{BIG}; pg8::gemm_phase<pg8::EpiSwiglu, pg8::StaticOrder, true, true>(lds, g, S, E, tid); } PH_END(k)
#define FFN2(k, L) PH_BEGIN(k) { pg8::Gemm g{BIG, (const bf16*)(ws + WS_W2 + (L) * SZ_W2), M, DM, FF}; pg8::PanelOrder S{G, bid, FF / 64}; \
        pg8::EpiRes<false> E{out, Xs_, out, nullptr}; pg8::gemm_phase<pg8::EpiRes<false>, pg8::PanelOrder, true, true>(lds, g, S, E, tid); \
        small_gemm_res(lds, BIG + (size_t)MP * FF, (const bf16*)(ws + WS_W2 + (L) * SZ_W2), FF, Xs_, tid, wave, G, bid); } PH_END(k)
#define PROJ_PH(k, jl) PH_BEGIN(k) { pg8::Gemm g{Hb, (const bf16*)(ws + WS_WIN + (jl) * SZ_WIN), M, NINP, DM}; pg8::StaticOrder S; S.init(M, NINP, G, bid, DM); \
        pg8::EpiProj E{BIG, (float*)(ws + WS_ALOW)}; pg8::gemm_phase<pg8::EpiProj, pg8::StaticOrder, true, true>(lds, g, S, E, tid); } PH_END(k)
#define WO_PH(k, jl) PH_BEGIN(k) { pg8::Gemm g{Hb, (const bf16*)(ws + WS_WO + (jl) * SZ_WO), M, DM, DM}; pg8::PanelOrder S{G, bid, DM / 64}; \
        pg8::EpiRes<false> E{out, Xs_, out, nullptr}; pg8::gemm_phase<pg8::EpiRes<false>, pg8::PanelOrder, true, true>(lds, g, S, E, tid); \
        small_gemm_res(lds, Hb + (size_t)MP * DM, (const bf16*)(ws + WS_WO + (jl) * SZ_WO), DM, Xs_, tid, wave, G, bid); } PH_END(k)
#define GLA_PH(k, sub, jl) PH_BEGIN(k) gla_phase(lds, tid, wave, lane, G, bid, (sub), (jl), in, out, ws); PH_END(k)

#ifdef NO_GLA
#undef GLA_PH
#define GLA_PH(k, sub, jl)
#endif
#ifdef NO_GEMM
#undef POOL_GEMM
#undef FFN1
#undef FFN2
#undef PROJ_PH
#undef WO_PH
#define POOL_GEMM(k, L)
#define FFN1(k, L)
#define FFN2(k, L)
#define PROJ_PH(k, jl)
#define WO_PH(k, jl)
#endif
#ifdef ONLY_FFN1
#undef POOL_GEMM
#undef FFN2
#undef PROJ_PH
#undef WO_PH
#define POOL_GEMM(k, L)
#define FFN2(k, L)
#define PROJ_PH(k, jl)
#define WO_PH(k, jl)
#endif
    PH_BEGIN(0)
        p0_weights(lds, wave, lane, gw, NGW, in, ws);
        __syncthreads();
        pool_prep(lds, tid, wave, lane, G, bid, in[0], in[1], in[4] + 0 * DM, in[2], BIG, out + O_NPP, out + O_NPS);
    PH_END(0)
    POOL_GEMM(1, 0)
    RMS_PH(2, in[5] + 0 * DM)
    FFN1(3, 0)
    FFN2(4, 0)
    RMS_PH(5, in[4] + 1 * DM)
    PROJ_PH(6, 0)
    GLA_PH(7, 0, 0)
    PH_BEGIN(8)
        gla_scan_phase(vcu * (NWAVES * 64) + tid, G * NWAVES * 64, ws);
    PH_END(8)
    GLA_PH(9, 1, 0)
    WO_PH(10, 0)
    RMS_PH(11, in[5] + 1 * DM)
    FFN1(12, 1)
    FFN2(13, 1)
    PH_BEGIN(14)
        pool_prep(lds, tid, wave, lane, G, bid, out, Xs_, in[4] + 2 * DM, in[2] + (size_t)NBS * 15 * DM, BIG, out + O_NPP + (size_t)NBP * 15 * DM, out + O_NPS + (size_t)NBS * 15 * DM);
    PH_END(14)
    POOL_GEMM(15, 2)
    RMS_PH(16, in[5] + 2 * DM)
    FFN1(17, 2)
    FFN2(18, 2)
    RMS_PH(19, in[4] + 3 * DM)
    PROJ_PH(20, 1)
    GLA_PH(21, 0, 1)
    PH_BEGIN(22)
        gla_scan_phase(vcu * (NWAVES * 64) + tid, G * NWAVES * 64, ws);
    PH_END(22)
    GLA_PH(23, 1, 1)
    WO_PH(24, 1)
    RMS_PH(25, in[5] + 3 * DM)
    FFN1(26, 3)
    FFN2(27, 3)
    PH_BEGIN(28)
        final_norm_phase(gw, NGW, lane, out, in[6]);
    PH_END(28)
}

#ifndef MK_SPLIT
#define MK_SPLIT 0
#endif
extern "C" void kernel_launch(void* const* d_in, const int* in_sizes, int n_in, void* d_out, int out_size, void* d_ws, size_t ws_size, hipStream_t stream) {
    static int grid = 0;
    if (grid == 0) {
        if (n_in != 17 || (size_t)out_size != O_END || ws_size < WS_END) { fprintf(stderr, "kernel_launch: unexpected shapes (n_in %d out %d ws %zu)\n", n_in, out_size, ws_size); grid = -1; return; }
        int dev = 0, cus = 0, per_cu = 0;
        if (hipGetDevice(&dev) != hipSuccess || hipDeviceGetAttribute(&cus, hipDeviceAttributeMultiprocessorCount, dev) != hipSuccess) { grid = -1; return; }
        if (hipFuncSetAttribute((const void*)mk_fwd, hipFuncAttributeMaxDynamicSharedMemorySize, LDS_BYTES) != hipSuccess) { fprintf(stderr, "kernel_launch: hipFuncSetAttribute failed\n"); grid = -1; return; }
        if (hipOccupancyMaxActiveBlocksPerMultiprocessor(&per_cu, (const void*)mk_fwd, NWAVES * 64, LDS_BYTES) != hipSuccess || per_cu < 1) { fprintf(stderr, "kernel_launch: occupancy query failed (%d)\n", per_cu); (void)hipGetLastError(); per_cu = 1; }
        grid = cus;
        if (grid > cus * per_cu) grid = cus * per_cu;
    }
    if (grid < 0) return;
    if (hipMemsetAsync((char*)d_ws + WS_CTL, 0, CTL_ZERO_BYTES, stream) != hipSuccess) { fprintf(stderr, "kernel_launch: memset failed\n"); return; }
    Args a{};
    for (int i = 0; i < 17; ++i) a.in[i] = (const float*)d_in[i];
    a.out = (float*)d_out; a.ws = (unsigned char*)d_ws;
#if MK_SPLIT
    for (int p = 0; p < N_PHASES; ++p) { a.ph_lo = p; a.ph_hi = p + 1; hipLaunchKernelGGL(mk_fwd, dim3(grid), dim3(NWAVES * 64), LDS_BYTES, stream, a); }
#else
    a.ph_lo = 0; a.ph_hi = N_PHASES;
    void* kargs[] = {&a};
    hipError_t e = hipLaunchCooperativeKernel((const void*)mk_fwd, dim3(grid), dim3(NWAVES * 64), kargs, LDS_BYTES, stream);
    if (e != hipSuccess) fprintf(stderr, "kernel_launch: cooperative launch failed: %s (grid %d)\n", hipGetErrorString(e), grid);
#endif
}
```

```cpp
#include <hip/hip_runtime.h>
#include <cstdio>
#include <cstdint>
namespace pg8 {
#define PG8_LAS __attribute__((address_space(3)))
typedef unsigned short bf16_t;
typedef short bf16x8 __attribute__((ext_vector_type(8)));
typedef float f32x4 __attribute__((ext_vector_type(4)));
typedef unsigned u32x4 __attribute__((ext_vector_type(4)));
constexpr int BM = 256, BK = 64, HALF = 128, HTB = HALF * BK * 2  , STAGE_BYTES = 8 * HTB, NXCD = 8, WGM = 4;

__host__ __device__ __forceinline__ int lds_byte(int r, int c) { const int st = (r >> 4) * 2 + (c >> 5), rr = r & 15, cc = c & 31, ob = rr * 64 + cc * 2; return st * 1024 + (ob ^ (((ob >> 9) & 1) << 5)); }
__host__ __device__ __forceinline__ void stage_rc(int b, int& R, int& C) { const int st = b / 1024, sb = b % 1024, swz = sb ^ (((sb >> 9) & 1) << 5); R = (st >> 1) * 16 + swz / 64; C = (st & 1) * 32 + (swz % 64) / 2; }
__host__ __device__ __forceinline__ int perm32(int rho) { const int n = rho >> 4, i = rho & 15; return 8 * (i >> 2) + 4 * n + (i & 3); }

struct Unit { int pm, pn, k0, nt, part; };
struct Gemm { const bf16_t* A; const bf16_t* Bt; int M, N, K; };

struct StaticOrder {
    int nM, nN, nwg, G, c, ntk;
    __host__ __device__ void init(int M, int N, int G_, int c_, int K_) { nM = M / BM; nN = N / BM; nwg = nM * nN; G = G_; c = c_; ntk = K_ / BK; }
    __host__ __device__ bool next(int i, Unit& u) const {
        const long L = (long)i * G + c; if (L >= nwg) return false;
        int wgid = (int)L; { const int q = nwg / NXCD, r = nwg % NXCD, xcd = wgid % NXCD, off = wgid / NXCD; wgid = (xcd < r ? xcd * (q + 1) : r * (q + 1) + (xcd - r) * q) + off; }
        const int nig = WGM * nN, gid = wgid / nig, fm = gid * WGM, gsz = (nM - fm) < WGM ? (nM - fm) : WGM;
        u.pm = fm + ((wgid % nig) % gsz); u.pn = (wgid % nig) / gsz; u.k0 = 0; u.nt = ntk; u.part = 0; return true;
    }
    __device__ __forceinline__ void a_ready(const Unit&) const {}
    __device__ __forceinline__ void done(const Unit&) const {}
};

__device__ __forceinline__ unsigned cvt_pk_bf16(float lo, float hi) { unsigned r; asm volatile("v_cvt_pk_bf16_f32 %0, %1, %2" : "=v"(r) : "v"(lo), "v"(hi)); return r; }
typedef float f32x2 __attribute__((ext_vector_type(2)));
typedef unsigned u32x2 __attribute__((ext_vector_type(2)));
__device__ __forceinline__ float silu_f(float x) { return x * __builtin_amdgcn_rcpf(1.0f + __builtin_amdgcn_exp2f(x * -1.4426950408889634f)); }
constexpr int P_DM = 1024, P_FF = 2816, P_NT = 68  , P_PROJ = 3072;

__device__ __forceinline__ unsigned swiglu_pk(f32x2 g, f32x2 u) {
    const f32x2 t = g * -1.4426950408889634f; f32x2 e; e.x = __builtin_amdgcn_exp2f(t.x); e.y = __builtin_amdgcn_exp2f(t.y);
    const f32x2 d = e + 1.0f; f32x2 r; r.x = __builtin_amdgcn_rcpf(d.x); r.y = __builtin_amdgcn_rcpf(d.y);
    const f32x2 o = (g * u) * r; return cvt_pk_bf16(o.x, o.y);
}
struct EpiSwiglu {
    static constexpr bool PERM = true, AFTER_DRAIN = false;
    bf16_t* U;
    __device__ __forceinline__ void operator()(const f32x4 (&acc)[2][2][4][2], const Unit& u, int wr, int wc, int fr, int fq) const {
        const int row0 = u.pm * BM + wr * 64 + fr, col0 = u.pn * 128 + wc * 32 + 8 * fq;
#pragma unroll
        for (int ai = 0; ai < 2; ++ai)
#pragma unroll
            for (int m = 0; m < 4; ++m) { bf16_t* rowp = U + (size_t)(row0 + ai * HALF + m * 16) * P_FF + col0;
                const f32x4 g0 = acc[ai][0][m][0], g1 = acc[ai][0][m][1], u0 = acc[ai][1][m][0], u1 = acc[ai][1][m][1];
                u32x4 w; w.x = swiglu_pk((f32x2){g0[0], g0[1]}, (f32x2){u0[0], u0[1]}); w.y = swiglu_pk((f32x2){g0[2], g0[3]}, (f32x2){u0[2], u0[3]});
                w.z = swiglu_pk((f32x2){g1[0], g1[1]}, (f32x2){u1[0], u1[1]}); w.w = swiglu_pk((f32x2){g1[2], g1[3]}, (f32x2){u1[2], u1[3]});
                *(u32x4*)rowp = w; }
    }
};
struct EpiProj {
    static constexpr bool PERM = true, AFTER_DRAIN = false;
    bf16_t* P; float* AL;
    __device__ __forceinline__ void operator()(const f32x4 (&acc)[2][2][4][2], const Unit& u, int wr, int wc, int fr, int fq) const {
        const int row0 = u.pm * BM + wr * 64 + fr;
        if (u.pn >= 8 && u.pn < 12) {
            const int col0 = u.pn * BM + wc * 32 + 8 * fq; const f32x2 one = (f32x2){1.f, 1.f};
#pragma unroll
            for (int ai = 0; ai < 2; ++ai)
#pragma unroll
                for (int m = 0; m < 4; ++m) { bf16_t* rowp = P + (size_t)(row0 + ai * HALF + m * 16) * P_PROJ + col0;
#pragma unroll
                    for (int bj = 0; bj < 2; ++bj) { const f32x4 v0 = acc[ai][bj][m][0], v1 = acc[ai][bj][m][1];
                        u32x4 w; w.x = swiglu_pk((f32x2){v0[0], v0[1]}, one); w.y = swiglu_pk((f32x2){v0[2], v0[3]}, one); w.z = swiglu_pk((f32x2){v1[0], v1[1]}, one); w.w = swiglu_pk((f32x2){v1[2], v1[3]}, one);
                        *(u32x4*)(rowp + bj * HALF) = w; } }
        } else if (u.pn < 12) {
            const float sc = u.pn < 2 ? 0.08838834764831845f : 1.0f;
            const int col0 = u.pn * BM + wc * 32 + 8 * fq;
#pragma unroll
            for (int ai = 0; ai < 2; ++ai)
#pragma unroll
                for (int m = 0; m < 4; ++m) { bf16_t* rowp = P + (size_t)(row0 + ai * HALF + m * 16) * P_PROJ + col0;
#pragma unroll
                    for (int bj = 0; bj < 2; ++bj) { const f32x4 v0 = acc[ai][bj][m][0] * sc, v1 = acc[ai][bj][m][1] * sc;
                        u32x4 w; w.x = cvt_pk_bf16(v0[0], v0[1]); w.y = cvt_pk_bf16(v0[2], v0[3]); w.z = cvt_pk_bf16(v1[0], v1[1]); w.w = cvt_pk_bf16(v1[2], v1[3]);
                        *(u32x4*)(rowp + bj * HALF) = w; } }
        } else if (wc == 0 && fq < 2) {
#pragma unroll
            for (int ai = 0; ai < 2; ++ai)
#pragma unroll
                for (int m = 0; m < 4; ++m) { float* rowp = AL + (size_t)(row0 + ai * HALF + m * 16) * 16 + 8 * fq;
                    *(f32x4*)rowp = acc[ai][0][m][0]; *(f32x4*)(rowp + 4) = acc[ai][0][m][1]; }
        }
    }
};
template <bool POOL> struct EpiRes {
    static constexpr bool PERM = false, AFTER_DRAIN = false;
    const float* bp; const float* bs; float* out; const float* scale;
    __device__ __forceinline__ void operator()(const f32x4 (&acc)[2][2][4][2], const Unit& u, int wr, int wc, int fr, int fq) const {
        const int pm = POOL ? (u.pm - P_NT * u.pn) : u.pm, pn = u.pn;
        const float* base = pm < 64 ? bp + (size_t)pm * BM * P_DM : bs + (size_t)(pm - 64) * BM * P_DM;
        float* o = out + (size_t)pm * BM * P_DM;
        int frq = fr + 16 * fq; asm volatile("" : "+v"(frq));
        const unsigned col0 = (unsigned)(pn * BM + wc * 32 + 4 * (frq >> 4));
        const unsigned roff = (unsigned)(wr * 64 + (frq & 15)) * P_DM + col0;
#pragma unroll
        for (int ai = 0; ai < 2; ++ai)
#pragma unroll
            for (int m = 0; m < 4; ++m) { const unsigned off = roff + (unsigned)(ai * HALF + m * 16) * P_DM;
#pragma unroll
                for (int bj = 0; bj < 2; ++bj)
#pragma unroll
                    for (int n = 0; n < 2; ++n) { f32x4 a = acc[ai][bj][m][n]; if (POOL) a = a * *(const f32x4*)(scale + col0 + bj * HALF + n * 16);
                        const f32x4 b = *(const f32x4*)(base + off + bj * HALF + n * 16); *(f32x4*)(o + off + bj * HALF + n * 16) = a + b; } }
    }
};
struct PoolOrder {
    int G, c;
    __device__ bool next(int i, Unit& u) const { const int L = i * G + c; if (L >= 256) return false; const int g = L & 3, pm = L >> 2;     u.pm = g * P_NT + pm; u.pn = g; u.k0 = 0; u.nt = 4; u.part = 0; return true; }
    __device__ __forceinline__ void a_ready(const Unit&) const {}
    __device__ __forceinline__ void done(const Unit&) const {}
};
struct PanelOrder {
    int G, c, ntk;
    __device__ bool next(int i, Unit& u) const {
        const int L = i * G + c; if (L >= 256) return false;
        const int x = L & 7, idx = L >> 3; u.pm = x * 8 + (idx >> 2); u.pn = idx & 3; u.k0 = 0; u.nt = ntk; u.part = 0; return true;
    }
    __device__ __forceinline__ void a_ready(const Unit&) const {}
    __device__ __forceinline__ void done(const Unit&) const {}
};
template <class Epi, class Sched, bool ALIGN_EPI = false, bool SP2 = false>
__device__ __forceinline__ void gemm_phase(PG8_LAS unsigned char* lds, const Gemm g, const Sched& S, const Epi& E, const int tid_in) {
    int tid_raw = tid_in; asm volatile("" : "+v"(tid_raw));
    const int tid = tid_raw, wid = __builtin_amdgcn_readfirstlane(tid >> 6), lane = tid & 63, wr = wid >> 2, wc = wid & 3, fr = lane & 15, fq = lane >> 4;
    const int K = g.K;
    unsigned voffA[2], voffB[2];
#pragma unroll
    for (int i = 0; i < 2; ++i) { int R, C; stage_rc(tid * 16 + i * 8192, R, C); const int Rb = Epi::PERM ? ((R & ~31) + perm32(R & 31)) : R;
        voffA[i] = (unsigned)(R * K + C) * 2u; voffB[i] = (unsigned)(Rb * K + C) * 2u; }
    const size_t kstep = (size_t)(BK * 2);
    const size_t hstep = (size_t)HALF * K * 2;
    const size_t tstep = 2 * hstep;
    const unsigned ldsw = (unsigned)wid * 1024u;
    const int aoff = lds_byte(wr * 64 + fr, fq * 8), boff = lds_byte(wc * 32 + fr, fq * 8);
#define PG8_SA(b, h) (((b) * 2 + (h)) * HTB)
#define PG8_SB(b, h) ((4 + (b) * 2 + (h)) * HTB)
#define PG8_STAGE(bufoff, gbase, voff) do { _Pragma("unroll") for (int _i = 0; _i < 2; ++_i) \
        __builtin_amdgcn_global_load_lds((const unsigned*)((const char*)(gbase) + (voff)[_i]), (PG8_LAS unsigned*)(lds + (bufoff) + ldsw + _i * 8192), 16, 0, 0); } while (0)
#define PG8_LDA(dst, b, h) do { _Pragma("unroll") for (int m = 0; m < 4; ++m) _Pragma("unroll") for (int k = 0; k < 2; ++k) dst[m][k] = *(const PG8_LAS bf16x8*)(lds + PG8_SA(b, h) + aoff + m * 2048 + k * 1024); } while (0)
#define PG8_LDB(dst, b, h) do { _Pragma("unroll") for (int n = 0; n < 2; ++n) _Pragma("unroll") for (int k = 0; k < 2; ++k) dst[n][k] = *(const PG8_LAS bf16x8*)(lds + PG8_SB(b, h) + boff + n * 2048 + k * 1024); } while (0)
#define PG8_MMA(ai, bj, At, Bt) do { __builtin_amdgcn_s_setprio(1); _Pragma("unroll") for (int m = 0; m < 4; ++m) _Pragma("unroll") for (int n = 0; n < 2; ++n) _Pragma("unroll") for (int k = 0; k < 2; ++k) \
        acc[ai][bj][m][n] = __builtin_amdgcn_mfma_f32_16x16x32_bf16(Bt[n][k], At[m][k], acc[ai][bj][m][n], 0, 0, 0); __builtin_amdgcn_s_setprio(0); } while (0)
#define PG8_WAIT_V(n) asm volatile("s_waitcnt vmcnt(" #n ")" ::: "memory")
#define PG8_WAIT_L(n) asm volatile("s_waitcnt lgkmcnt(" #n ")" ::: "memory")
#define PG8_BAR __builtin_amdgcn_s_barrier()
#define PG8_SCHED __builtin_amdgcn_sched_barrier(0)
    Unit cur, nxt; int ui = 0;
    if (!S.next(0, cur)) return;
    f32x4 acc[2][2][4][2];
#pragma unroll
    for (int a = 0; a < 2; ++a)
#pragma unroll
        for (int b = 0; b < 2; ++b)
#pragma unroll
            for (int m = 0; m < 4; ++m)
#pragma unroll
                for (int n = 0; n < 2; ++n) acc[a][b][m][n] = (f32x4){0.f, 0.f, 0.f, 0.f};
    bf16x8 At[4][2], B0[2][2], B1[2][2];
    const char* cA = (const char*)g.A + (size_t)cur.pm * tstep + (size_t)cur.k0 * 2; const char* cB = (const char*)g.Bt + (size_t)cur.pn * tstep + (size_t)cur.k0 * 2;
    S.a_ready(cur);
    if constexpr (SP2) {
        PG8_STAGE(PG8_SB(0, 0), cB, voffB); PG8_STAGE(PG8_SB(0, 1), cB + hstep, voffB); PG8_STAGE(PG8_SA(0, 0), cA, voffA); PG8_STAGE(PG8_SA(0, 1), cA + hstep, voffA);
        if (wr == 1) PG8_BAR;
        PG8_WAIT_V(2); PG8_BAR;
        PG8_STAGE(PG8_SB(1, 0), cB + kstep, voffB); PG8_STAGE(PG8_SA(1, 0), cA + kstep, voffA); PG8_STAGE(PG8_SB(1, 1), cB + hstep + kstep, voffB);
        PG8_WAIT_V(6); PG8_BAR;
    } else {
        PG8_STAGE(PG8_SB(0, 0), cB, voffB); PG8_STAGE(PG8_SA(0, 0), cA, voffA); PG8_STAGE(PG8_SB(0, 1), cB + hstep, voffB); PG8_STAGE(PG8_SA(0, 1), cA + hstep, voffA);
        if (wr == 1) PG8_BAR;
        PG8_WAIT_V(4); PG8_BAR;
        PG8_STAGE(PG8_SB(1, 0), cB + kstep, voffB); PG8_STAGE(PG8_SA(1, 0), cA + kstep, voffA); PG8_STAGE(PG8_SB(1, 1), cB + hstep + kstep, voffB);
        PG8_WAIT_V(6); PG8_BAR;
    }
    for (;;) {
        const bool has_next = S.next(ui + 1, nxt);
        const char* nA = has_next ? (const char*)g.A + (size_t)nxt.pm * tstep + (size_t)nxt.k0 * 2 : cA; const char* nB = has_next ? (const char*)g.Bt + (size_t)nxt.pn * tstep + (size_t)nxt.k0 * 2 : cB;
        const int nt = cur.nt;
        for (int t = 0; t < nt; t += 2) {
            const bool last = (t == nt - 2);
            const char* a1 = cA + (size_t)(t + 1) * kstep;
            const char* a2 = last ? nA : cA + (size_t)(t + 2) * kstep; const char* b2 = last ? nB : cB + (size_t)(t + 2) * kstep;
            const char* a3 = a2 + kstep; const char* b3 = b2 + kstep;
            if (last && has_next) S.a_ready(nxt);
            if constexpr (SP2) {
            PG8_LDB(B0, 0, 0); PG8_LDB(B1, 0, 1); PG8_SCHED; PG8_LDA(At, 0, 0); PG8_STAGE(PG8_SA(1, 1), a1 + hstep, voffA);
            PG8_WAIT_V(8); PG8_WAIT_L(0); PG8_BAR; PG8_MMA(0, 0, At, B0); PG8_MMA(0, 1, At, B1); PG8_BAR; PG8_SCHED;
            PG8_LDA(At, 0, 1); PG8_STAGE(PG8_SB(0, 0), b2, voffB); PG8_STAGE(PG8_SB(0, 1), b2 + hstep, voffB); PG8_STAGE(PG8_SA(0, 0), a2, voffA);
            PG8_WAIT_V(8); PG8_WAIT_L(0); PG8_BAR; PG8_MMA(1, 0, At, B0); PG8_MMA(1, 1, At, B1); PG8_BAR; PG8_SCHED;
            PG8_LDB(B0, 1, 0); PG8_LDB(B1, 1, 1); PG8_SCHED; PG8_LDA(At, 1, 0); PG8_STAGE(PG8_SA(0, 1), a2 + hstep, voffA);
            PG8_WAIT_V(8); PG8_WAIT_L(0); PG8_BAR; PG8_MMA(0, 0, At, B0); PG8_MMA(0, 1, At, B1); PG8_BAR; PG8_SCHED;
            PG8_LDA(At, 1, 1); PG8_STAGE(PG8_SB(1, 0), b3, voffB); PG8_STAGE(PG8_SB(1, 1), b3 + hstep, voffB); PG8_STAGE(PG8_SA(1, 0), a3, voffA);
            PG8_WAIT_V(8); PG8_WAIT_L(0); PG8_BAR; PG8_MMA(1, 0, At, B0); PG8_MMA(1, 1, At, B1); PG8_BAR; PG8_SCHED;
            } else {
            PG8_LDB(B0, 0, 0); PG8_SCHED; PG8_LDA(At, 0, 0); PG8_STAGE(PG8_SA(1, 1), a1 + hstep, voffA);
            PG8_WAIT_L(8); PG8_BAR; PG8_WAIT_L(0); PG8_MMA(0, 0, At, B0); PG8_BAR; PG8_SCHED;
            PG8_LDB(B1, 0, 1); PG8_STAGE(PG8_SB(0, 0), b2, voffB);
            PG8_BAR; PG8_WAIT_L(0); PG8_MMA(0, 1, At, B1); PG8_BAR;
            PG8_LDA(At, 0, 1); PG8_STAGE(PG8_SA(0, 0), a2, voffA);
            PG8_BAR; PG8_WAIT_L(0); PG8_MMA(1, 0, At, B0); PG8_BAR; PG8_SCHED;
            PG8_STAGE(PG8_SB(0, 1), b2 + hstep, voffB);
            PG8_WAIT_V(6); PG8_BAR; PG8_MMA(1, 1, At, B1); PG8_BAR;
            PG8_LDB(B0, 1, 0); PG8_SCHED; PG8_LDA(At, 1, 0); PG8_STAGE(PG8_SA(0, 1), a2 + hstep, voffA);
            PG8_WAIT_L(8); PG8_BAR; PG8_WAIT_L(0); PG8_MMA(0, 0, At, B0); PG8_BAR; PG8_SCHED;
            PG8_LDB(B1, 1, 1); PG8_STAGE(PG8_SB(1, 0), b3, voffB);
            PG8_BAR; PG8_WAIT_L(0); PG8_MMA(0, 1, At, B1); PG8_BAR;
            PG8_LDA(At, 1, 1); PG8_STAGE(PG8_SA(1, 0), a3, voffA);
            PG8_BAR; PG8_WAIT_L(0); PG8_MMA(1, 0, At, B0); PG8_BAR; PG8_SCHED;
            PG8_STAGE(PG8_SB(1, 1), b3 + hstep, voffB);
            PG8_WAIT_V(6); PG8_BAR; PG8_MMA(1, 1, At, B1); PG8_BAR;
            }
        }
        if constexpr (ALIGN_EPI) { if (wr == 0) PG8_BAR; }
        if constexpr (!Epi::AFTER_DRAIN) { E(acc, cur, wr, wc, fr, fq); S.done(cur); }
        if (!has_next) break;
#pragma unroll
        for (int a = 0; a < 2; ++a)
#pragma unroll
            for (int b = 0; b < 2; ++b)
#pragma unroll
                for (int m = 0; m < 4; ++m)
#pragma unroll
                    for (int n = 0; n < 2; ++n) acc[a][b][m][n] = (f32x4){0.f, 0.f, 0.f, 0.f};
        cur = nxt; cA = nA; cB = nB; ++ui;
        if constexpr (ALIGN_EPI) { if (wr == 1) PG8_BAR; }
    }
    PG8_WAIT_V(0);
    if constexpr (!ALIGN_EPI) { if (wr == 0) PG8_BAR; }
    PG8_BAR;
    if constexpr (Epi::AFTER_DRAIN) { E.fused(acc, cur, wr, wc, fr, fq, lds, wid, lane); S.done(cur); }
#undef PG8_SA
#undef PG8_SB
#undef PG8_STAGE
#undef PG8_LDA
#undef PG8_LDB
#undef PG8_MMA
#undef PG8_WAIT_V
#undef PG8_WAIT_L
#undef PG8_BAR
#undef PG8_SCHED
}
}
#define GAS __attribute__((address_space(1)))
#define LAS __attribute__((address_space(3)))
typedef unsigned short bf16;
typedef unsigned v4u __attribute__((ext_vector_type(4)));
typedef float f32x4 __attribute__((ext_vector_type(4)));
typedef short bf16x8 __attribute__((ext_vector_type(8)));
typedef GAS unsigned gu32;
typedef GAS unsigned long long gu64;
#define RLX_AGENT __ATOMIC_RELAXED, __HIP_MEMORY_SCOPE_AGENT
#define LDS_WAIT() asm volatile("s_waitcnt lgkmcnt(0)" ::: "memory")
#define VM_WAIT() asm volatile("s_waitcnt vmcnt(0)" ::: "memory")
__device__ __forceinline__ unsigned long long rt() { return __builtin_amdgcn_s_memrealtime(); }
__device__ __forceinline__ unsigned f2bf(float f) { unsigned u = __builtin_bit_cast(unsigned, f); return (u + 0x7fffu + ((u >> 16) & 1u)) >> 16; }
__device__ __forceinline__ unsigned pk2(float lo, float hi) { return f2bf(lo) | (f2bf(hi) << 16); }

#define XB_TMO      128
#define XB_XCNT(j)  (256  + 64 * (j))
#define XB_XSUB(j)  (1280 + 64 * (j))
#define XB_XGEN(j)  (2304 + 64 * (j))
#define XB_TOP      3328
#define XB_TOPGEN   3392
#define XCD_BAR_WORDS 3456
#define XB_SPIN_CAP (1u << 18)

__device__ __forceinline__ unsigned xb_ld(unsigned* p)              { return __hip_atomic_load(p, __ATOMIC_RELAXED, __HIP_MEMORY_SCOPE_AGENT); }
__device__ __forceinline__ unsigned xb_add(unsigned* p, unsigned v) { return __hip_atomic_fetch_add(p, v, __ATOMIC_RELAXED, __HIP_MEMORY_SCOPE_AGENT); }
__device__ __forceinline__ unsigned xb_xcc_id() { return (unsigned)__builtin_amdgcn_s_getreg((3 << 11) | 20) & 0xFu; }
#define XB_SPIN(cond, bar) do { unsigned _sp = 0; while (cond) { __builtin_amdgcn_s_sleep(1); \
    if ((++_sp & 255u) == 0u) { if (xb_ld(&(bar)[XB_TMO])) break; if (_sp > XB_SPIN_CAP) { atomicAdd(&(bar)[XB_TMO], 1u); break; } } } } while (0)

struct XcdBarrier {
    unsigned* bar; unsigned x;
    volatile LAS unsigned* st;
};

__device__ __forceinline__ XcdBarrier xcd_barrier_post(unsigned* bar, volatile LAS unsigned* st) {
    XcdBarrier b; b.bar = bar; b.x = xb_xcc_id(); b.st = st;
    if (threadIdx.x == 0) (void)xb_add(&bar[XB_XCNT(b.x)], 1u);
    return b;
}
__device__ __forceinline__ void xcd_barrier_complete(unsigned* bar, unsigned x, unsigned& nloc, unsigned& nx) {
    const unsigned G = gridDim.x * gridDim.y * gridDim.z;
    unsigned sum, cnt, mine, sp = 0u;
    for (;;) {
        sum = 0u; cnt = 0u; mine = 0u;
#pragma unroll
        for (unsigned j = 0; j < 16; ++j) { const unsigned c = xb_ld(&bar[XB_XCNT(j)]); sum += c; cnt += (c > 0u) ? 1u : 0u; mine = (j == x) ? c : mine; }
        if (sum == G) break;
        __builtin_amdgcn_s_sleep(1);
        if ((++sp & 255u) == 0u) { if (xb_ld(&bar[XB_TMO])) break; if (sp > XB_SPIN_CAP) { atomicAdd(&bar[XB_TMO], 1u); break; } }
    }
    nloc = mine > 0u ? mine : 1u; nx = cnt > 0u ? cnt : 1u;
}

__device__ __forceinline__ void xcd_barrier(const XcdBarrier& b) {
    asm volatile("s_waitcnt vmcnt(0)" ::: "memory");
    __syncthreads();
    if (threadIdx.x == 0) {
        unsigned* bar = b.bar;
        __builtin_amdgcn_s_waitcnt(0);
        unsigned nloc = b.st[0], nx = b.st[1];
        if (nloc == 0u) { xcd_barrier_complete(bar, b.x, nloc, nx); b.st[0] = nloc; b.st[1] = nx; }
        const unsigned old = xb_add(&bar[XB_XSUB(b.x)], 1u);
        const unsigned gen = old / nloc;
        if (old + 1u == (gen + 1u) * nloc) {
            __builtin_amdgcn_fence(__ATOMIC_RELEASE, "agent");
            asm volatile("s_waitcnt vmcnt(0)" ::: "memory");
            const unsigned og = xb_add(&bar[XB_TOP], 1u);
            const unsigned tg = og / nx;
            if (og + 1u == (tg + 1u) * nx) xb_add(&bar[XB_TOPGEN], 1u);
            else XB_SPIN(xb_ld(&bar[XB_TOPGEN]) == tg, bar);
            __builtin_amdgcn_fence(__ATOMIC_ACQUIRE, "agent");
            xb_add(&bar[XB_XGEN(b.x)], 1u);
            asm volatile("s_waitcnt vmcnt(0)" ::: "memory");
        } else {
            XB_SPIN(xb_ld(&bar[XB_XGEN(b.x)]) == gen, bar);
            __builtin_amdgcn_fence(__ATOMIC_ACQUIRE, "agent");
            asm volatile("s_waitcnt vmcnt(0)" ::: "memory");
        }
    }
    __syncthreads();
}
constexpr int NWAVES = 8;
constexpr int DM = 1024, TP = 2048, NBP = 8, MP = NBP * TP, NBS = 128, TS = 8, MS = NBS * TS, M = MP + MS, FF = 2816, NG1 = 2 * FF;
constexpr int NIN = 3088, NINP = 3328, NPROJ = 3072, DK = 128, DV = 256, NH = 4;
constexpr float EPS = 1e-6f;
static_assert(M == 68 * 256, "row tiles");
constexpr size_t O_YP = 0, O_YS = (size_t)MP * DM, O_NPP = O_YS + (size_t)MS * DM, O_NGP = O_NPP + (size_t)2 * NBP * 15 * DM, O_NPS = O_NGP + (size_t)2 * NBP * NH * DK * DV,
                 O_NGS = O_NPS + (size_t)2 * NBS * 15 * DM, O_END = O_NGS + (size_t)2 * NBS * NH * DK * DV;
constexpr size_t MiB = 1u << 20;
constexpr size_t WS_CTL = 0, CTL_ZERO_BYTES = 1 * MiB;
constexpr size_t SZ_W13 = (size_t)NG1 * DM * 2, SZ_W2 = (size_t)DM * FF * 2, SZ_WIN = (size_t)NINP * DM * 2, SZ_WO = (size_t)DM * DM * 2, SZ_WP = (size_t)4 * 256 * 256 * 2;
constexpr size_t WS_W13 = 1 * MiB, WS_W2 = WS_W13 + 4 * SZ_W13, WS_WIN = WS_W2 + 4 * SZ_W2, WS_WO = WS_WIN + 2 * SZ_WIN, WS_WP = WS_WO + 2 * SZ_WO;
constexpr size_t WS_H = WS_WP + 2 * SZ_WP;
constexpr size_t WS_BIG = WS_H + (size_t)M * DM * 2;
constexpr size_t WS_ALOW = WS_BIG + (size_t)M * NPROJ * 2;
constexpr size_t WS_DS = WS_ALOW + (size_t)M * 16 * 4;
constexpr size_t WS_DSC = WS_DS + (size_t)32 * 7 * DK * DV * 4;
constexpr size_t WS_END = WS_DSC + (size_t)32 * 7 * DK * 4;
static_assert(WS_END <= 256 * MiB, "d_ws map");
static_assert(WS_H % 256 == 0 && WS_BIG % 256 == 0 && WS_ALOW % 256 == 0 && WS_DS % 256 == 0 && WS_DSC % 256 == 0, "alignment");
constexpr int CW_BAR = 4096;
constexpr int RING_BYTES = 131072, LDSCTL_OFF = RING_BYTES, MISC_OFF = LDSCTL_OFF + 320, LDS_BYTES = 147456;

__device__ __forceinline__ float wave_sum(float v) {
#pragma unroll
    for (int o = 1; o < 64; o <<= 1) v += __shfl_xor(v, o);
    return v;
}
__device__ __forceinline__ float bf2f(unsigned short b) { return __builtin_bit_cast(float, (unsigned)b << 16); }

__device__ __forceinline__ void tr_item(const float* W, int K, int N, bf16* WT, int mode, int row_off, LAS float* scr, int item, int lane) {
    const int nblk = (N + 31) >> 5, kb = item / nblk, nb = item - kb * nblk, k0 = 64 * kb, n0 = 32 * nb;
    const int nn = n0 + (lane & 31); const bool ok = nn < N;
    float wv[32];
#pragma unroll
    for (int i = 0; i < 32; ++i) { const int kk = 2 * i + (lane >> 5); wv[i] = ok ? W[(size_t)(k0 + kk) * N + nn] : 0.f; }
#pragma unroll
    for (int i = 0; i < 32; ++i) { const int kk = 2 * i + (lane >> 5); scr[kk * 33 + (lane & 31)] = wv[i]; }
    LDS_WAIT(); asm volatile("" ::: "memory");
    const int c = lane & 7;
#pragma unroll
    for (int j = 0; j < 4; ++j) { const int n = (lane >> 3) + 8 * j; const LAS float* s = scr + (8 * c) * 33 + n;
        v4u o; o.x = pk2(s[0 * 33], s[1 * 33]); o.y = pk2(s[2 * 33], s[3 * 33]); o.z = pk2(s[4 * 33], s[5 * 33]); o.w = pk2(s[6 * 33], s[7 * 33]);
        const int ng = n0 + n; const int row = mode ? (((ng >> 7) << 8) + (ng & 127) + row_off) : (row_off + ng);
        *(v4u*)(WT + (size_t)row * K + k0 + 8 * c) = o; }
    LDS_WAIT(); asm volatile("" ::: "memory");
}
__device__ __forceinline__ void p0_weights(LAS unsigned char* lds, int wave, int lane, int gw, int NGW, const float* const* in, unsigned char* ws) {
    LAS float* scr = (LAS float*)(lds + wave * 16384);
    constexpr int I_W1 = (DM / 64) * (FF / 32), I_W2 = (FF / 64) * (DM / 32), I_WIN = (DM / 64) * ((NIN + 31) / 32), I_WO = (DM / 64) * (DM / 32), I_WP = (256 / 64) * (256 / 32);
    constexpr int N_FFN = 4 * (2 * I_W1 + I_W2), N_GLA = 2 * (I_WIN + I_WO), N_POOL = 8 * I_WP, NITEMS = N_FFN + N_GLA + N_POOL;
    for (int it = gw; it < NITEMS; it += NGW) {
        int r = it;
        if (r < N_FFN) { const int L = r / (2 * I_W1 + I_W2); r -= L * (2 * I_W1 + I_W2);
            if (r < I_W1) { tr_item(in[14] + (size_t)L * DM * FF, DM, FF, (bf16*)(ws + WS_W13 + L * SZ_W13), 1, 0, scr, r, lane); continue; } r -= I_W1;
            if (r < I_W1) { tr_item(in[15] + (size_t)L * DM * FF, DM, FF, (bf16*)(ws + WS_W13 + L * SZ_W13), 1, 128, scr, r, lane); continue; } r -= I_W1;
            tr_item(in[16] + (size_t)L * FF * DM, FF, DM, (bf16*)(ws + WS_W2 + L * SZ_W2), 0, 0, scr, r, lane); continue; }
        r -= N_FFN;
        if (r < N_GLA) { const int L = r / (I_WIN + I_WO); r -= L * (I_WIN + I_WO);
            if (r < I_WIN) { tr_item(in[9] + (size_t)L * DM * NIN, DM, NIN, (bf16*)(ws + WS_WIN + L * SZ_WIN), 0, 0, scr, r, lane); continue; } r -= I_WIN;
            tr_item(in[13] + (size_t)L * DM * DM, DM, DM, (bf16*)(ws + WS_WO + L * SZ_WO), 0, 0, scr, r, lane); continue; }
        r -= N_GLA;
        { const int jg = r / I_WP; r -= jg * I_WP;
          tr_item(in[7] + (size_t)jg * 65536, 256, 256, (bf16*)(ws + WS_WP + (jg >> 2) * SZ_WP), 0, (jg & 3) * 256, scr, r, lane); }
    }
    constexpr int PADV = (NINP - 3104) * DM * 2 / 16;
    for (int i = gw * 64 + lane; i < 2 * PADV; i += NGW * 64) { const int L = i / PADV, e = i - L * PADV;
        ((v4u*)(ws + WS_WIN + L * SZ_WIN + (size_t)3104 * DM * 2))[e] = (v4u){0u, 0u, 0u, 0u}; }
}

__device__ __forceinline__ void rms_row_bf16(const float* xrow, const float* g, bf16* orow, int lane) {
    const f32x4* xr = (const f32x4*)xrow + lane; const f32x4* gr = (const f32x4*)g + lane;
    f32x4 v[4]; float s = 0.f;
#pragma unroll
    for (int j = 0; j < 4; ++j) { v[j] = xr[64 * j]; s += (v[j].x * v[j].x + v[j].y * v[j].y) + (v[j].z * v[j].z + v[j].w * v[j].w); }
    const float rstd = rsqrtf(wave_sum(s) * (1.f / DM) + EPS);
    unsigned long long* o8 = (unsigned long long*)orow + lane;
#pragma unroll
    for (int j = 0; j < 4; ++j) { const f32x4 gg = gr[64 * j]; const f32x4 y = v[j] * rstd * gg;
        o8[64 * j] = (unsigned long long)pk2(y.x, y.y) | ((unsigned long long)pk2(y.z, y.w) << 32); }
}
__device__ __forceinline__ void rms_phase(int gw, int NGW, int lane, const float* X, const float* g, bf16* H) {
    for (int m = gw; m < M; m += NGW) rms_row_bf16(X + (size_t)m * DM, g, H + (size_t)m * DM, lane);
}
__device__ __forceinline__ void final_norm_phase(int gw, int NGW, int lane, float* X, const float* g) {
    for (int m = gw; m < M; m += NGW) {
        f32x4* xr = (f32x4*)(X + (size_t)m * DM) + lane; const f32x4* gr = (const f32x4*)g + lane;
        f32x4 v[4]; float s = 0.f;
#pragma unroll
        for (int j = 0; j < 4; ++j) { v[j] = xr[64 * j]; s += (v[j].x * v[j].x + v[j].y * v[j].y) + (v[j].z * v[j].z + v[j].w * v[j].w); }
        const float rstd = rsqrtf(wave_sum(s) * (1.f / DM) + EPS);
#pragma unroll
        for (int j = 0; j < 4; ++j) xr[64 * j] = v[j] * rstd * gr[64 * j];
    }
}

__device__ __forceinline__ void small_gemm_res(LAS unsigned char* lds, const bf16* A, const bf16* Bt, int K, float* X, int tid, int wave, int G, int bid) {
    constexpr int RS = 272, BUF = 2 * 64 * RS;
    const int lane = tid & 63, fr = lane & 15, fq = lane >> 4, rt = wave & 3, ch = wave >> 2;
    const int lr = tid >> 3, lc = (tid & 7) * 16;
    const int nch = K >> 7;
    for (int L = bid; L < 256; L += G) {
        const int tm = L >> 4, tn = L & 15;
        const v4u* ag = (const v4u*)(A + (size_t)(tm * 64 + lr) * K + lc); const v4u* bg = (const v4u*)(Bt + (size_t)(tn * 64 + lr) * K + lc);
        LAS unsigned char* wa = lds + lr * RS + lc * 2; LAS unsigned char* wb = wa + 64 * RS;
        v4u pa[2], pb[2], qa[2], qb[2];
        { const v4u a0 = ag[0], a1 = ag[1], b0 = bg[0], b1 = bg[1];
          pa[0] = ag[16]; pa[1] = ag[17]; pb[0] = bg[16]; pb[1] = bg[17];
          qa[0] = ag[32]; qa[1] = ag[33]; qb[0] = bg[32]; qb[1] = bg[33];
          *(LAS v4u*)wa = a0; *(LAS v4u*)(wa + 16) = a1; *(LAS v4u*)wb = b0; *(LAS v4u*)(wb + 16) = b1; }
        __syncthreads();
        f32x4 acc0 = (f32x4){0.f, 0.f, 0.f, 0.f}, acc1 = (f32x4){0.f, 0.f, 0.f, 0.f};
#define SG_COMPUTE(bufoff) { _Pragma("unroll") for (int ks = 0; ks < 4; ++ks) { const bf16x8 a = *(const LAS bf16x8*)(lds + (bufoff) + (16 * rt + fr) * RS + (32 * ks + 8 * fq) * 2); \
            const bf16x8 b0 = *(const LAS bf16x8*)(lds + (bufoff) + 64 * RS + (32 * ch + fr) * RS + (32 * ks + 8 * fq) * 2), b1 = *(const LAS bf16x8*)(lds + (bufoff) + 64 * RS + (32 * ch + 16 + fr) * RS + (32 * ks + 8 * fq) * 2); \
            acc0 = __builtin_amdgcn_mfma_f32_16x16x32_bf16(b0, a, acc0, 0, 0, 0); acc1 = __builtin_amdgcn_mfma_f32_16x16x32_bf16(b1, a, acc1, 0, 0, 0); } }
        for (int kc = 0; kc < nch; kc += 2) {
            SG_COMPUTE(0)
            *(LAS v4u*)(wa + BUF) = pa[0]; *(LAS v4u*)(wa + BUF + 16) = pa[1]; *(LAS v4u*)(wb + BUF) = pb[0]; *(LAS v4u*)(wb + BUF + 16) = pb[1];
            if (kc + 3 < nch) { pa[0] = ag[16 * (kc + 3)]; pa[1] = ag[16 * (kc + 3) + 1]; pb[0] = bg[16 * (kc + 3)]; pb[1] = bg[16 * (kc + 3) + 1]; }
            __syncthreads();
            SG_COMPUTE(BUF)
            if (kc + 2 < nch) { *(LAS v4u*)wa = qa[0]; *(LAS v4u*)(wa + 16) = qa[1]; *(LAS v4u*)wb = qb[0]; *(LAS v4u*)(wb + 16) = qb[1]; }
            if (kc + 4 < nch) { qa[0] = ag[16 * (kc + 4)]; qa[1] = ag[16 * (kc + 4) + 1]; qb[0] = bg[16 * (kc + 4)]; qb[1] = bg[16 * (kc + 4) + 1]; }
            __syncthreads();
        }
#undef SG_COMPUTE
        float* o = X + (size_t)(tm * 64 + 16 * rt + fr) * DM + tn * 64 + 32 * ch + 4 * fq;
        *(f32x4*)o = *(const f32x4*)o + acc0; *(f32x4*)(o + 16) = *(const f32x4*)(o + 16) + acc1;
    }
    __syncthreads();
}

__device__ __forceinline__ void small_gemm_pool(LAS unsigned char* lds, const bf16* DIFF, const bf16* Wp, const float* base_s, float* Xs, const float* scale, int tid, int wave, int G, int bid) {
    constexpr int RS = 272, BUF = 2 * 64 * RS;
    const int lane = tid & 63, fr = lane & 15, fq = lane >> 4, rt = wave & 3, ch = wave >> 2;
    const int lr = tid >> 3, lc = (tid & 7) * 16;
    for (int L = bid; L < 256; L += G) {
        const int tm = L >> 4, tn = L & 15, g = tn >> 2, cb = (tn & 3) * 64;
        const v4u* ag = (const v4u*)(DIFF + ((size_t)g * M + MP + tm * 64 + lr) * 256 + lc); const v4u* bg = (const v4u*)(Wp + ((size_t)g * 256 + cb + lr) * 256 + lc);
        const v4u a0 = ag[0], a1 = ag[1], a2 = ag[16], a3 = ag[17], b0 = bg[0], b1 = bg[1], b2 = bg[16], b3 = bg[17];
        LAS unsigned char* wa = lds + lr * RS + lc * 2; LAS unsigned char* wb = wa + 64 * RS;
        *(LAS v4u*)wa = a0; *(LAS v4u*)(wa + 16) = a1; *(LAS v4u*)wb = b0; *(LAS v4u*)(wb + 16) = b1;
        *(LAS v4u*)(wa + BUF) = a2; *(LAS v4u*)(wa + BUF + 16) = a3; *(LAS v4u*)(wb + BUF) = b2; *(LAS v4u*)(wb + BUF + 16) = b3;
        __syncthreads();
        f32x4 acc0 = (f32x4){0.f, 0.f, 0.f, 0.f}, acc1 = (f32x4){0.f, 0.f, 0.f, 0.f};
#pragma unroll
        for (int kk = 0; kk < 8; ++kk) { const int bufoff = (kk >> 2) * BUF, ks = kk & 3;
            const bf16x8 a = *(const LAS bf16x8*)(lds + bufoff + (16 * rt + fr) * RS + (32 * ks + 8 * fq) * 2);
            const bf16x8 w0 = *(const LAS bf16x8*)(lds + bufoff + 64 * RS + (32 * ch + fr) * RS + (32 * ks + 8 * fq) * 2), w1 = *(const LAS bf16x8*)(lds + bufoff + 64 * RS + (32 * ch + 16 + fr) * RS + (32 * ks + 8 * fq) * 2);
            acc0 = __builtin_amdgcn_mfma_f32_16x16x32_bf16(w0, a, acc0, 0, 0, 0); acc1 = __builtin_amdgcn_mfma_f32_16x16x32_bf16(w1, a, acc1, 0, 0, 0); }
        const int col = g * 256 + cb + 32 * ch + 4 * fq; const size_t ro = (size_t)(tm * 64 + 16 * rt + fr) * DM + col;
        const f32x4 x0 = *(const f32x4*)(base_s + ro) + acc0 * *(const f32x4*)(scale + col), x1 = *(const f32x4*)(base_s + ro + 16) + acc1 * *(const f32x4*)(scale + col + 16);
        *(f32x4*)(Xs + ro) = x0; *(f32x4*)(Xs + ro + 16) = x1;
        __syncthreads();
    }
}

__device__ __forceinline__ void pool_prep(LAS unsigned char* lds, int tid, int wave, int lane, int G, int bid,
                                          const float* xp, const float* xs, const float* gmix, const float* spool, bf16* DIFF, float* onp, float* ons) {
    typedef float f32x2 __attribute__((ext_vector_type(2)));
    LAS float* hb = (LAS float*)lds;
    for (int u = bid; u < 1024 + NBS; u += G) {
        const bool pr = u < 1024; const int b = pr ? (u >> 7) : (u - 1024); const int t0 = pr ? (u & 127) * 16 : 0; const int ntok = pr ? 16 : 8;
        {
            f32x4 v[4][4]; bool has[4], donorm[4];
#pragma unroll
            for (int k = 0; k < 4; ++k) { const int r = wave + 8 * k; const float* src = nullptr; donorm[k] = true;
                if (r < 15 + ntok) {
                    if (pr) { const int t = t0 - 15 + r; if (t >= 0) src = xp + ((size_t)b * TP + t) * DM; }
                    else { if (r < 15) { src = spool + ((size_t)b * 15 + r) * DM; donorm[k] = false; } else src = xs + ((size_t)b * TS + (r - 15)) * DM; } }
                has[k] = src != nullptr;
#pragma unroll
                for (int j = 0; j < 4; ++j) v[k][j] = has[k] ? ((const f32x4*)src + lane)[64 * j] : (f32x4){0.f, 0.f, 0.f, 0.f}; }
            const f32x4* gr = (const f32x4*)gmix + lane;
#pragma unroll
            for (int k = 0; k < 4; ++k) { const int r = wave + 8 * k;
                if (r < 15 + ntok) { float s = 0.f;
#pragma unroll
                    for (int j = 0; j < 4; ++j) s += (v[k][j].x * v[k][j].x + v[k][j].y * v[k][j].y) + (v[k][j].z * v[k][j].z + v[k][j].w * v[k][j].w);
                    const float rstd = (has[k] && donorm[k]) ? rsqrtf(wave_sum(s) * (1.f / DM) + EPS) : 1.f;
                    LAS f32x4* hrow = (LAS f32x4*)(hb + r * DM) + lane;
#pragma unroll
                    for (int j = 0; j < 4; ++j) hrow[64 * j] = (has[k] && donorm[k]) ? v[k][j] * rstd * gr[64 * j] : v[k][j]; } }
        }
        __syncthreads();
        const int c = 2 * tid, gi = tid >> 7, w = 2 << gi;
        f32x2 sum = (f32x2){0.f, 0.f};
        for (int l = 1; l < w; ++l) sum += *(const LAS f32x2*)(hb + (15 - l) * DM + c);
        for (int i = 0; i < ntok; ++i) {
            const f32x2 cur = *(const LAS f32x2*)(hb + (15 + i) * DM + c); sum += cur;
            const int cnt = pr ? ((t0 + i + 1) < w ? (t0 + i + 1) : w) : w; const float inv = 1.0f / (float)cnt;
            const f32x2 d = sum * inv - cur;
            const size_t row = pr ? ((size_t)b * TP + t0 + i) : ((size_t)MP + b * TS + i);
            *(unsigned*)(DIFF + ((size_t)gi * M + row) * 256 + (c & 255)) = pk2(d.x, d.y);
            sum -= *(const LAS f32x2*)(hb + (15 + i - w + 1) * DM + c);
        }
        if (pr) { if (t0 == TP - 16) for (int i = 1; i < 16; ++i) *(f32x2*)(onp + ((size_t)b * 15 + (i - 1)) * DM + c) = *(const LAS f32x2*)(hb + (15 + i) * DM + c); }
        else for (int i = 0; i < 15; ++i) *(f32x2*)(ons + ((size_t)b * 15 + i) * DM + c) = *(const LAS f32x2*)(hb + (8 + i) * DM + c);
        __syncthreads();
    }
}

constexpr int L_QH = 0, L_KH = 17408, L_KT = 34816, L_VT = 53248, L_AL = 90112, L_ALOW = 99328, L_DL = 105472, L_SSQ = 105984, L_TOT = 108032, L_WA = 112128, L_BA = 120320, L_NW = 120832, L_GLA_END = 121856;
constexpr int QS = 272, TSB = 144;
static_assert(L_GLA_END <= RING_BYTES, "GLA LDS");
__device__ __forceinline__ bf16x8 pack8(const f32x4 a, const f32x4 b) {
    v4u w; w.x = pg8::cvt_pk_bf16(a[0], a[1]); w.y = pg8::cvt_pk_bf16(a[2], a[3]); w.z = pg8::cvt_pk_bf16(b[0], b[1]); w.w = pg8::cvt_pk_bf16(b[2], b[3]);
    return __builtin_bit_cast(bf16x8, w);
}
__device__ __forceinline__ void gla_phase(LAS unsigned char* lds, int tid, int wave, int lane, int G, int bid, int phase, int jl,
                                          const float* const* in, float* out, unsigned char* ws) {
    typedef unsigned u32x2 __attribute__((ext_vector_type(2)));
    const bf16* PROJ = (const bf16*)(ws + WS_BIG); const float* ALOW = (const float*)(ws + WS_ALOW); bf16* GOUT = (bf16*)(ws + WS_H);
    float* DS = (float*)(ws + WS_DS); float* DSC = (float*)(ws + WS_DSC);
    const int nitems = phase == 0 ? (224 + 4 * NBS) : 256;
    const int tid_in = tid;
    for (int item = bid; item < nitems; item += G) {
        int tid = tid_in; asm volatile("" : "+v"(tid));
        int lane = tid & 63, fr = lane & 15, fq = lane >> 4;
        int b, h, row0, ntok, sc = 0; bool want_out, samp = false;
        if (phase == 0) { if (item < 224) { const int bh = item / 7; sc = item - bh * 7; b = bh >> 2; h = bh & 3; row0 = b * TP + sc * 256; ntok = 256; want_out = false; }
                          else { const int q = item - 224; b = q >> 2; h = q & 3; row0 = MP + b * TS; ntok = TS; want_out = true; samp = true; } }
        else { const int bh = item >> 3; sc = item & 7; b = bh >> 2; h = bh & 3; row0 = b * TP + sc * 256; ntok = 256; want_out = true; }
        const int bh = b * 4 + h;
        f32x4 S[8][2];
#pragma unroll
        for (int dt = 0; dt < 8; ++dt)
#pragma unroll
            for (int vt = 0; vt < 2; ++vt) S[dt][vt] = (f32x4){0.f, 0.f, 0.f, 0.f};
        if (samp) {
            const float* s0 = in[3] + ((size_t)(jl * NBS + b) * NH + h) * DK * DV;
#pragma unroll
            for (int dt = 0; dt < 8; ++dt)
#pragma unroll
                for (int vt = 0; vt < 2; ++vt)
#pragma unroll
                    for (int e = 0; e < 4; ++e) S[dt][vt][e] = s0[(size_t)(16 * dt + 4 * fq + e) * DV + 32 * wave + 16 * vt + fr];
        } else if (phase == 1 && sc > 0) {
            const float* dsp = DS + (size_t)(bh * 7 + sc - 1) * DK * DV;
#pragma unroll
            for (int dt = 0; dt < 8; ++dt)
#pragma unroll
                for (int vt = 0; vt < 2; ++vt) S[dt][vt] = *(const f32x4*)(dsp + (size_t)(((wave * 8 + dt) * 2 + vt) * 64 + lane) * 4);
        }
        { const int r = tid >> 5, d4 = (tid & 31) * 4;
          *(LAS f32x4*)(lds + L_WA + (r * 128 + d4) * 4) = *(const f32x4*)(in[10] + (size_t)jl * 16 * 512 + r * 512 + h * DK + d4) * 1.4426950408889634f;
          if (tid < 32) *(LAS f32x4*)(lds + L_BA + tid * 16) = *(const f32x4*)(in[11] + jl * 512 + h * DK + tid * 4) * 1.4426950408889634f;
          if (tid < 64) *(LAS f32x4*)(lds + L_NW + tid * 16) = *(const f32x4*)(in[12] + jl * DM + h * DV + tid * 4); }
        float btot0 = 0.f, btot1 = 0.f;
        const int nsub = (ntok + 63) >> 6;
        unsigned qn[8], kn[8]; v4u vn[4]; f32x4 aln;
#define GLA_LOAD(sbx) { const int tokv_ = (ntok - 64 * (sbx)) < 64 ? (ntok - 64 * (sbx)) : 64; const int rb_ = row0 + 64 * (sbx); const int dp_ = tid & 63, jp_ = tid & 31, vg_ = tid >> 5; \
            _Pragma("unroll") for (int i = 0; i < 8; ++i) { const int tok = 8 * wave + i; qn[i] = 0u; kn[i] = 0u; \
                if (tok < tokv_) { const unsigned* pr = (const unsigned*)(PROJ + (size_t)(rb_ + tok) * NPROJ + h * DK) + dp_; if (want_out) qn[i] = pr[0]; kn[i] = pr[256]; } } \
            _Pragma("unroll") for (int i = 0; i < 2; ++i) { const int tok = 2 * jp_ + i; vn[2 * i] = (v4u){0u, 0u, 0u, 0u}; vn[2 * i + 1] = (v4u){0u, 0u, 0u, 0u}; \
                if (tok < tokv_) { const v4u* pv = (const v4u*)(PROJ + (size_t)(rb_ + tok) * NPROJ + 1024 + h * DV + 16 * vg_); vn[2 * i] = pv[0]; vn[2 * i + 1] = pv[1]; } } \
            aln = (f32x4){0.f, 0.f, 0.f, 0.f}; if (tid < 256) { const int tok = tid >> 2; if (tok < tokv_) aln = *(const f32x4*)(ALOW + (size_t)(rb_ + tok) * 16 + 4 * (tid & 3)); } }
        GLA_LOAD(0)
        for (int sb = 0; sb < nsub; ++sb) {
            typedef float f32x2 __attribute__((ext_vector_type(2)));
            const int tokv = (ntok - 64 * sb) < 64 ? (ntok - 64 * sb) : 64; const int rbase = row0 + 64 * sb;
            asm volatile("" : "+v"(tid)); lane = tid & 63; fr = lane & 15; fq = lane >> 4;
            const int dp = tid & 63, jp = tid & 31, vg = tid >> 5;
            if (tid < 256) *(LAS f32x4*)(lds + L_ALOW + (tid >> 2) * 64 + 16 * (tid & 3)) = aln;
            __syncthreads();
            f32x2 bj[8];
            { f32x2 x[8]; const f32x2 bav = *(const LAS f32x2*)(lds + L_BA + dp * 8);
#pragma unroll
              for (int i = 0; i < 8; ++i) x[i] = bav;
#pragma unroll
              for (int r4 = 0; r4 < 4; ++r4) { const f32x2 w0 = *(const LAS f32x2*)(lds + L_WA + ((4 * r4 + 0) * 128 + 2 * dp) * 4), w1 = *(const LAS f32x2*)(lds + L_WA + ((4 * r4 + 1) * 128 + 2 * dp) * 4),
                                                            w2 = *(const LAS f32x2*)(lds + L_WA + ((4 * r4 + 2) * 128 + 2 * dp) * 4), w3 = *(const LAS f32x2*)(lds + L_WA + ((4 * r4 + 3) * 128 + 2 * dp) * 4);
                  f32x4 al[8];
#pragma unroll
                  for (int i = 0; i < 8; ++i) al[i] = *(const LAS f32x4*)(lds + L_ALOW + (8 * wave + i) * 64 + 16 * r4);
#pragma unroll
                  for (int i = 0; i < 8; ++i) x[i] = w0 * al[i][0] + x[i];
#pragma unroll
                  for (int i = 0; i < 8; ++i) x[i] = w1 * al[i][1] + x[i];
#pragma unroll
                  for (int i = 0; i < 8; ++i) x[i] = w2 * al[i][2] + x[i];
#pragma unroll
                  for (int i = 0; i < 8; ++i) x[i] = w3 * al[i][3] + x[i]; }
              f32x2 run = (f32x2){0.f, 0.f};
#pragma unroll
              for (int i = 0; i < 8; ++i) { f32x2 g;
                  g.x = (fminf(x[i].x, 0.f) - __builtin_amdgcn_logf(1.0f + __builtin_amdgcn_exp2f(-fabsf(x[i].x)))) * (1.0f / 16.0f); g.y = (fminf(x[i].y, 0.f) - __builtin_amdgcn_logf(1.0f + __builtin_amdgcn_exp2f(-fabsf(x[i].y)))) * (1.0f / 16.0f);
                  if (tokv < 64 && 8 * wave + i >= tokv) g = (f32x2){0.f, 0.f};
                  run += g; bj[i] = run; }
              *(LAS f32x2*)(lds + L_TOT + (wave * 128 + 2 * dp) * 4) = run; }
            __syncthreads();
            f32x2 pre = (f32x2){0.f, 0.f}, blast = (f32x2){0.f, 0.f};
#pragma unroll
            for (int q = 0; q < 8; ++q) { const f32x2 t = *(const LAS f32x2*)(lds + L_TOT + (q * 128 + 2 * dp) * 4); blast += t; if (q < wave) pre += t; }
            btot0 += blast.x; btot1 += blast.y;
            if (wave == 0) *(LAS f32x2*)(lds + L_DL + dp * 8) = (f32x2){__builtin_amdgcn_exp2f(blast.x), __builtin_amdgcn_exp2f(blast.y)};
            { unsigned kb[8];
#pragma unroll
              for (int i = 0; i < 8; ++i) { const int tok = 8 * wave + i; const f32x2 bb = bj[i] + pre;
                  const float e1x = __builtin_amdgcn_exp2f(blast.x - bb.x), e1y = __builtin_amdgcn_exp2f(blast.y - bb.y);
                  const unsigned kh = pg8::cvt_pk_bf16(bf2f((unsigned short)(kn[i] & 0xffffu)) * e1x, bf2f((unsigned short)(kn[i] >> 16)) * e1y);
                  kb[i] = kh;
                  if (want_out) {
                      const float e2x = __builtin_amdgcn_exp2f(bb.x - blast.x), e2y = __builtin_amdgcn_exp2f(bb.y - blast.y);
                      const unsigned qh = pg8::cvt_pk_bf16(bf2f((unsigned short)(qn[i] & 0xffffu)) * e2x, bf2f((unsigned short)(qn[i] >> 16)) * e2y);
                      *(LAS unsigned*)(lds + L_QH + tok * QS + dp * 4) = qh; *(LAS unsigned*)(lds + L_KH + tok * QS + dp * 4) = kh; } }
              v4u k0, k1;
              k0.x = (kb[0] & 0xffffu) | (kb[1] << 16); k0.y = (kb[2] & 0xffffu) | (kb[3] << 16); k0.z = (kb[4] & 0xffffu) | (kb[5] << 16); k0.w = (kb[6] & 0xffffu) | (kb[7] << 16);
              k1.x = (kb[0] >> 16) | (kb[1] & 0xffff0000u); k1.y = (kb[2] >> 16) | (kb[3] & 0xffff0000u); k1.z = (kb[4] >> 16) | (kb[5] & 0xffff0000u); k1.w = (kb[6] >> 16) | (kb[7] & 0xffff0000u);
              *(LAS v4u*)(lds + L_KT + (2 * dp) * TSB + wave * 16) = k0; *(LAS v4u*)(lds + L_KT + (2 * dp + 1) * TSB + wave * 16) = k1; }
            {
#pragma unroll
              for (int hv = 0; hv < 2; ++hv) { const unsigned a4[4] = {vn[hv].x, vn[hv].y, vn[hv].z, vn[hv].w}, b4[4] = {vn[2 + hv].x, vn[2 + hv].y, vn[2 + hv].z, vn[2 + hv].w};
#pragma unroll
                  for (int k = 0; k < 4; ++k) { LAS unsigned char* p = lds + L_VT + (16 * vg + 8 * hv + 2 * k) * TSB + jp * 4;
                      *(LAS unsigned*)p = (a4[k] & 0xffffu) | (b4[k] << 16); *(LAS unsigned*)(p + TSB) = (a4[k] >> 16) | (b4[k] & 0xffff0000u); } } }
            __syncthreads();
            u32x2 rcur[4][2];
            if (want_out) {
#pragma unroll
                for (int it = 0; it < 4; ++it)
#pragma unroll
                    for (int vt = 0; vt < 2; ++vt) { rcur[it][vt] = (u32x2){0u, 0u};
                        if (16 * it + fr < tokv) rcur[it][vt] = *(const u32x2*)(PROJ + (size_t)(rbase + 16 * it + fr) * NPROJ + 2048 + h * DV + 32 * wave + 16 * vt + 4 * fq); } }
            if (sb + 1 < nsub) GLA_LOAD(sb + 1)
#pragma unroll
            for (int dt = 0; dt < 8; ++dt) { const f32x4 dv = *(const LAS f32x4*)(lds + L_DL + (16 * dt + 4 * fq) * 4); S[dt][0] = S[dt][0] * dv; S[dt][1] = S[dt][1] * dv; }
            if (want_out) {
                f32x4 O[2][4];
#pragma unroll
                for (int tt = 0; tt < 2; ++tt) { const int idx = 2 * wave + tt, it = idx >> 2, jt = idx & 3; f32x4 a = (f32x4){0.f, 0.f, 0.f, 0.f};
                    if (jt <= it) {
#pragma unroll
                        for (int ks = 0; ks < 4; ++ks) { const bf16x8 X = *(const LAS bf16x8*)(lds + L_KH + (16 * jt + fr) * QS + (32 * ks + 8 * fq) * 2);
                            const bf16x8 Y = *(const LAS bf16x8*)(lds + L_QH + (16 * it + fr) * QS + (32 * ks + 8 * fq) * 2);
                            a = __builtin_amdgcn_mfma_f32_16x16x32_bf16(X, Y, a, 0, 0, 0); }
                        const int ii = 16 * it + fr, j0 = 16 * jt + 4 * fq;
#pragma unroll
                        for (int e = 0; e < 4; ++e) if (j0 + e > ii) a[e] = 0.f;
                    }
                    u32x2 w2; w2.x = pg8::cvt_pk_bf16(a[0], a[1]); w2.y = pg8::cvt_pk_bf16(a[2], a[3]);
                    *(LAS u32x2*)(lds + L_AL + (16 * it + fr) * TSB + (16 * jt + 4 * fq) * 2) = w2; }
                __syncthreads();
                {
                bf16x8 Xs[2][4];
#pragma unroll
                for (int vt = 0; vt < 2; ++vt)
#pragma unroll
                    for (int dp = 0; dp < 4; ++dp) Xs[vt][dp] = pack8(S[2 * dp][vt], S[2 * dp + 1][vt]);
                bf16x8 XV[2][2];
#pragma unroll
                for (int vt = 0; vt < 2; ++vt)
#pragma unroll
                    for (int js = 0; js < 2; ++js) XV[vt][js] = *(const LAS bf16x8*)(lds + L_VT + (32 * wave + 16 * vt + fr) * TSB + (32 * js + 8 * fq) * 2);
#pragma unroll
                for (int it = 0; it < 4; ++it) {
                    bf16x8 YQ[4], YA[2];
#pragma unroll
                    for (int dp = 0; dp < 4; ++dp) { const u32x2 lo = *(const LAS u32x2*)(lds + L_QH + (16 * it + fr) * QS + (32 * dp + 4 * fq) * 2);
                        const u32x2 hi = *(const LAS u32x2*)(lds + L_QH + (16 * it + fr) * QS + (32 * dp + 16 + 4 * fq) * 2);
                        YQ[dp] = __builtin_bit_cast(bf16x8, (v4u){lo.x, lo.y, hi.x, hi.y}); }
#pragma unroll
                    for (int js = 0; js < 2; ++js) YA[js] = *(const LAS bf16x8*)(lds + L_AL + (16 * it + fr) * TSB + (32 * js + 8 * fq) * 2);
                    { f32x4 o0 = (f32x4){0.f, 0.f, 0.f, 0.f}, o1 = (f32x4){0.f, 0.f, 0.f, 0.f};
#pragma unroll
                      for (int dp = 0; dp < 4; ++dp) { o0 = __builtin_amdgcn_mfma_f32_16x16x32_bf16(Xs[0][dp], YQ[dp], o0, 0, 0, 0); o1 = __builtin_amdgcn_mfma_f32_16x16x32_bf16(Xs[1][dp], YQ[dp], o1, 0, 0, 0); }
#pragma unroll
                      for (int js = 0; js < 2; ++js) { o0 = __builtin_amdgcn_mfma_f32_16x16x32_bf16(XV[0][js], YA[js], o0, 0, 0, 0); o1 = __builtin_amdgcn_mfma_f32_16x16x32_bf16(XV[1][js], YA[js], o1, 0, 0, 0); }
                      O[0][it] = o0; O[1][it] = o1; }
                    __builtin_amdgcn_sched_barrier(0);
                }
                }
#pragma unroll
                for (int it = 0; it < 4; ++it) { float ss = 0.f;
#pragma unroll
                    for (int vt = 0; vt < 2; ++vt) { const f32x4 o = O[vt][it]; ss += (o[0] * o[0] + o[1] * o[1]) + (o[2] * o[2] + o[3] * o[3]); }
                    ss += __shfl_xor(ss, 16); ss += __shfl_xor(ss, 32);
                    if (fq == 0) *(LAS float*)(lds + L_SSQ + (wave * 64 + 16 * it + fr) * 4) = ss; }
                __syncthreads();
#pragma unroll
                for (int it = 0; it < 4; ++it) { const int tok = 16 * it + fr; float tot = 0.f;
#pragma unroll
                    for (int w8 = 0; w8 < 8; ++w8) tot += *(const LAS float*)(lds + L_SSQ + (w8 * 64 + tok) * 4);
                    const float rstd = rsqrtf(tot * (1.0f / DV) + EPS);
                    if (tok < tokv) { const size_t row = (size_t)(rbase + tok);
#pragma unroll
                        for (int vt = 0; vt < 2; ++vt) { const int vcol = h * DV + 32 * wave + 16 * vt + 4 * fq;
                            const u32x2 r2 = rcur[it][vt]; const f32x4 nw = *(const LAS f32x4*)(lds + L_NW + (32 * wave + 16 * vt + 4 * fq) * 4);
                            const f32x4 o = O[vt][it];
                            const float r0 = bf2f((unsigned short)(r2.x & 0xffffu)), r1 = bf2f((unsigned short)(r2.x >> 16)), r2f = bf2f((unsigned short)(r2.y & 0xffffu)), r3 = bf2f((unsigned short)(r2.y >> 16));
                            u32x2 w2; w2.x = pg8::cvt_pk_bf16(o[0] * rstd * nw[0] * r0, o[1] * rstd * nw[1] * r1);
                            w2.y = pg8::cvt_pk_bf16(o[2] * rstd * nw[2] * r2f, o[3] * rstd * nw[3] * r3);
                            *(u32x2*)(GOUT + row * DM + vcol) = w2; } }
                    __builtin_amdgcn_sched_barrier(0); }
            }
            __builtin_amdgcn_sched_barrier(0);
#pragma unroll
            for (int js = 0; js < 2; ++js)
#pragma unroll
                for (int vt = 0; vt < 2; ++vt) { const bf16x8 Yv = *(const LAS bf16x8*)(lds + L_VT + (32 * wave + 16 * vt + fr) * TSB + (32 * js + 8 * fq) * 2);
#pragma unroll
                    for (int dt = 0; dt < 8; ++dt) { const bf16x8 Xk = *(const LAS bf16x8*)(lds + L_KT + (16 * dt + fr) * TSB + (32 * js + 8 * fq) * 2);
                        S[dt][vt] = __builtin_amdgcn_mfma_f32_16x16x32_bf16(Xk, Yv, S[dt][vt], 0, 0, 0); }
                    __builtin_amdgcn_sched_barrier(0); }
            __syncthreads();
        }
        asm volatile("" : "+v"(tid)); lane = tid & 63; fr = lane & 15; fq = lane >> 4;
        if (phase == 0 && !samp) {
            float* dsp = DS + (size_t)(bh * 7 + sc) * DK * DV;
#pragma unroll
            for (int dt = 0; dt < 8; ++dt)
#pragma unroll
                for (int vt = 0; vt < 2; ++vt) *(f32x4*)(dsp + (size_t)(((wave * 8 + dt) * 2 + vt) * 64 + lane) * 4) = S[dt][vt];
            if (wave == 0) { DSC[(size_t)(bh * 7 + sc) * DK + 2 * (tid & 63)] = __builtin_amdgcn_exp2f(btot0); DSC[(size_t)(bh * 7 + sc) * DK + 2 * (tid & 63) + 1] = __builtin_amdgcn_exp2f(btot1); }
        } else if (samp || sc == 7) {
            float* so = samp ? out + O_NGS + ((size_t)(jl * NBS + b) * NH + h) * DK * DV : out + O_NGP + ((size_t)(jl * NBP + b) * NH + h) * DK * DV;
#pragma unroll
            for (int dt = 0; dt < 8; ++dt)
#pragma unroll
                for (int vt = 0; vt < 2; ++vt)
#pragma unroll
                    for (int e = 0; e < 4; ++e) so[(size_t)(16 * dt + 4 * fq + e) * DV + 32 * wave + 16 * vt + fr] = S[dt][vt][e];
        }
    }
}


__device__ __forceinline__ void gla_scan_phase(int gt, int NT, unsigned char* ws) {
    float* DS = (float*)(ws + WS_DS); const float* DSC = (const float*)(ws + WS_DSC);
    for (int c = gt; c < 32 * 8192; c += NT) {
        const int bh = c >> 13, e4 = c & 8191, ln = e4 & 63, dt = (e4 >> 7) & 7, dcol = 16 * dt + 4 * (ln >> 4);
        f32x4 ds[7], dv[7];
#pragma unroll
        for (int k = 0; k < 7; ++k) { ds[k] = *(const f32x4*)(DS + (size_t)(bh * 7 + k) * DK * DV + (size_t)e4 * 4); dv[k] = *(const f32x4*)(DSC + (size_t)(bh * 7 + k) * DK + dcol); }
        f32x4 run = (f32x4){0.f, 0.f, 0.f, 0.f};
#pragma unroll
        for (int k = 0; k < 7; ++k) { run = run * dv[k] + ds[k]; *(f32x4*)(DS + (size_t)(bh * 7 + k) * DK * DV + (size_t)e4 * 4) = run; }
    }
}

struct Args { const float* in[17]; float* out; unsigned char* ws; int ph_lo, ph_hi; };
constexpr int N_PHASES = 29;
__global__ void __launch_bounds__(NWAVES * 64, 2) mk_fwd(Args args) {
    extern __shared__ __attribute__((aligned(16))) unsigned char lds_raw[];
    LAS unsigned char* lds = (LAS unsigned char*)lds_raw;
    volatile LAS unsigned* MISC = (volatile LAS unsigned*)(lds + MISC_OFF);
    for (int u = threadIdx.x; u < (LDS_BYTES - LDSCTL_OFF) / 4; u += NWAVES * 64) ((LAS unsigned*)(lds + LDSCTL_OFF))[u] = 0u;
    __syncthreads();
    XcdBarrier bar = xcd_barrier_post((unsigned*)(args.ws + WS_CTL) + CW_BAR, MISC + 8);
    const int lo = args.ph_lo, hi = args.ph_hi;
    const int wave0 = __builtin_amdgcn_readfirstlane(threadIdx.x >> 6);
#define PH_BEGIN(k) if ((k) >= lo && (k) < hi) { int tid = wave0 * 64 + (int)__builtin_amdgcn_mbcnt_hi(~0u, __builtin_amdgcn_mbcnt_lo(~0u, 0u)); asm volatile("" : "+v"(tid)); const int lane = tid & 63, wave = wave0; \
        const int G = gridDim.x, bid = blockIdx.x; const int vcu = (G % 8 == 0) ? (bid % 8) * (G / 8) + bid / 8 : bid; const int gw = vcu * NWAVES + wave, NGW = G * NWAVES; \
        unsigned char* ws = args.ws; float* out = args.out; const float* const* in = args.in; bf16* Hb = (bf16*)(ws + WS_H); bf16* BIG = (bf16*)(ws + WS_BIG); float* Xs_ = out + O_YS; \
        (void)lane; (void)gw; (void)NGW; (void)Hb; (void)BIG; (void)Xs_; (void)in;
#define PH_END(k)   if ((k) + 1 < hi) xcd_barrier(bar); }

#define POOL_GEMM(k, L) PH_BEGIN(k) { constexpr int jl = (L) >> 1; \
        pg8::Gemm g{BIG, (const bf16*)(ws + WS_WP + jl * SZ_WP), 4 * M, 1024, 256}; pg8::PoolOrder S{G, bid}; \
        pg8::EpiRes<true> E{(L) == 0 ? in[0] : out, (L) == 0 ? in[1] : Xs_, out, in[8] + jl * DM}; \
        pg8::gemm_phase<pg8::EpiRes<true>, pg8::PoolOrder, true, true>(lds, g, S, E, tid); \
        small_gemm_pool(lds, BIG, (const bf16*)(ws + WS_WP + jl * SZ_WP), (L) == 0 ? in[1] : Xs_, Xs_, in[8] + jl * DM, tid, wave, G, bid); } PH_END(k)
#define RMS_PH(k, gain) PH_BEGIN(k) rms_phase(gw, NGW, lane, out, (gain), Hb); PH_END(k)
#define FFN1(k, L) PH_BEGIN(k) { pg8::Gemm g{Hb, (const bf16*)(ws + WS_W13 + (L) * SZ_W13), M, NG1, DM}; pg8::StaticOrder S; S.init(M, NG1, G, bid, DM); \
        pg8::EpiSwiglu E{BIG}; pg8::gemm_phase<pg8::EpiSwiglu, pg8::StaticOrder, true, true>(lds, g, S, E, tid); } PH_END(k)
#define FFN2(k, L) PH_BEGIN(k) { pg8::Gemm g{BIG, (const bf16*)(ws + WS_W2 + (L) * SZ_W2), M, DM, FF}; pg8::PanelOrder S{G, bid, FF / 64}; \
        pg8::EpiRes<false> E{out, Xs_, out, nullptr}; pg8::gemm_phase<pg8::EpiRes<false>, pg8::PanelOrder, true, true>(lds, g, S, E, tid); \
        small_gemm_res(lds, BIG + (size_t)MP * FF, (const bf16*)(ws + WS_W2 + (L) * SZ_W2), FF, Xs_, tid, wave, G, bid); } PH_END(k)
#define PROJ_PH(k, jl) PH_BEGIN(k) { pg8::Gemm g{Hb, (const bf16*)(ws + WS_WIN + (jl) * SZ_WIN), M, NINP, DM}; pg8::StaticOrder S; S.init(M, NINP, G, bid, DM); \
        pg8::EpiProj E{BIG, (float*)(ws + WS_ALOW)}; pg8::gemm_phase<pg8::EpiProj, pg8::StaticOrder, true, true>(lds, g, S, E, tid); } PH_END(k)
#define WO_PH(k, jl) PH_BEGIN(k) { pg8::Gemm g{Hb, (const bf16*)(ws + WS_WO + (jl) * SZ_WO), M, DM, DM}; pg8::PanelOrder S{G, bid, DM / 64}; \
        pg8::EpiRes<false> E{out, Xs_, out, nullptr}; pg8::gemm_phase<pg8::EpiRes<false>, pg8::PanelOrder, true, true>(lds, g, S, E, tid); \
        small_gemm_res(lds, Hb + (size_t)MP * DM, (const bf16*)(ws + WS_WO + (jl) * SZ_WO), DM, Xs_, tid, wave, G, bid); } PH_END(k)
#define GLA_PH(k, sub, jl) PH_BEGIN(k) gla_phase(lds, tid, wave, lane, G, bid, (sub), (jl), in, out, ws); PH_END(k)

#ifdef NO_GLA
#undef GLA_PH
#define GLA_PH(k, sub, jl)
#endif
#ifdef NO_GEMM
#undef POOL_GEMM
#undef FFN1
#undef FFN2
#undef PROJ_PH
#undef WO_PH
#define POOL_GEMM(k, L)
#define FFN1(k, L)
#define FFN2(k, L)
#define PROJ_PH(k, jl)
#define WO_PH(k, jl)
#endif
#ifdef ONLY_FFN1
#undef POOL_GEMM
#undef FFN2
#undef PROJ_PH
#undef WO_PH
#define POOL_GEMM(k, L)
#define FFN2(k, L)
#define PROJ_PH(k, jl)
#define WO_PH(k, jl)
#endif
    PH_BEGIN(0)
        p0_weights(lds, wave, lane, gw, NGW, in, ws);
        __syncthreads();
        pool_prep(lds, tid, wave, lane, G, bid, in[0], in[1], in[4] + 0 * DM, in[2], BIG, out + O_NPP, out + O_NPS);
    PH_END(0)
    POOL_GEMM(1, 0)
    RMS_PH(2, in[5] + 0 * DM)
    FFN1(3, 0)
    FFN2(4, 0)
    RMS_PH(5, in[4] + 1 * DM)
    PROJ_PH(6, 0)
    GLA_PH(7, 0, 0)
    PH_BEGIN(8)
        gla_scan_phase(vcu * (NWAVES * 64) + tid, G * NWAVES * 64, ws);
    PH_END(8)
    GLA_PH(9, 1, 0)
    WO_PH(10, 0)
    RMS_PH(11, in[5] + 1 * DM)
    FFN1(12, 1)
    FFN2(13, 1)
    PH_BEGIN(14)
        pool_prep(lds, tid, wave, lane, G, bid, out, Xs_, in[4] + 2 * DM, in[2] + (size_t)NBS * 15 * DM, BIG, out + O_NPP + (size_t)NBP * 15 * DM, out + O_NPS + (size_t)NBS * 15 * DM);
    PH_END(14)
    POOL_GEMM(15, 2)
    RMS_PH(16, in[5] + 2 * DM)
    FFN1(17, 2)
    FFN2(18, 2)
    RMS_PH(19, in[4] + 3 * DM)
    PROJ_PH(20, 1)
    GLA_PH(21, 0, 1)
    PH_BEGIN(22)
        gla_scan_phase(vcu * (NWAVES * 64) + tid, G * NWAVES * 64, ws);
    PH_END(22)
    GLA_PH(23, 1, 1)
    WO_PH(24, 1)
    RMS_PH(25, in[5] + 3 * DM)
    FFN1(26, 3)
    FFN2(27, 3)
    PH_BEGIN(28)
        final_norm_phase(gw, NGW, lane, out, in[6]);
    PH_END(28)
}

#ifndef MK_SPLIT
#define MK_SPLIT 0
#endif
extern "C" void kernel_launch(void* const* d_in, const int* in_sizes, int n_in, void* d_out, int out_size, void* d_ws, size_t ws_size, hipStream_t stream) {
    static int grid = 0;
    if (grid == 0) {
        if (n_in != 17 || (size_t)out_size != O_END || ws_size < WS_END) { fprintf(stderr, "kernel_launch: unexpected shapes (n_in %d out %d ws %zu)\n", n_in, out_size, ws_size); grid = -1; return; }
        int dev = 0, cus = 0, per_cu = 0;
        if (hipGetDevice(&dev) != hipSuccess || hipDeviceGetAttribute(&cus, hipDeviceAttributeMultiprocessorCount, dev) != hipSuccess) { grid = -1; return; }
        if (hipFuncSetAttribute((const void*)mk_fwd, hipFuncAttributeMaxDynamicSharedMemorySize, LDS_BYTES) != hipSuccess) { fprintf(stderr, "kernel_launch: hipFuncSetAttribute failed\n"); grid = -1; return; }
        if (hipOccupancyMaxActiveBlocksPerMultiprocessor(&per_cu, (const void*)mk_fwd, NWAVES * 64, LDS_BYTES) != hipSuccess || per_cu < 1) { fprintf(stderr, "kernel_launch: occupancy query failed (%d)\n", per_cu); (void)hipGetLastError(); per_cu = 1; }
        grid = cus;
        if (grid > cus * per_cu) grid = cus * per_cu;
    }
    if (grid < 0) return;
    if (hipMemsetAsync((char*)d_ws + WS_CTL, 0, CTL_ZERO_BYTES, stream) != hipSuccess) { fprintf(stderr, "kernel_launch: memset failed\n"); return; }
    Args a{};
    for (int i = 0; i < 17; ++i) a.in[i] = (const float*)d_in[i];
    a.out = (float*)d_out; a.ws = (unsigned char*)d_ws;
#if MK_SPLIT
    for (int p = 0; p < N_PHASES; ++p) { a.ph_lo = p; a.ph_hi = p + 1; hipLaunchKernelGGL(mk_fwd, dim3(grid), dim3(NWAVES * 64), LDS_BYTES, stream, a); }
#else
    a.ph_lo = 0; a.ph_hi = N_PHASES;
    void* kargs[] = {&a};
    hipError_t e = hipLaunchCooperativeKernel((const void*)mk_fwd, dim3(grid), dim3(NWAVES * 64), kargs, LDS_BYTES, stream);
    if (e != hipSuccess) fprintf(stderr, "kernel_launch: cooperative launch failed: %s (grid %d)\n", hipGetErrorString(e), grid);
#endif
}
```
